# Optimizing an MI355X kernel written in HIP

```python
import jax
import jax.numpy as jnp
from jax import lax
import numpy as np

D_MODEL = 1024
BATCH = 1
SEQ = 16384
DEPTH = 1

HEAD_DIM = 64
N_ATT_HEADS = 8
N_RWKV_HEADS = 8
D_ATT = N_ATT_HEADS * HEAD_DIM
D_RWKV = N_RWKV_HEADS * HEAD_DIM
D_MIX = D_ATT + D_RWKV
ROPE_THETA = 500000.0
N_IDX_HEADS = 8
IDX_DIM = 32
TOPK_MAX = 256
Q_BLOCK = 128
D_DECAY_LORA = 32
D_AAA_LORA = 32
D_GATE_LORA = 64
RWKV_GN_EPS = 64e-5
N_EXPERTS = 32
TOP_K_EXPERTS = 4
D_FF_EXPERT = 1024
SWIGLU_LIMIT = 7.0
SWIGLU_ALPHA = 1.702
MOE_BLOCK = 128
RMS_EPS = 1e-6

ATT_COL_SIZES = (D_ATT, D_ATT, D_ATT, N_IDX_HEADS * IDX_DIM, IDX_DIM, N_IDX_HEADS)
RWKV_COL_SIZES = (D_RWKV, D_RWKV, D_RWKV, D_DECAY_LORA, D_AAA_LORA, D_GATE_LORA)
D_ATT_COLS = 3 * D_ATT + N_IDX_HEADS * IDX_DIM + IDX_DIM + N_IDX_HEADS
D_RWKV_COLS = 3 * D_RWKV + D_DECAY_LORA + D_AAA_LORA + D_GATE_LORA
D_IN = D_ATT_COLS + D_RWKV_COLS

kernel_name = "hybrid_dsa_rwkv7_moe_layer"


def _split_cols(z, sizes):
    return jnp.split(z, np.cumsum(sizes)[:-1].tolist(), axis=-1)


def rms_norm(x, w):
    xf = x.astype(jnp.float32)
    y = xf * lax.rsqrt(jnp.mean(xf * xf, axis=-1, keepdims=True) + RMS_EPS)
    return (y * w.astype(jnp.float32)).astype(x.dtype)


def partial_rotary(x, positions):
    d = x.shape[-1]
    rot = d // 4
    half = rot // 2
    inv_freq = ROPE_THETA ** (-jnp.arange(half, dtype=jnp.float32) / half)
    ang = positions.astype(jnp.float32)[..., None] * inv_freq
    ang = ang.reshape(ang.shape[:2] + (1,) * (x.ndim - 3) + (half,))
    cos, sin = jnp.cos(ang), jnp.sin(ang)
    xf = x.astype(jnp.float32)
    x1, x2, rest = xf[..., :half], xf[..., half:rot], xf[..., rot:]
    out = jnp.concatenate([x1 * cos - x2 * sin, x2 * cos + x1 * sin, rest], axis=-1)
    return out.astype(x.dtype)


def dsa_sparse_attention(q, k, v, iq, ik, iw):
    B, T, H, dh = q.shape
    n_sel = min(TOPK_MAX, T // 4)
    nb = T // Q_BLOCK
    idx_scale = (IDX_DIM * N_IDX_HEADS) ** -0.5
    att_scale = HEAD_DIM ** -0.5
    batch_ix = jnp.arange(B)[:, None, None]
    s_pos = jnp.arange(T)

    def to_blocks(a):
        return a.reshape((B, nb, Q_BLOCK) + a.shape[2:]).swapaxes(0, 1)

    def one_block(args):
        qb, iqb, iwb, start = args
        t_pos = start + jnp.arange(Q_BLOCK)
        dots = jnp.einsum("bqhd,bsd->bqhs", iqb, ik, preferred_element_type=jnp.float32)
        score = jnp.einsum("bqh,bqhs->bqs", iwb.astype(jnp.float32), jax.nn.relu(dots)) * idx_scale
        causal = s_pos[None, :] <= t_pos[:, None]
        score = jnp.where(causal[None], score, -jnp.inf)
        _, sel = lax.top_k(score, n_sel)
        valid = sel <= t_pos[None, :, None]
        k_sel = k[batch_ix, sel]
        v_sel = v[batch_ix, sel]
        logits = jnp.einsum("bqhd,bqkhd->bhqk", qb, k_sel, preferred_element_type=jnp.float32) * att_scale
        logits = jnp.where(valid[:, None], logits, -jnp.inf)
        p = jax.nn.softmax(logits, axis=-1)
        return jnp.einsum("bhqk,bqkhd->bqhd", p.astype(v.dtype), v_sel)

    starts = jnp.arange(nb) * Q_BLOCK
    out = lax.map(one_block, (to_blocks(q), to_blocks(iq), to_blocks(iw), starts))
    return out.swapaxes(0, 1).reshape(B, T, H, dh)


def token_shift(z, mu):
    prev = jnp.pad(z, ((0, 0), (1, 0), (0, 0)))[:, :-1]
    return z + (prev - z) * mu


def rwkv7_time_mix(r, k, v, wd, ad, gd, w0, w2, a0, a2, g2, k_k, k_a, r_k, ln_w, ln_b):
    B, T, _ = r.shape
    H, N = N_RWKV_HEADS, HEAD_DIM
    f32 = jnp.float32
    r, k, v, wd, ad, gd = (z.astype(f32) for z in (r, k, v, wd, ad, gd))
    log_w = -jax.nn.softplus(-(w0 + jnp.tanh(wd) @ w2)) - 0.5
    decay = jnp.exp(-jnp.exp(log_w))
    a = jax.nn.sigmoid(a0 + ad @ a2)
    g = jax.nn.sigmoid(gd) @ g2
    kk = (k * k_k).reshape(B, T, H, N)
    kk = kk * lax.rsqrt(jnp.maximum(jnp.sum(kk * kk, axis=-1, keepdims=True), 1e-24))
    k = k * (1.0 + (a - 1.0) * k_a)
    heads = lambda z: z.reshape(B, T, H, N)
    r, decay, k, v, a = heads(r), heads(decay), heads(k), heads(v), heads(a)

    def step(S, inp):
        r_t, w_t, k_t, v_t, kk_t, a_t = inp
        sa = jnp.einsum("bhij,bhj->bhi", S, kk_t)
        S = (S * w_t[:, :, None, :]
             - sa[..., None] * (kk_t * a_t)[:, :, None, :]
             + v_t[..., None] * k_t[:, :, None, :])
        return S, jnp.einsum("bhij,bhj->bhi", S, r_t)

    xs = tuple(z.swapaxes(0, 1) for z in (r, decay, k, v, kk, a))
    _, y = lax.scan(step, jnp.zeros((B, H, N, N), f32), xs)
    y = y.swapaxes(0, 1)
    mean = jnp.mean(y, axis=-1, keepdims=True)
    var = jnp.mean(jnp.square(y - mean), axis=-1, keepdims=True)
    y = ((y - mean) * lax.rsqrt(var + RWKV_GN_EPS)).reshape(B, T, H * N) * ln_w + ln_b
    bonus = jnp.sum(r * k * r_k, axis=-1, keepdims=True) * v
    return (y + bonus.reshape(B, T, H * N)) * g


def moe_ffn(xn, router_w, router_b, w_gu, b_gu, w_dn, b_dn):
    B, T, D = xn.shape
    n_tok = B * T
    xt = xn.reshape(n_tok, D)
    logits = (xt @ router_w + router_b).astype(jnp.float32)
    top_val, top_e = lax.top_k(logits, TOP_K_EXPERTS)
    gates = jax.nn.softmax(top_val, axis=-1)
    n_asg = n_tok * TOP_K_EXPERTS
    flat_e = top_e.reshape(n_asg)
    flat_tok = jnp.arange(n_asg, dtype=jnp.int32) // TOP_K_EXPERTS
    order = jnp.argsort(flat_e)
    se, stok, sg = flat_e[order], flat_tok[order], gates.reshape(n_asg)[order]
    counts = jnp.zeros((N_EXPERTS,), jnp.int32).at[flat_e].add(1)
    padded = (counts + MOE_BLOCK - 1) // MOE_BLOCK * MOE_BLOCK
    start = jnp.cumsum(counts) - counts
    pend = jnp.cumsum(padded)
    pstart = pend - padded
    dest = pstart[se] + (jnp.arange(n_asg, dtype=jnp.int32) - start[se])
    n_rows = (-(-n_asg // MOE_BLOCK) + N_EXPERTS) * MOE_BLOCK
    n_blk = n_rows // MOE_BLOCK
    row_tok = jnp.full((n_rows,), n_tok, jnp.int32).at[dest].set(stok)
    row_g = jnp.zeros((n_rows,), jnp.float32).at[dest].set(sg)
    blk_e = jnp.clip(jnp.searchsorted(pend, jnp.arange(n_blk) * MOE_BLOCK, side="right"), 0, N_EXPERTS - 1)
    x_pad = jnp.concatenate([xt, jnp.zeros((1, D), xt.dtype)], axis=0)
    xb = x_pad[row_tok].reshape(n_blk, MOE_BLOCK, D)

    def expert_block(args):
        xblk, e = args
        hgu = xblk @ w_gu[e] + b_gu[e]
        glu = jnp.minimum(hgu[:, :D_FF_EXPERT], SWIGLU_LIMIT)
        lin = jnp.clip(hgu[:, D_FF_EXPERT:], -SWIGLU_LIMIT, SWIGLU_LIMIT)
        act = (lin + 1.0) * glu * jax.nn.sigmoid(SWIGLU_ALPHA * glu)
        return act @ w_dn[e] + b_dn[e]

    yb = lax.map(expert_block, (xb, blk_e)).reshape(n_rows, D)
    y = jax.ops.segment_sum(yb * row_g[:, None].astype(yb.dtype), row_tok, num_segments=n_tok + 1)[:n_tok]
    return y.reshape(B, T, D)


def setup_inputs(seed: int = 0) -> dict:
    key = jax.random.key(seed)
    ks = jax.random.split(key, 24)
    f32 = jnp.float32
    L = DEPTH

    def nrm(kk, shape, scale):
        return jax.random.normal(kk, shape, f32) * scale

    return {
        "x": nrm(ks[0], (BATCH, SEQ, D_MODEL), 1.0),
        "positions": jnp.tile(jnp.arange(SEQ, dtype=jnp.int32)[None], (BATCH, 1)),
        "norm1_w": 1.0 + nrm(ks[1], (L, D_MODEL), 0.02),
        "w_in": nrm(ks[2], (L, D_MODEL, D_IN), D_MODEL ** -0.5),
        "q_norm_w": 1.0 + nrm(ks[3], (L, HEAD_DIM), 0.02),
        "k_norm_w": 1.0 + nrm(ks[4], (L, HEAD_DIM), 0.02),
        "rwkv_mu": jax.random.uniform(ks[5], (L, D_RWKV_COLS), f32),
        "rwkv_w0": jax.random.uniform(ks[6], (L, D_RWKV), f32, -5.0, 1.0),
        "rwkv_w2": nrm(ks[7], (L, D_DECAY_LORA, D_RWKV), 0.1),
        "rwkv_a0": nrm(ks[8], (L, D_RWKV), 0.1),
        "rwkv_a2": nrm(ks[9], (L, D_AAA_LORA, D_RWKV), D_AAA_LORA ** -0.5),
        "rwkv_g2": nrm(ks[10], (L, D_GATE_LORA, D_RWKV), D_GATE_LORA ** -0.5),
        "rwkv_k_k": 0.85 + nrm(ks[11], (L, D_RWKV), 0.05),
        "rwkv_k_a": 1.0 + nrm(ks[12], (L, D_RWKV), 0.05),
        "rwkv_r_k": nrm(ks[13], (L, N_RWKV_HEADS, HEAD_DIM), 0.1),
        "rwkv_ln_w": 1.0 + nrm(ks[14], (L, D_RWKV), 0.02),
        "rwkv_ln_b": nrm(ks[15], (L, D_RWKV), 0.01),
        "w_out": nrm(ks[16], (L, D_MIX, D_MODEL), D_MIX ** -0.5),
        "norm2_w": 1.0 + nrm(ks[17], (L, D_MODEL), 0.02),
        "router_w": nrm(ks[18], (L, D_MODEL, N_EXPERTS), D_MODEL ** -0.5),
        "router_b": nrm(ks[19], (L, N_EXPERTS), 0.01),
        "exp_w_gu": nrm(ks[20], (L, N_EXPERTS, D_MODEL, 2 * D_FF_EXPERT), D_MODEL ** -0.5),
        "exp_b_gu": nrm(ks[21], (L, N_EXPERTS, 2 * D_FF_EXPERT), 0.01),
        "exp_w_down": nrm(ks[22], (L, N_EXPERTS, D_FF_EXPERT, D_MODEL), D_FF_EXPERT ** -0.5),
        "exp_b_down": nrm(ks[23], (L, N_EXPERTS, D_MODEL), 0.01),
    }


def reference(x, positions, norm1_w, w_in, q_norm_w, k_norm_w, rwkv_mu, rwkv_w0, rwkv_w2,
              rwkv_a0, rwkv_a2, rwkv_g2, rwkv_k_k, rwkv_k_a, rwkv_r_k, rwkv_ln_w, rwkv_ln_b,
              w_out, norm2_w, router_w, router_b, exp_w_gu, exp_b_gu, exp_w_down, exp_b_down):
    B, T, _ = x.shape
    h = x
    for l in range(DEPTH):
        xn = rms_norm(h, norm1_w[l])
        z = xn @ w_in[l]
        att_cols, rw_cols = z[..., :D_ATT_COLS], z[..., D_ATT_COLS:]

        q, k, v, iq, ik, iw = _split_cols(att_cols, ATT_COL_SIZES)
        q = partial_rotary(rms_norm(q.reshape(B, T, N_ATT_HEADS, HEAD_DIM), q_norm_w[l]), positions)
        k = partial_rotary(rms_norm(k.reshape(B, T, N_ATT_HEADS, HEAD_DIM), k_norm_w[l]), positions)
        v = v.reshape(B, T, N_ATT_HEADS, HEAD_DIM)
        iq = partial_rotary(iq.reshape(B, T, N_IDX_HEADS, IDX_DIM), positions)
        ik = partial_rotary(ik, positions)
        att = dsa_sparse_attention(q, k, v, iq, ik, iw).reshape(B, T, D_ATT)

        rw_cols = token_shift(rw_cols, rwkv_mu[l])
        r, kr, vr, wd, ad, gd = _split_cols(rw_cols, RWKV_COL_SIZES)
        rw = rwkv7_time_mix(r, kr, vr, wd, ad, gd, rwkv_w0[l], rwkv_w2[l], rwkv_a0[l], rwkv_a2[l],
                            rwkv_g2[l], rwkv_k_k[l], rwkv_k_a[l], rwkv_r_k[l], rwkv_ln_w[l], rwkv_ln_b[l])

        h = h + jnp.concatenate([att, rw.astype(h.dtype)], axis=-1) @ w_out[l]

        h = h + moe_ffn(rms_norm(h, norm2_w[l]), router_w[l], router_b[l], exp_w_gu[l], exp_b_gu[l],
                        exp_w_down[l], exp_b_down[l]).astype(h.dtype)
    return h
```

```cpp
#include <hip/hip_runtime.h>
#include <hip/hip_bf16.h>
#include <hip/hip_fp16.h>
#include <hip/hip_cooperative_groups.h>
#include <stdint.h>
#include <stdio.h>
namespace cg = cooperative_groups;

typedef unsigned short u16;
typedef unsigned int u32;
using bf16x8 = __attribute__((ext_vector_type(8))) short;
using f32x4 = __attribute__((ext_vector_type(4))) float;
using f32x16 = __attribute__((ext_vector_type(16))) float;

constexpr int T = 16384, D = 1024, DIN = 3496, DINP = 3584;
constexpr int NCH = 64, CHL = T / NCH;
constexpr int NE = 32, DFF = 1024;
constexpr int ROWCAP = 73728;
constexpr int C_Q = 0, C_K = 512, C_V = 1024, C_IQ = 1536, C_IK = 1792, C_IW = 1824, C_RW = 1832;
constexpr int NTHREADS = 512;
constexpr int LDS_BYTES = 152 * 1024;

constexpr size_t SZ_WGUT = (size_t)NE * 2048 * 1024 * 2;
constexpr size_t SZ_WDNT = (size_t)NE * 1024 * 1024 * 2;
constexpr size_t SZ_WINT = (size_t)DINP * 1024 * 2;
constexpr size_t SZ_WOUTT = (size_t)1024 * 1024 * 2;
constexpr size_t SZ_XN = (size_t)T * 1024 * 2;
constexpr size_t SZ_Z = (size_t)T * DINP * 4;
constexpr size_t SZ_QKV = (size_t)T * 512 * 2;
constexpr size_t SZ_IQ = (size_t)T * 256 * 2;
constexpr size_t SZ_IK = (size_t)T * 32 * 2;
constexpr size_t SZ_IW = (size_t)T * 8 * 4;
constexpr size_t SZ_SV = (size_t)T * 8 * 384 * 4;
constexpr size_t SZ_G = (size_t)T * 512 * 4;
constexpr size_t SZ_BONUS = (size_t)T * 8 * 4;
constexpr size_t SZ_Y = (size_t)T * 512 * 4;
constexpr size_t SZ_SMAT = (size_t)8 * NCH * 4096 * 4;
constexpr size_t SZ_SEL = (size_t)T * 256 * 2;
constexpr size_t SZ_MIX = (size_t)T * 1024 * 2;
constexpr size_t SZ_H1 = (size_t)T * 1024 * 4;
constexpr size_t SZ_TOK = (size_t)T * 4 * 4;
constexpr size_t SZ_ROWTOK = (size_t)ROWCAP * 4;

constexpr size_t OFF_WGUT = 0;
constexpr size_t OFF_WDNT = OFF_WGUT + SZ_WGUT;
constexpr size_t OFF_WINT = OFF_WDNT + SZ_WDNT;
constexpr size_t OFF_WOUTT = OFF_WINT + SZ_WINT;
constexpr size_t OFF_XN = OFF_WOUTT + SZ_WOUTT;
constexpr size_t OFF_Z = OFF_XN + SZ_XN;
constexpr size_t OFF_QR = OFF_Z + SZ_Z;
constexpr size_t OFF_KR = OFF_QR + SZ_QKV;
constexpr size_t OFF_VV = OFF_KR + SZ_QKV;
constexpr size_t OFF_IQ = OFF_VV + SZ_QKV;
constexpr size_t OFF_IK = OFF_IQ + SZ_IQ;
constexpr size_t OFF_IW = OFF_IK + SZ_IK;
constexpr size_t OFF_SV = OFF_IW + SZ_IW;
constexpr size_t OFF_G = OFF_SV + SZ_SV;
constexpr size_t OFF_BONUS = OFF_G + SZ_G;
constexpr size_t OFF_Y = OFF_BONUS + SZ_BONUS;
constexpr size_t OFF_SP = OFF_Y + SZ_Y;
constexpr size_t OFF_SL = OFF_SP + SZ_SMAT;
constexpr size_t OFF_SI = OFF_SL + SZ_SMAT;
constexpr size_t OFF_SEL = OFF_SI + SZ_SMAT;
constexpr size_t OFF_MIX = OFF_SEL + SZ_SEL;
constexpr size_t OFF_H1 = OFF_MIX + SZ_MIX;
constexpr size_t OFF_TOKE = OFF_H1 + SZ_H1;
constexpr size_t OFF_TOKG = OFF_TOKE + SZ_TOK;
constexpr size_t OFF_TOKP = OFF_TOKG + SZ_TOK;
constexpr size_t OFF_ROWTOK = OFF_TOKP + SZ_TOK;
constexpr size_t OFF_CNT = OFF_ROWTOK + SZ_ROWTOK;
constexpr size_t WS_NEEDED = OFF_CNT + 4096;

struct Params {
  const float* x; const int* positions; const float* norm1_w; const float* w_in;
  const float* q_norm_w; const float* k_norm_w; const float* rwkv_mu; const float* rwkv_w0;
  const float* rwkv_w2; const float* rwkv_a0; const float* rwkv_a2; const float* rwkv_g2;
  const float* rwkv_k_k; const float* rwkv_k_a; const float* rwkv_r_k; const float* rwkv_ln_w;
  const float* rwkv_ln_b; const float* w_out; const float* norm2_w; const float* router_w;
  const float* router_b; const float* exp_w_gu; const float* exp_b_gu; const float* exp_w_down;
  const float* exp_b_down;
  float* out;
  char* ws;
};

__device__ __forceinline__ u16 f2bf(float f) {
  u32 u = __float_as_uint(f);
  u += 0x7FFFu + ((u >> 16) & 1u);
  return (u16)(u >> 16);
}
__device__ __forceinline__ float bf2f(u16 h) { return __uint_as_float(((u32)h) << 16); }
__device__ __forceinline__ u32 pack2bf(float a, float b) { return (u32)f2bf(a) | ((u32)f2bf(b) << 16); }
__device__ __forceinline__ float wave_sum(float v) {
#pragma unroll
  for (int o = 32; o >= 1; o >>= 1) v += __shfl_xor(v, o);
  return v;
}
__device__ __forceinline__ float sigmoidf_(float x) { return 1.f / (1.f + __expf(-x)); }

__device__ __forceinline__ void sincos_big(float ang, float& s, float& c) {
  double a = (double)ang * 0.15915494309189535;
  double r = a - rint(a);
  float rf = (float)r;
  s = __builtin_amdgcn_sinf(rf);
  c = __builtin_amdgcn_cosf(rf);
}

__device__ void phase_init(const Params& p) {
  int* cnt = (int*)(p.ws + OFF_CNT);
  int* rowtok = (int*)(p.ws + OFF_ROWTOK);
  int gtid = blockIdx.x * NTHREADS + threadIdx.x;
  int gsz = gridDim.x * NTHREADS;
  if (gtid < 64) cnt[gtid] = 0;
  for (int i = gtid; i < ROWCAP; i += gsz) rowtok[i] = -1;
}

__device__ void transpose_convert(const float* src, u16* dst, int R, int C, int Cpad, int nbatch, char* smem) {
  float* tile = (float*)smem;
  int tr = R / 64, tc = Cpad / 64;
  int ntile = tr * tc * nbatch;
  int tid = threadIdx.x;
  for (int id = blockIdx.x; id < ntile; id += gridDim.x) {
    int b = id / (tr * tc), rem = id % (tr * tc);
    int r0 = (rem / tc) * 64, c0 = (rem % tc) * 64;
    const float* s = src + (size_t)b * R * C;
    u16* d = dst + (size_t)b * Cpad * R;
#pragma unroll
    for (int i = 0; i < 8; ++i) {
      int r = (tid >> 6) + 8 * i, c = tid & 63;
      float v = (c0 + c < C) ? s[(size_t)(r0 + r) * C + c0 + c] : 0.f;
      tile[r * 65 + c] = v;
    }
    __syncthreads();
    {
      int cc = tid >> 3, rg = tid & 7;
      u32 w[4];
#pragma unroll
      for (int i = 0; i < 4; ++i) w[i] = pack2bf(tile[(rg * 8 + 2 * i) * 65 + cc], tile[(rg * 8 + 2 * i + 1) * 65 + cc]);
      uint4 o; o.x = w[0]; o.y = w[1]; o.z = w[2]; o.w = w[3];
      *(uint4*)(d + (size_t)(c0 + cc) * R + r0 + rg * 8) = o;
    }
    __syncthreads();
  }
}

__device__ void phase_norm1(const Params& p) {
  u16* xn = (u16*)(p.ws + OFF_XN);
  int lane = threadIdx.x & 63, wid = threadIdx.x >> 6;
  int gw = blockIdx.x * 8 + wid, nw = gridDim.x * 8;
  for (int t = gw; t < T; t += nw) {
    const float4* xr = (const float4*)(p.x + (size_t)t * D);
    float4 v[4]; float ss = 0.f;
#pragma unroll
    for (int i = 0; i < 4; ++i) { v[i] = xr[lane + 64 * i]; ss += v[i].x * v[i].x + v[i].y * v[i].y + v[i].z * v[i].z + v[i].w * v[i].w; }
    ss = wave_sum(ss);
    float rstd = rsqrtf(ss * (1.f / D) + 1e-6f);
#pragma unroll
    for (int i = 0; i < 4; ++i) {
      float4 w = ((const float4*)p.norm1_w)[lane + 64 * i];
      uint2 o; o.x = pack2bf(v[i].x * rstd * w.x, v[i].y * rstd * w.y); o.y = pack2bf(v[i].z * rstd * w.z, v[i].w * rstd * w.w);
      *(uint2*)(xn + (size_t)t * D + (lane + 64 * i) * 4) = o;
    }
  }
}

enum { EPI_Z = 0, EPI_H1 = 1, EPI_GU = 2, EPI_DN = 3 };

struct GemmTile {
  const u16* A; int lda;
  const int* rowtok;
  int rowbase;
  const u16* Bt;
  int K; int n0;
  float* outf; u16* outh; const float* resid; const float* bias; int ldo;
};

template <int EPI, bool GATHER>
__device__ void gemm_tile(const GemmTile& g, char* smem) {
  const int tid = threadIdx.x, lane = tid & 63, wid = tid >> 6;
  const int wr = wid >> 1, wc = wid & 1, fr = lane & 15, fq = lane >> 4;
  const int K = g.K;
  const int ldrow = tid >> 3, ldc = tid & 7;
  const u16* ap[4]; bool aval[4];
#pragma unroll
  for (int i = 0; i < 4; ++i) {
    int r = g.rowbase + ldrow + 64 * i;
    if (GATHER) { int tk = g.rowtok[r]; aval[i] = tk >= 0; ap[i] = g.A + (size_t)(tk < 0 ? 0 : tk) * g.lda + ldc * 8; }
    else { aval[i] = true; ap[i] = g.A + (size_t)r * g.lda + ldc * 8; }
  }
  const u16* bp[2];
#pragma unroll
  for (int i = 0; i < 2; ++i) {
    int j = ldrow + 64 * i;
    int br = (EPI == EPI_GU) ? (((j >> 5) & 1) * 1024 + g.n0 + (j >> 6) * 32 + (j & 31)) : (g.n0 + j);
    bp[i] = g.Bt + (size_t)br * K + ldc * 8;
  }
  const int swz = ((ldc ^ (ldrow & 7)) << 4);
  uint4 ra[4], rb[2];
  auto gload = [&](int kt) {
#pragma unroll
    for (int i = 0; i < 4; ++i) { ra[i] = aval[i] ? *(const uint4*)(ap[i] + kt * 64) : make_uint4(0, 0, 0, 0); }
#pragma unroll
    for (int i = 0; i < 2; ++i) rb[i] = *(const uint4*)(bp[i] + kt * 64);
  };
  auto lwrite = [&](int buf) {
#pragma unroll
    for (int i = 0; i < 4; ++i) *(uint4*)(smem + buf * 49152 + (ldrow + 64 * i) * 128 + swz) = ra[i];
#pragma unroll
    for (int i = 0; i < 2; ++i) *(uint4*)(smem + buf * 49152 + 32768 + (ldrow + 64 * i) * 128 + swz) = rb[i];
  };
  f32x4 acc[4][4];
#pragma unroll
  for (int m = 0; m < 4; ++m)
#pragma unroll
    for (int n = 0; n < 4; ++n) acc[m][n] = (f32x4){0.f, 0.f, 0.f, 0.f};
  const int nk = K / 64;
  gload(0);
  lwrite(0);
  __syncthreads();
  for (int kt = 0; kt < nk; ++kt) {
    const int cur = kt & 1;
    if (kt + 1 < nk) gload(kt + 1);
#pragma unroll
    for (int kk = 0; kk < 2; ++kk) {
      bf16x8 af[4], bfr[4];
      const int cs = (((kk * 4 + fq) ^ (fr & 7)) << 4);
#pragma unroll
      for (int m = 0; m < 4; ++m) af[m] = *(const bf16x8*)(smem + cur * 49152 + (wr * 64 + m * 16 + fr) * 128 + cs);
#pragma unroll
      for (int n = 0; n < 4; ++n) bfr[n] = *(const bf16x8*)(smem + cur * 49152 + 32768 + (wc * 64 + n * 16 + fr) * 128 + cs);
#pragma unroll
      for (int m = 0; m < 4; ++m)
#pragma unroll
        for (int n = 0; n < 4; ++n) acc[m][n] = __builtin_amdgcn_mfma_f32_16x16x32_bf16(af[m], bfr[n], acc[m][n], 0, 0, 0);
    }
    if (kt + 1 < nk) lwrite(cur ^ 1);
    __syncthreads();
  }
#pragma unroll
  for (int m = 0; m < 4; ++m) {
#pragma unroll
    for (int j = 0; j < 4; ++j) {
      const int row = g.rowbase + wr * 64 + m * 16 + fq * 4 + j;
      if (EPI == EPI_Z) {
#pragma unroll
        for (int n = 0; n < 4; ++n) g.outf[(size_t)row * g.ldo + g.n0 + wc * 64 + n * 16 + fr] = acc[m][n][j];
      } else if (EPI == EPI_H1) {
#pragma unroll
        for (int n = 0; n < 4; ++n) {
          size_t o = (size_t)row * g.ldo + g.n0 + wc * 64 + n * 16 + fr;
          g.outf[o] = g.resid[o] + acc[m][n][j];
        }
      } else if (EPI == EPI_GU) {
#pragma unroll
        for (int n = 0; n < 2; ++n) {
          const int col = g.n0 + wc * 32 + n * 16 + fr;
          float glu = acc[m][n][j] + g.bias[col];
          float lin = acc[m][n + 2][j] + g.bias[1024 + col];
          glu = fminf(glu, 7.f);
          lin = fminf(fmaxf(lin, -7.f), 7.f);
          float a = (lin + 1.f) * glu * sigmoidf_(1.702f * glu);
          g.outh[(size_t)row * g.ldo + col] = f2bf(a);
        }
      } else {
#pragma unroll
        for (int n = 0; n < 4; ++n) {
          const int col = g.n0 + wc * 64 + n * 16 + fr;
          g.outh[(size_t)row * g.ldo + col] = f2bf(acc[m][n][j] + g.bias[col]);
        }
      }
    }
  }
}

__device__ void phase_gemm_in(const Params& p, char* smem) {
  GemmTile g{};
  g.A = (const u16*)(p.ws + OFF_XN); g.lda = D; g.rowtok = nullptr;
  g.Bt = (const u16*)(p.ws + OFF_WINT); g.K = D;
  g.outf = (float*)(p.ws + OFF_Z); g.ldo = DINP;
  constexpr int NT = DINP / 128, MT = T / 256;
  for (int id = blockIdx.x; id < NT * MT; id += gridDim.x) {
    g.rowbase = (id / NT) * 256; g.n0 = (id % NT) * 128;
    gemm_tile<EPI_Z, false>(g, smem);
  }
}

__device__ void phase_post_attn(const Params& p) {
  const float* z = (const float*)(p.ws + OFF_Z);
  u16* qr = (u16*)(p.ws + OFF_QR); u16* kr = (u16*)(p.ws + OFF_KR); u16* vv = (u16*)(p.ws + OFF_VV);
  u16* iq = (u16*)(p.ws + OFF_IQ); u16* ik = (u16*)(p.ws + OFF_IK); float* iw = (float*)(p.ws + OFF_IW);
  const float INVF8[8] = {1.0f, 0.1939227432012558f, 0.03760603070259094f, 0.007292664609849453f,
                          0.0014142135623842478f, 0.00027424818836152554f, 5.318296098266728e-05f, 1.0313386155758053e-05f};
  const float INVF4[4] = {1.0f, 0.03760603070259094f, 0.0014142135623842478f, 5.318296098266728e-05f};
  int lane = threadIdx.x & 63, wid = threadIdx.x >> 6;
  int gw = blockIdx.x * 8 + wid, nw = gridDim.x * 8;
  const int sub = lane & 7;
  for (int t = gw; t < T; t += nw) {
    const float* zr = z + (size_t)t * DINP;
    const float pos = (float)p.positions[t];
    float cs8[8], sn8[8];
#pragma unroll
    for (int i = 0; i < 8; ++i) sincos_big(pos * INVF8[i], sn8[i], cs8[i]);
#pragma unroll
    for (int which = 0; which < 2; ++which) {
      const float* src = zr + (which ? C_K : C_Q) + lane * 8;
      const float* nw_ = (which ? p.k_norm_w : p.q_norm_w) + sub * 8;
      float4 a = *(const float4*)src, b = *(const float4*)(src + 4);
      float v[8] = {a.x, a.y, a.z, a.w, b.x, b.y, b.z, b.w};
      float ss = 0.f;
#pragma unroll
      for (int i = 0; i < 8; ++i) ss += v[i] * v[i];
      ss += __shfl_xor(ss, 1); ss += __shfl_xor(ss, 2); ss += __shfl_xor(ss, 4);
      float rstd = rsqrtf(ss * (1.f / 64.f) + 1e-6f);
      float y[8], o[8];
#pragma unroll
      for (int i = 0; i < 8; ++i) y[i] = v[i] * rstd * nw_[i];
#pragma unroll
      for (int i = 0; i < 8; ++i) {
        float oth = __shfl_xor(y[i], 1);
        float r0 = y[i] * cs8[i] - oth * sn8[i];
        float r1 = y[i] * cs8[i] + oth * sn8[i];
        o[i] = (sub == 0) ? r0 : ((sub == 1) ? r1 : y[i]);
      }
      const float sc = which ? 1.f : (0.125f * 1.4426950408889634f);
      uint4 w; w.x = pack2bf(o[0] * sc, o[1] * sc); w.y = pack2bf(o[2] * sc, o[3] * sc); w.z = pack2bf(o[4] * sc, o[5] * sc); w.w = pack2bf(o[6] * sc, o[7] * sc);
      *(uint4*)((which ? kr : qr) + (size_t)t * 512 + lane * 8) = w;
    }
    {
      const float* src = zr + C_V + lane * 8;
      float4 a = *(const float4*)src, b = *(const float4*)(src + 4);
      uint4 w; w.x = pack2bf(a.x, a.y); w.y = pack2bf(a.z, a.w); w.z = pack2bf(b.x, b.y); w.w = pack2bf(b.z, b.w);
      *(uint4*)(vv + (size_t)t * 512 + lane * 8) = w;
    }
    float cs4[4], sn4[4];
#pragma unroll
    for (int i = 0; i < 4; ++i) sincos_big(pos * INVF4[i], sn4[i], cs4[i]);
    {
      float4 a = *(const float4*)(zr + C_IQ + lane * 4);
      float y[4] = {a.x, a.y, a.z, a.w}, o[4];
#pragma unroll
      for (int i = 0; i < 4; ++i) {
        float oth = __shfl_xor(y[i], 1);
        float r0 = y[i] * cs4[i] - oth * sn4[i];
        float r1 = y[i] * cs4[i] + oth * sn4[i];
        o[i] = (sub == 0) ? r0 : ((sub == 1) ? r1 : y[i]);
      }
      uint2 w; w.x = pack2bf(o[0], o[1]); w.y = pack2bf(o[2], o[3]);
      *(uint2*)(iq + (size_t)t * 256 + lane * 4) = w;
    }
    {
      float4 a = (lane < 8) ? *(const float4*)(zr + C_IK + lane * 4) : make_float4(0, 0, 0, 0);
      float y[4] = {a.x, a.y, a.z, a.w}, o[4];
#pragma unroll
      for (int i = 0; i < 4; ++i) {
        float oth = __shfl_xor(y[i], 1);
        float r0 = y[i] * cs4[i] - oth * sn4[i];
        float r1 = y[i] * cs4[i] + oth * sn4[i];
        o[i] = (sub == 0) ? r0 : ((sub == 1) ? r1 : y[i]);
      }
      if (lane < 8) {
        uint2 w; w.x = pack2bf(o[0], o[1]); w.y = pack2bf(o[2], o[3]);
        *(uint2*)(ik + (size_t)t * 32 + lane * 4) = w;
        iw[(size_t)t * 8 + lane] = zr[C_IW + lane];
      }
    }
  }
}

__device__ void phase_post_rwkv(const Params& p, char* smem) {
  const float* z = (const float*)(p.ws + OFF_Z);
  float* sv = (float*)(p.ws + OFF_SV); float* G = (float*)(p.ws + OFF_G); float* BON = (float*)(p.ws + OFF_BONUS);
  float* lora = (float*)smem;
  const int tid = threadIdx.x, lane = tid & 63, h = tid >> 6, c = tid;
  const float mu_r = p.rwkv_mu[c], mu_k = p.rwkv_mu[512 + c], mu_v = p.rwkv_mu[1024 + c];
  const float w0 = p.rwkv_w0[c], a0 = p.rwkv_a0[c], kkw = p.rwkv_k_k[c], kaw = p.rwkv_k_a[c], rkw = p.rwkv_r_k[c];
  for (int tg = blockIdx.x; tg < T / 8; tg += gridDim.x) {
    const int t0 = tg * 8;
#pragma unroll
    for (int i = 0; i < 2; ++i) {
      int item = tid + 512 * i, tok = item >> 7, j = item & 127, t = t0 + tok;
      int col = C_RW + 1536 + j;
      float zc = z[(size_t)t * DINP + col];
      float zp = (t > 0) ? z[(size_t)(t - 1) * DINP + col] : 0.f;
      float xs = zc + (zp - zc) * p.rwkv_mu[1536 + j];
      float o = (j < 32) ? tanhf(xs) : ((j < 64) ? xs : sigmoidf_(xs));
      lora[tok * 128 + j] = o;
    }
    __syncthreads();
    float aw[8], aa[8], ag[8];
#pragma unroll
    for (int k = 0; k < 8; ++k) { aw[k] = 0.f; aa[k] = 0.f; ag[k] = 0.f; }
    for (int j = 0; j < 32; ++j) {
      float w = p.rwkv_w2[j * 512 + c], a = p.rwkv_a2[j * 512 + c];
#pragma unroll
      for (int k = 0; k < 8; ++k) { aw[k] += lora[k * 128 + j] * w; aa[k] += lora[k * 128 + 32 + j] * a; }
    }
    for (int j = 0; j < 64; ++j) {
      float gg = p.rwkv_g2[j * 512 + c];
#pragma unroll
      for (int k = 0; k < 8; ++k) ag[k] += lora[k * 128 + 64 + j] * gg;
    }
#pragma unroll
    for (int k = 0; k < 8; ++k) {
      const int t = t0 + k;
      const float* zr = z + (size_t)t * DINP + C_RW;
      const float* zq = zr - DINP;
      float rc = zr[c], kc = zr[512 + c], vc = zr[1024 + c];
      float rp = 0.f, kp = 0.f, vp = 0.f;
      if (t > 0) { rp = zq[c]; kp = zq[512 + c]; vp = zq[1024 + c]; }
      float r = rc + (rp - rc) * mu_r, kx = kc + (kp - kc) * mu_k, v = vc + (vp - vc) * mu_v;
      float xw = -(w0 + aw[k]);
      float sp = fmaxf(xw, 0.f) + log1pf(__expf(-fabsf(xw)));
      float logw = -sp - 0.5f;
      float decay = __expf(-__expf(logw));
      float a = sigmoidf_(a0 + aa[k]);
      float kk = kx * kkw;
      float ss = wave_sum(kk * kk);
      kk *= rsqrtf(fmaxf(ss, 1e-24f));
      float kmod = kx * (1.f + (a - 1.f) * kaw);
      float bon = wave_sum(r * kmod * rkw);
      float* o = sv + ((size_t)t * 8 + h) * 384 + lane;
      o[0] = decay; o[64] = kk; o[128] = kk * a; o[192] = kmod; o[256] = r; o[320] = v;
      G[(size_t)t * 512 + c] = ag[k];
      if (lane == 0) BON[(size_t)t * 8 + h] = bon;
    }
    __syncthreads();
  }
}

template <int MODE>
__device__ void scan_task(const Params& p, int h, int c, float* wl  ) {
  const int lane = threadIdx.x & 63;
  const float* sv = (const float*)(p.ws + OFF_SV);
  float S[64];
  if (MODE == 0) {
#pragma unroll
    for (int j = 0; j < 64; ++j) S[j] = (j == lane) ? 1.f : 0.f;
  } else if (MODE == 1) {
#pragma unroll
    for (int j = 0; j < 64; ++j) S[j] = 0.f;
  } else {
    const float4* si = (const float4*)((const float*)(p.ws + OFF_SI) + ((size_t)(h * NCH + c) * 64 + lane) * 64);
#pragma unroll
    for (int j = 0; j < 16; ++j) { float4 v = si[j]; S[4 * j] = v.x; S[4 * j + 1] = v.y; S[4 * j + 2] = v.z; S[4 * j + 3] = v.w; }
  }
  float* Y = (float*)(p.ws + OFF_Y);
  const float* src = sv + ((size_t)(c * CHL) * 8 + h) * 384;
  const int f0 = lane, f1 = lane + 64, f2 = lane + 128, f3 = lane + 192, f4 = lane + 256, f5 = lane + 320;
  const int go0 = (f0 / 96) * 3072 + (f0 % 96) * 4, go1 = (f1 / 96) * 3072 + (f1 % 96) * 4, go2 = (f2 / 96) * 3072 + (f2 % 96) * 4;
  const int go3 = (f3 / 96) * 3072 + (f3 % 96) * 4, go4 = (f4 / 96) * 3072 + (f4 % 96) * 4, go5 = (f5 / 96) * 3072 + (f5 % 96) * 4;
#define SCAN_GLOAD(base) do { rg0 = *(const float4*)((base) + go0); rg1 = *(const float4*)((base) + go1); rg2 = *(const float4*)((base) + go2); \
    rg3 = *(const float4*)((base) + go3); rg4 = *(const float4*)((base) + go4); rg5 = *(const float4*)((base) + go5); } while (0)
#define SCAN_LWRITE(dst) do { *(float4*)((dst) + f0 * 4) = rg0; *(float4*)((dst) + f1 * 4) = rg1; *(float4*)((dst) + f2 * 4) = rg2; \
    *(float4*)((dst) + f3 * 4) = rg3; *(float4*)((dst) + f4 * 4) = rg4; *(float4*)((dst) + f5 * 4) = rg5; } while (0)
  float4 rg0, rg1, rg2, rg3, rg4, rg5;
  SCAN_GLOAD(src);
  SCAN_LWRITE(wl);
  constexpr int NG = CHL / 4;
  for (int g = 0; g < NG; ++g) {
    if (g + 1 < NG) SCAN_GLOAD(src + (size_t)(g + 1) * 4 * 3072);
    const float* Lb = wl + (g & 1) * 1536;
#pragma unroll 1
    for (int st = 0; st < 4; ++st) {
      const float4* pv = (const float4*)(Lb + st * 384);
      float sa0 = 0.f, sa1 = 0.f, sa2 = 0.f, sa3 = 0.f;
#pragma unroll
      for (int j = 0; j < 16; ++j) {
        float4 k4 = pv[16 + j];
        sa0 += S[4 * j] * k4.x; sa1 += S[4 * j + 1] * k4.y; sa2 += S[4 * j + 2] * k4.z; sa3 += S[4 * j + 3] * k4.w;
      }
      const float nsa = -((sa0 + sa1) + (sa2 + sa3));
      float vi = 0.f;
      if (MODE != 0) vi = Lb[st * 384 + 320 + lane];
#pragma unroll
      for (int j = 0; j < 16; ++j) {
        float4 w4 = pv[j], b4 = pv[32 + j];
        S[4 * j] = S[4 * j] * w4.x + nsa * b4.x; S[4 * j + 1] = S[4 * j + 1] * w4.y + nsa * b4.y;
        S[4 * j + 2] = S[4 * j + 2] * w4.z + nsa * b4.z; S[4 * j + 3] = S[4 * j + 3] * w4.w + nsa * b4.w;
        if (MODE != 0) {
          float4 k4 = pv[48 + j];
          S[4 * j] += vi * k4.x; S[4 * j + 1] += vi * k4.y; S[4 * j + 2] += vi * k4.z; S[4 * j + 3] += vi * k4.w;
        }
      }
      if (MODE == 2) {
        float y0 = 0.f, y1 = 0.f, y2 = 0.f, y3 = 0.f;
#pragma unroll
        for (int j = 0; j < 16; ++j) {
          float4 r4 = pv[64 + j];
          y0 += S[4 * j] * r4.x; y1 += S[4 * j + 1] * r4.y; y2 += S[4 * j + 2] * r4.z; y3 += S[4 * j + 3] * r4.w;
        }
        Y[(size_t)(c * CHL + g * 4 + st) * 512 + h * 64 + lane] = (y0 + y1) + (y2 + y3);
      }
    }
    if (g + 1 < NG) { float* Ln = wl + ((g + 1) & 1) * 1536; SCAN_LWRITE(Ln); }
  }
  if (MODE != 2) {
    float4* o = (float4*)((float*)(p.ws + (MODE == 0 ? OFF_SP : OFF_SL)) + ((size_t)(h * NCH + c) * 64 + lane) * 64);
#pragma unroll
    for (int j = 0; j < 16; ++j) o[j] = make_float4(S[4 * j], S[4 * j + 1], S[4 * j + 2], S[4 * j + 3]);
  }
}

__device__ void phase_scan_a(const Params& p, char* smem) {
  int wid = threadIdx.x >> 6;
  float* wl = (float*)smem + wid * 3072;
  int gw = blockIdx.x * 8 + wid, nw = gridDim.x * 8;
  for (int task = gw; task < 8 * NCH * 2; task += nw) {
    int which = task & 1, hc = task >> 1, h = hc % 8, c = hc / 8;
    if (which == 0) scan_task<0>(p, h, c, wl); else scan_task<1>(p, h, c, wl);
  }
}

__device__ void phase_scan_b_impl(const Params& p, char* smem) {
  const int h = blockIdx.x, tid = threadIdx.x;
  float* Ss = (float*)smem;
  float* Ps = Ss + 64 * 65;
  const float* SP = (const float*)(p.ws + OFF_SP) + (size_t)h * NCH * 4096;
  const float* SL = (const float*)(p.ws + OFF_SL) + (size_t)h * NCH * 4096;
  float* SI = (float*)(p.ws + OFF_SI) + (size_t)h * NCH * 4096;
  const int i = tid >> 3, jg = tid & 7;
  for (int e = tid; e < 4096; e += 512) { Ss[(e >> 6) * 65 + (e & 63)] = 0.f; SI[e] = 0.f; }
  for (int c = 0; c < NCH - 1; ++c) {
    for (int e = tid; e < 4096; e += 512) Ps[e] = SP[(size_t)c * 4096 + e];
    __syncthreads();
    float acc[8];
#pragma unroll
    for (int u = 0; u < 8; ++u) acc[u] = SL[(size_t)c * 4096 + i * 64 + jg * 8 + u];
    for (int k = 0; k < 64; ++k) {
      float s = Ss[i * 65 + k];
      float4 p0 = *(const float4*)(Ps + k * 64 + jg * 8), p1 = *(const float4*)(Ps + k * 64 + jg * 8 + 4);
      acc[0] += s * p0.x; acc[1] += s * p0.y; acc[2] += s * p0.z; acc[3] += s * p0.w;
      acc[4] += s * p1.x; acc[5] += s * p1.y; acc[6] += s * p1.z; acc[7] += s * p1.w;
    }
    __syncthreads();
#pragma unroll
    for (int u = 0; u < 8; ++u) { Ss[i * 65 + jg * 8 + u] = acc[u]; SI[(size_t)(c + 1) * 4096 + i * 64 + jg * 8 + u] = acc[u]; }
    __syncthreads();
  }
}

__device__ void phase_scan_b(const Params& p, char* smem) { if (blockIdx.x < 8) phase_scan_b_impl(p, smem); }

__device__ void phase_scan_c(const Params& p, char* smem) {
  int wid = threadIdx.x >> 6;
  float* wl = (float*)smem + wid * 3072;
  int gw = blockIdx.x * 8 + wid, nw = gridDim.x * 8;
  for (int task = gw; task < 8 * NCH; task += nw) scan_task<2>(p, task % 8, task / 8, wl);
}

__device__ void phase_rwkv_out(const Params& p) {
  const float* Y = (const float*)(p.ws + OFF_Y); const float* sv = (const float*)(p.ws + OFF_SV);
  const float* G = (const float*)(p.ws + OFF_G); const float* BON = (const float*)(p.ws + OFF_BONUS);
  u16* mix = (u16*)(p.ws + OFF_MIX);
  const int tid = threadIdx.x, lane = tid & 63, h = tid >> 6;
  const float lw = p.rwkv_ln_w[tid], lb = p.rwkv_ln_b[tid];
  for (int t = blockIdx.x; t < T; t += gridDim.x) {
    float y = Y[(size_t)t * 512 + tid];
    float mean = wave_sum(y) * (1.f / 64.f);
    float d = y - mean;
    float var = wave_sum(d * d) * (1.f / 64.f);
    float o = d * rsqrtf(var + 64e-5f) * lw + lb;
    float v = sv[((size_t)t * 8 + h) * 384 + 320 + lane];
    o = (o + BON[(size_t)t * 8 + h] * v) * G[(size_t)t * 512 + tid];
    mix[(size_t)t * 1024 + 512 + tid] = f2bf(o);
  }
}

__device__ __forceinline__ u16 score_key(float s) {
  s = fminf(fmaxf(s, -60000.f), 60000.f);
  u16 b = __half_as_ushort(__float2half_rn(s));
  return (b & 0x8000u) ? (u16)(~b) : (u16)(b | 0x8000u);
}

__device__ void topk_select(const u16* keys, u32* hq, u32* h2, int t, u16* selout, int lane) {
  const int n = t + 1;
  u32 ssum = 0;
#pragma unroll
  for (int d = 0; d < 16; ++d) { u32 v = hq[16 * lane + d]; ssum += (v & 0xFFFFu) + (v >> 16); }
  u32 suf = ssum;
#pragma unroll
  for (int off = 1; off < 64; off <<= 1) { u32 o = __shfl_down(suf, off); if (lane + off < 64) suf += o; }
  unsigned long long m = __ballot(suf >= 256u);
  const int Ls = 63 - __clzll(m);
  const u32 above = __shfl(suf, Ls) - __shfl(ssum, Ls);
  u32 c1 = 0;
  if (lane < 32) { u32 v = hq[16 * Ls + (lane >> 1)]; c1 = (lane & 1) ? (v >> 16) : (v & 0xFFFFu); }
  u32 suf2 = c1;
#pragma unroll
  for (int off = 1; off < 32; off <<= 1) { u32 o = __shfl_down(suf2, off); if (lane + off < 64) suf2 += o; }
  unsigned long long m2 = __ballot((lane < 32) && (above + suf2 >= 256u));
  const int js = 63 - __clzll(m2);
  const u32 Bs = (u32)(32 * Ls + js);
  const u32 cnt_above = above + __shfl(suf2, js) - __shfl(c1, js);
  const int niter = (n + 511) >> 9;
  for (int it = 0; it < niter; ++it) {
    const int base = it * 512 + lane * 8;
    uint4 kv = *(const uint4*)(keys + base);
    u32 w[4] = {kv.x, kv.y, kv.z, kv.w};
#pragma unroll
    for (int e = 0; e < 8; ++e) {
      u32 k = (w[e >> 1] >> ((e & 1) * 16)) & 0xFFFFu;
      if ((base + e < n) && ((k >> 5) == Bs)) atomicAdd(&h2[k & 31u], 1u);
    }
  }
  __threadfence_block();
  const u32 need = 256u - cnt_above;
  u32 c2 = (lane < 32) ? h2[lane] : 0u;
  u32 suf3 = c2;
#pragma unroll
  for (int off = 1; off < 32; off <<= 1) { u32 o = __shfl_down(suf3, off); if (lane + off < 64) suf3 += o; }
  unsigned long long m3 = __ballot((lane < 32) && (suf3 >= need));
  const int vs = 63 - __clzll(m3);
  const u32 Kstar = (Bs << 5) | (u32)vs;
  const u32 cnt_gt = cnt_above + __shfl(suf3, vs) - __shfl(c2, vs);
  const u32 need_eq = 256u - cnt_gt;
  u32 base_gt = 0, base_eq = 0;
  for (int it = 0; it < niter; ++it) {
    const int base = it * 512 + lane * 8;
    uint4 kv = *(const uint4*)(keys + base);
    u32 w[4] = {kv.x, kv.y, kv.z, kv.w};
    u32 gtm = 0, eqm = 0;
#pragma unroll
    for (int e = 0; e < 8; ++e) {
      u32 k = (w[e >> 1] >> ((e & 1) * 16)) & 0xFFFFu;
      bool valid = (base + e < n);
      if (valid && k > Kstar) gtm |= (1u << e);
      if (valid && k == Kstar) eqm |= (1u << e);
    }
    u32 packed = __popc(gtm) | (__popc(eqm) << 16);
    u32 incl = packed;
#pragma unroll
    for (int off = 1; off < 64; off <<= 1) { u32 o = __shfl_up(incl, off); if (lane >= off) incl += o; }
    u32 excl = incl - packed;
    u32 tot = __shfl(incl, 63);
    u32 gb = base_gt + (excl & 0xFFFFu), eb = base_eq + (excl >> 16);
#pragma unroll
    for (int e = 0; e < 8; ++e) {
      u32 bit = 1u << e;
      u32 g_before = gb + __popc(gtm & (bit - 1u));
      u32 e_before = eb + __popc(eqm & (bit - 1u));
      if (gtm & bit) selout[g_before + min(e_before, need_eq)] = (u16)(base + e);
      else if ((eqm & bit) && e_before < need_eq) selout[g_before + e_before] = (u16)(base + e);
    }
    base_gt += tot & 0xFFFFu; base_eq += tot >> 16;
  }
}

__device__ void phase_topk(const Params& p, char* smem) {
  u16* keys = (u16*)smem;
  u32* hist = (u32*)(smem + 131072);
  u32* hist2 = hist + 4096;
  const u16* iq = (const u16*)(p.ws + OFF_IQ); const u16* ik = (const u16*)(p.ws + OFF_IK);
  const float* iw = (const float*)(p.ws + OFF_IW);
  u16* sel = (u16*)(p.ws + OFF_SEL);
  const int tid = threadIdx.x, lane = tid & 63, wid = tid >> 6;
  const int r = lane & 31, hh = lane >> 5;
  const int ngroups = (T - 256) / 4;
  const int nrounds = (ngroups + gridDim.x - 1) / gridDim.x;
  for (int rr = 0; rr < nrounds; ++rr) {
    const int gsel = rr * gridDim.x + ((rr & 1) ? (gridDim.x - 1 - blockIdx.x) : blockIdx.x);
    if (gsel >= ngroups) continue;
    const int t0 = 256 + gsel * 4;
    for (int i = tid; i < 4096 + 128; i += NTHREADS) hist[i] = 0u;
    __syncthreads();
    const u16* iqp = iq + ((size_t)(t0 + (r & 3)) * 8 + (r >> 2)) * 32 + 8 * hh;
    const bf16x8 a0 = *(const bf16x8*)iqp, a1 = *(const bf16x8*)(iqp + 16);
    float wq[16];
#pragma unroll
    for (int i = 0; i < 16; ++i) wq[i] = iw[(size_t)(t0 + (i & 3)) * 8 + 2 * (i >> 2) + hh];
    const int ntiles = (t0 + 4 + 31) >> 5;
    for (int kt = wid; kt < ntiles; kt += 8) {
      const int key = kt * 32 + r;
      const u16* ikp = ik + (size_t)key * 32 + 8 * hh;
      const bf16x8 b0 = *(const bf16x8*)ikp, b1 = *(const bf16x8*)(ikp + 16);
      f32x16 acc;
#pragma unroll
      for (int i = 0; i < 16; ++i) acc[i] = 0.f;
      acc = __builtin_amdgcn_mfma_f32_32x32x16_bf16(a0, b0, acc, 0, 0, 0);
      acc = __builtin_amdgcn_mfma_f32_32x32x16_bf16(a1, b1, acc, 0, 0, 0);
      float s0 = 0.f, s1 = 0.f, s2 = 0.f, s3 = 0.f;
#pragma unroll
      for (int i = 0; i < 16; i += 4) {
        s0 += wq[i] * fmaxf(acc[i], 0.f); s1 += wq[i + 1] * fmaxf(acc[i + 1], 0.f);
        s2 += wq[i + 2] * fmaxf(acc[i + 2], 0.f); s3 += wq[i + 3] * fmaxf(acc[i + 3], 0.f);
      }
      s0 += __shfl_xor(s0, 32); s1 += __shfl_xor(s1, 32); s2 += __shfl_xor(s2, 32); s3 += __shfl_xor(s3, 32);
      const float sa = hh ? s2 : s0, sb = hh ? s3 : s1;
      const int qa = hh * 2, qb = hh * 2 + 1;
      {
        bool valid = key <= t0 + qa;
        u16 k16 = valid ? score_key(sa) : (u16)0;
        keys[qa * 16384 + key] = k16;
        if (valid) { u32 bin = k16 >> 5; atomicAdd(&hist[qa * 1024 + (bin >> 1)], (bin & 1u) ? 0x10000u : 1u); }
      }
      {
        bool valid = key <= t0 + qb;
        u16 k16 = valid ? score_key(sb) : (u16)0;
        keys[qb * 16384 + key] = k16;
        if (valid) { u32 bin = k16 >> 5; atomicAdd(&hist[qb * 1024 + (bin >> 1)], (bin & 1u) ? 0x10000u : 1u); }
      }
    }
    __syncthreads();
    if (wid < 4) topk_select(keys + wid * 16384, hist + wid * 1024, hist2 + wid * 32, t0 + wid, sel + (size_t)(t0 + wid) * 256, lane);
    __syncthreads();
  }
}

__device__ void phase_attn(const Params& p) {
  const u16* qr = (const u16*)(p.ws + OFF_QR); const u16* kr = (const u16*)(p.ws + OFF_KR); const u16* vv = (const u16*)(p.ws + OFF_VV);
  const u16* sel = (const u16*)(p.ws + OFF_SEL);
  u16* mix = (u16*)(p.ws + OFF_MIX);
  const int lane = threadIdx.x & 63, wid = threadIdx.x >> 6;
  const int gw = blockIdx.x * 8 + wid, nw = gridDim.x * 8;
  for (int ti = gw; ti < T; ti += nw) {
    const int t = ti;
    const int nsel = (t + 1 < 256) ? (t + 1) : 256;
    int myidx[4];
#pragma unroll
    for (int m = 0; m < 4; ++m) {
      int pos = lane + 64 * m;
      myidx[m] = (pos < nsel) ? ((t < 256) ? pos : (int)sel[(size_t)t * 256 + pos]) : 0;
    }
    float q[8];
    {
      uint4 w = *(const uint4*)(qr + (size_t)t * 512 + lane * 8);
      u32 ww[4] = {w.x, w.y, w.z, w.w};
#pragma unroll
      for (int i = 0; i < 4; ++i) { q[2 * i] = __uint_as_float(ww[i] << 16); q[2 * i + 1] = __uint_as_float(ww[i] & 0xFFFF0000u); }
    }
    float mrun = -INFINITY, lrun = 0.f, acc[8];
#pragma unroll
    for (int i = 0; i < 8; ++i) acc[i] = 0.f;
#pragma unroll
    for (int m = 0; m < 4; ++m) {
      if (m * 64 < nsel) {
        for (int jj = 0; jj < 64; jj += 4) {
          if (m * 64 + jj >= nsel) break;
          float sc[4]; uint4 vrow[4];
#pragma unroll
          for (int u = 0; u < 4; ++u) {
            const int idx = __shfl(myidx[m], jj + u);
            uint4 kw = *(const uint4*)(kr + (size_t)idx * 512 + lane * 8);
            vrow[u] = *(const uint4*)(vv + (size_t)idx * 512 + lane * 8);
            u32 ww[4] = {kw.x, kw.y, kw.z, kw.w};
            float d = 0.f;
#pragma unroll
            for (int i = 0; i < 4; ++i) { d += q[2 * i] * __uint_as_float(ww[i] << 16); d += q[2 * i + 1] * __uint_as_float(ww[i] & 0xFFFF0000u); }
            d += __shfl_xor(d, 1); d += __shfl_xor(d, 2); d += __shfl_xor(d, 4);
            sc[u] = (m * 64 + jj + u < nsel) ? d : -INFINITY;
          }
          float mnew = fmaxf(fmaxf(fmaxf(sc[0], sc[1]), fmaxf(sc[2], sc[3])), mrun);
          float corr = exp2f(mrun - mnew);
          lrun *= corr;
#pragma unroll
          for (int i = 0; i < 8; ++i) acc[i] *= corr;
#pragma unroll
          for (int u = 0; u < 4; ++u) {
            float pu = exp2f(sc[u] - mnew);
            lrun += pu;
            u32 ww[4] = {vrow[u].x, vrow[u].y, vrow[u].z, vrow[u].w};
#pragma unroll
            for (int i = 0; i < 4; ++i) { acc[2 * i] += pu * __uint_as_float(ww[i] << 16); acc[2 * i + 1] += pu * __uint_as_float(ww[i] & 0xFFFF0000u); }
          }
          mrun = mnew;
        }
      }
    }
    const float inv = 1.f / lrun;
    uint4 o; o.x = pack2bf(acc[0] * inv, acc[1] * inv); o.y = pack2bf(acc[2] * inv, acc[3] * inv);
    o.z = pack2bf(acc[4] * inv, acc[5] * inv); o.w = pack2bf(acc[6] * inv, acc[7] * inv);
    *(uint4*)(mix + (size_t)t * 1024 + lane * 8) = o;
  }
}

__device__ void phase_gemm_out(const Params& p, char* smem) {
  GemmTile g{};
  g.A = (const u16*)(p.ws + OFF_MIX); g.lda = 1024; g.rowtok = nullptr;
  g.Bt = (const u16*)(p.ws + OFF_WOUTT); g.K = 1024;
  g.outf = (float*)(p.ws + OFF_H1); g.resid = p.x; g.ldo = 1024;
  constexpr int NT = 1024 / 128, MT = T / 256;
  for (int id = blockIdx.x; id < NT * MT; id += gridDim.x) {
    g.rowbase = (id / NT) * 256; g.n0 = (id % NT) * 128;
    gemm_tile<EPI_H1, false>(g, smem);
  }
}

__device__ void phase_router(const Params& p, char* smem) {
  const float* h1 = (const float*)(p.ws + OFF_H1);
  u16* xn2 = (u16*)(p.ws + OFF_XN);
  int* toke = (int*)(p.ws + OFF_TOKE); float* tokg = (float*)(p.ws + OFF_TOKG); int* tokp = (int*)(p.ws + OFF_TOKP);
  int* cnt = (int*)(p.ws + OFF_CNT);
  const int lane = threadIdx.x & 63, wid = threadIdx.x >> 6;
  float* xs = (float*)smem + wid * 4096;
  const int gw = blockIdx.x * 8 + wid, nw = gridDim.x * 8;
  const int e = lane & 31, kh = lane >> 5;
  for (int tg = gw; tg < T / 4; tg += nw) {
    const int t0 = tg * 4;
#pragma unroll
    for (int u = 0; u < 4; ++u) {
      const float4* hr = (const float4*)(h1 + (size_t)(t0 + u) * D);
      float4 v[4]; float ss = 0.f;
#pragma unroll
      for (int i = 0; i < 4; ++i) { v[i] = hr[lane + 64 * i]; ss += v[i].x * v[i].x + v[i].y * v[i].y + v[i].z * v[i].z + v[i].w * v[i].w; }
      ss = wave_sum(ss);
      float rstd = rsqrtf(ss * (1.f / D) + 1e-6f);
#pragma unroll
      for (int i = 0; i < 4; ++i) {
        float4 w = ((const float4*)p.norm2_w)[lane + 64 * i];
        float4 y = make_float4(v[i].x * rstd * w.x, v[i].y * rstd * w.y, v[i].z * rstd * w.z, v[i].w * rstd * w.w);
        *(float4*)(xs + u * 1024 + (lane + 64 * i) * 4) = y;
        uint2 o; o.x = pack2bf(y.x, y.y); o.y = pack2bf(y.z, y.w);
        *(uint2*)(xn2 + (size_t)(t0 + u) * D + (lane + 64 * i) * 4) = o;
      }
    }
    __threadfence_block();
    float l0 = 0.f, l1 = 0.f, l2 = 0.f, l3 = 0.f;
    const float* rw = p.router_w + (size_t)kh * 512 * 32 + e;
    const float* xk = xs + kh * 512;
    for (int k = 0; k < 512; ++k) {
      float w = rw[k * 32];
      l0 += xk[k] * w; l1 += xk[1024 + k] * w; l2 += xk[2048 + k] * w; l3 += xk[3072 + k] * w;
    }
    l0 += __shfl_xor(l0, 32); l1 += __shfl_xor(l1, 32); l2 += __shfl_xor(l2, 32); l3 += __shfl_xor(l3, 32);
    const float rb = p.router_b[e];
    float lg[4] = {l0 + rb, l1 + rb, l2 + rb, l3 + rb};
#pragma unroll
    for (int u = 0; u < 4; ++u) {
      float val = lg[u];
      float tv[4]; int te[4];
#pragma unroll
      for (int k = 0; k < 4; ++k) {
        float bv = val; int bi = e;
#pragma unroll
        for (int off = 16; off >= 1; off >>= 1) {
          float ov = __shfl_xor(bv, off); int oi = __shfl_xor(bi, off);
          if (ov > bv || (ov == bv && oi < bi)) { bv = ov; bi = oi; }
        }
        tv[k] = bv; te[k] = bi;
        if (e == bi) val = -INFINITY;
      }
      float m = tv[0];
      float ex[4], s = 0.f;
#pragma unroll
      for (int k = 0; k < 4; ++k) { ex[k] = __expf(tv[k] - m); s += ex[k]; }
      if (lane < 4) {
        int ee = (lane == 0) ? te[0] : (lane == 1) ? te[1] : (lane == 2) ? te[2] : te[3];
        float gg = ((lane == 0) ? ex[0] : (lane == 1) ? ex[1] : (lane == 2) ? ex[2] : ex[3]) / s;
        int pos = atomicAdd(&cnt[ee], 1);
        toke[(size_t)(t0 + u) * 4 + lane] = ee; tokg[(size_t)(t0 + u) * 4 + lane] = gg; tokp[(size_t)(t0 + u) * 4 + lane] = pos;
      }
    }
    __threadfence_block();
  }
}

__device__ __forceinline__ int expert_tstart(const int* cnt, int e) {
  int s = 0;
  for (int i = 0; i < e; ++i) s += (cnt[i] + 255) >> 8;
  return s;
}

__device__ void phase_fill_rows(const Params& p) {
  const int* toke = (const int*)(p.ws + OFF_TOKE); const int* tokp = (const int*)(p.ws + OFF_TOKP);
  const int* cnt = (const int*)(p.ws + OFF_CNT);
  int* rowtok = (int*)(p.ws + OFF_ROWTOK);
  __shared__ int ts[NE];
  if (threadIdx.x < NE) ts[threadIdx.x] = expert_tstart(cnt, threadIdx.x);
  __syncthreads();
  int gtid = blockIdx.x * NTHREADS + threadIdx.x, gsz = gridDim.x * NTHREADS;
  for (int i = gtid; i < T * 4; i += gsz) rowtok[ts[toke[i]] * 256 + tokp[i]] = i >> 2;
}

__device__ void phase_gemm_gu(const Params& p, char* smem) {
  const int* cnt = (const int*)(p.ws + OFF_CNT);
  __shared__ int ts[NE + 1];
  if (threadIdx.x <= NE) ts[threadIdx.x] = expert_tstart(cnt, threadIdx.x);
  __syncthreads();
  const int ntiles = ts[NE];
  GemmTile g{};
  g.A = (const u16*)(p.ws + OFF_XN); g.lda = 1024; g.rowtok = (const int*)(p.ws + OFF_ROWTOK);
  g.K = 1024; g.outh = (u16*)(p.ws + OFF_Z); g.ldo = 1024;
  for (int id = blockIdx.x; id < ntiles * 16; id += gridDim.x) {
    const int tile = id >> 4, nt = id & 15;
    int e = 0;
    while (e < NE - 1 && ts[e + 1] <= tile) ++e;
    g.rowbase = tile * 256; g.n0 = nt * 64;
    g.Bt = (const u16*)(p.ws + OFF_WGUT) + (size_t)e * 2048 * 1024;
    g.bias = p.exp_b_gu + (size_t)e * 2048;
    gemm_tile<EPI_GU, true>(g, smem);
  }
}

__device__ void phase_gemm_dn(const Params& p, char* smem) {
  const int* cnt = (const int*)(p.ws + OFF_CNT);
  __shared__ int ts[NE + 1];
  if (threadIdx.x <= NE) ts[threadIdx.x] = expert_tstart(cnt, threadIdx.x);
  __syncthreads();
  const int ntiles = ts[NE];
  GemmTile g{};
  g.A = (const u16*)(p.ws + OFF_Z); g.lda = 1024; g.rowtok = nullptr;
  g.K = 1024; g.outh = (u16*)(p.ws + OFF_SV); g.ldo = 1024;
  for (int id = blockIdx.x; id < ntiles * 8; id += gridDim.x) {
    const int tile = id >> 3, nt = id & 7;
    int e = 0;
    while (e < NE - 1 && ts[e + 1] <= tile) ++e;
    g.rowbase = tile * 256; g.n0 = nt * 128;
    g.Bt = (const u16*)(p.ws + OFF_WDNT) + (size_t)e * 1024 * 1024;
    g.bias = p.exp_b_down + (size_t)e * 1024;
    gemm_tile<EPI_DN, false>(g, smem);
  }
}

__device__ void phase_combine(const Params& p) {
  const int* toke = (const int*)(p.ws + OFF_TOKE); const float* tokg = (const float*)(p.ws + OFF_TOKG); const int* tokp = (const int*)(p.ws + OFF_TOKP);
  const int* cnt = (const int*)(p.ws + OFF_CNT);
  const float* h1 = (const float*)(p.ws + OFF_H1); const u16* yb = (const u16*)(p.ws + OFF_SV);
  __shared__ int ts[NE];
  if (threadIdx.x < NE) ts[threadIdx.x] = expert_tstart(cnt, threadIdx.x);
  __syncthreads();
  const int tid = threadIdx.x;
  const int sub = tid & 127, tl = tid >> 7;
  for (int t0 = blockIdx.x * 4; t0 < T; t0 += gridDim.x * 4) {
    const int t = t0 + tl;
    float4 a = *(const float4*)(h1 + (size_t)t * D + sub * 8), b = *(const float4*)(h1 + (size_t)t * D + sub * 8 + 4);
    float o[8] = {a.x, a.y, a.z, a.w, b.x, b.y, b.z, b.w};
#pragma unroll
    for (int k = 0; k < 4; ++k) {
      const int e = toke[t * 4 + k]; const float gte = tokg[t * 4 + k];
      const size_t row = (size_t)ts[e] * 256 + tokp[t * 4 + k];
      uint4 w = *(const uint4*)(yb + row * 1024 + sub * 8);
      u32 ww[4] = {w.x, w.y, w.z, w.w};
#pragma unroll
      for (int i = 0; i < 4; ++i) { o[2 * i] += gte * __uint_as_float(ww[i] << 16); o[2 * i + 1] += gte * __uint_as_float(ww[i] & 0xFFFF0000u); }
    }
    *(float4*)(p.out + (size_t)t * D + sub * 8) = make_float4(o[0], o[1], o[2], o[3]);
    *(float4*)(p.out + (size_t)t * D + sub * 8 + 4) = make_float4(o[4], o[5], o[6], o[7]);
  }
}

enum { PH_INIT = 0, PH_PREP, PH_GEMM_IN, PH_POST, PH_SCAN_A, PH_TOPK, PH_SCAN_B, PH_SCAN_C, PH_ATTN, PH_RWKV_OUT, PH_GEMM_OUT, PH_ROUTER, PH_FILL, PH_GEMM_GU, PH_GEMM_DN, PH_COMBINE, PH_COUNT };

template <int PH>
__device__ __forceinline__ void run_phase(const Params& p, char* smem) {
  if (PH == PH_INIT) { phase_init(p); phase_norm1(p); }
  if (PH == PH_PREP) {
    transpose_convert(p.w_in, (u16*)(p.ws + OFF_WINT), 1024, DIN, DINP, 1, smem);
    transpose_convert(p.w_out, (u16*)(p.ws + OFF_WOUTT), 1024, 1024, 1024, 1, smem);
    transpose_convert(p.exp_w_gu, (u16*)(p.ws + OFF_WGUT), 1024, 2048, 2048, NE, smem);
    transpose_convert(p.exp_w_down, (u16*)(p.ws + OFF_WDNT), 1024, 1024, 1024, NE, smem);
  }
  if (PH == PH_GEMM_IN) phase_gemm_in(p, smem);
  if (PH == PH_POST) { phase_post_attn(p); phase_post_rwkv(p, smem); }
  if (PH == PH_SCAN_A) phase_scan_a(p, smem);
  if (PH == PH_TOPK) phase_topk(p, smem);
  if (PH == PH_SCAN_B) phase_scan_b(p, smem);
  if (PH == PH_SCAN_C) phase_scan_c(p, smem);
  if (PH == PH_ATTN) phase_attn(p);
  if (PH == PH_RWKV_OUT) phase_rwkv_out(p);
  if (PH == PH_GEMM_OUT) phase_gemm_out(p, smem);
  if (PH == PH_ROUTER) phase_router(p, smem);
  if (PH == PH_FILL) phase_fill_rows(p);
  if (PH == PH_GEMM_GU) phase_gemm_gu(p, smem);
  if (PH == PH_GEMM_DN) phase_gemm_dn(p, smem);
  if (PH == PH_COMBINE) phase_combine(p);
}

template <int PH>
__global__ void __launch_bounds__(NTHREADS) phase_kernel(Params p) {
  extern __shared__ __attribute__((aligned(16))) char smem[];
  run_phase<PH>(p, smem);
}

template <int PH>
static void launch_phase(const Params& p, int grid, hipStream_t stream) {
  static bool attr_set = false;
  if (!attr_set) { (void)hipFuncSetAttribute((const void*)phase_kernel<PH>, hipFuncAttributeMaxDynamicSharedMemorySize, LDS_BYTES); attr_set = true; }
  hipLaunchKernelGGL(phase_kernel<PH>, dim3(grid), dim3(NTHREADS), LDS_BYTES, stream, p);
}

extern "C" void kernel_launch(void* const* d_in, const int* in_sizes, int n_in, void* d_out, int out_size, void* d_ws, size_t ws_size,
                              hipStream_t stream) {
  if (ws_size < WS_NEEDED) { fprintf(stderr, "workspace too small: %zu < %zu\n", ws_size, (size_t)WS_NEEDED); return; }
  Params p{};
  p.x = (const float*)d_in[0]; p.positions = (const int*)d_in[1]; p.norm1_w = (const float*)d_in[2]; p.w_in = (const float*)d_in[3];
  p.q_norm_w = (const float*)d_in[4]; p.k_norm_w = (const float*)d_in[5]; p.rwkv_mu = (const float*)d_in[6]; p.rwkv_w0 = (const float*)d_in[7];
  p.rwkv_w2 = (const float*)d_in[8]; p.rwkv_a0 = (const float*)d_in[9]; p.rwkv_a2 = (const float*)d_in[10]; p.rwkv_g2 = (const float*)d_in[11];
  p.rwkv_k_k = (const float*)d_in[12]; p.rwkv_k_a = (const float*)d_in[13]; p.rwkv_r_k = (const float*)d_in[14]; p.rwkv_ln_w = (const float*)d_in[15];
  p.rwkv_ln_b = (const float*)d_in[16]; p.w_out = (const float*)d_in[17]; p.norm2_w = (const float*)d_in[18]; p.router_w = (const float*)d_in[19];
  p.router_b = (const float*)d_in[20]; p.exp_w_gu = (const float*)d_in[21]; p.exp_b_gu = (const float*)d_in[22]; p.exp_w_down = (const float*)d_in[23];
  p.exp_b_down = (const float*)d_in[24];
  p.out = (float*)d_out; p.ws = (char*)d_ws;
  const int grid = 256;
  launch_phase<PH_INIT>(p, grid, stream);
  launch_phase<PH_PREP>(p, grid, stream);
  launch_phase<PH_GEMM_IN>(p, grid, stream);
  launch_phase<PH_POST>(p, grid, stream);
  launch_phase<PH_SCAN_A>(p, grid, stream);
  launch_phase<PH_TOPK>(p, grid, stream);
  launch_phase<PH_SCAN_B>(p, grid, stream);
  launch_phase<PH_SCAN_C>(p, grid, stream);
  launch_phase<PH_ATTN>(p, grid, stream);
  launch_phase<PH_RWKV_OUT>(p, grid, stream);
  launch_phase<PH_GEMM_OUT>(p, grid, stream);
  launch_phase<PH_ROUTER>(p, grid, stream);
  launch_phase<PH_FILL>(p, grid, stream);
  launch_phase<PH_GEMM_GU>(p, grid, stream);
  launch_phase<PH_GEMM_DN>(p, grid, stream);
  launch_phase<PH_COMBINE>(p, grid, stream);
}
```

```cpp
#include <hip/hip_runtime.h>
#include <hip/hip_bf16.h>
#include <hip/hip_fp16.h>
#include <hip/hip_cooperative_groups.h>
#include <stdint.h>
#include <stdio.h>
namespace cg = cooperative_groups;

typedef unsigned short u16;
typedef unsigned int u32;
using bf16x8 = __attribute__((ext_vector_type(8))) short;
using f32x4 = __attribute__((ext_vector_type(4))) float;
using f32x16 = __attribute__((ext_vector_type(16))) float;

constexpr int T = 16384, D = 1024, DIN = 3496, DINP = 3584;
constexpr int NCH = 64, CHL = T / NCH;
constexpr int NE = 32, DFF = 1024;
constexpr int ROWCAP = 73728;
constexpr int C_Q = 0, C_K = 512, C_V = 1024, C_IQ = 1536, C_IK = 1792, C_IW = 1824, C_RW = 1832;
constexpr int NTHREADS = 512;
constexpr int LDS_BYTES = 152 * 1024;

constexpr size_t SZ_WGUT = (size_t)NE * 2048 * 1024 * 2;
constexpr size_t SZ_WDNT = (size_t)NE * 1024 * 1024 * 2;
constexpr size_t SZ_WINT = (size_t)DINP * 1024 * 2;
constexpr size_t SZ_WOUTT = (size_t)1024 * 1024 * 2;
constexpr size_t SZ_XN = (size_t)T * 1024 * 2;
constexpr size_t SZ_Z = (size_t)T * DINP * 4;
constexpr size_t SZ_QKV = (size_t)T * 512 * 2;
constexpr size_t SZ_IQ = (size_t)T * 256 * 2;
constexpr size_t SZ_IK = (size_t)T * 32 * 2;
constexpr size_t SZ_IW = (size_t)T * 8 * 4;
constexpr size_t SZ_SV = (size_t)T * 8 * 384 * 4;
constexpr size_t SZ_G = (size_t)T * 512 * 4;
constexpr size_t SZ_BONUS = (size_t)T * 8 * 4;
constexpr size_t SZ_Y = (size_t)T * 512 * 4;
constexpr size_t SZ_SMAT = (size_t)8 * NCH * 4096 * 4;
constexpr size_t SZ_SEL = (size_t)T * 256 * 2;
constexpr size_t SZ_MIX = (size_t)T * 1024 * 2;
constexpr size_t SZ_H1 = (size_t)T * 1024 * 4;
constexpr size_t SZ_TOK = (size_t)T * 4 * 4;
constexpr size_t SZ_ROWTOK = (size_t)ROWCAP * 4;

constexpr size_t OFF_WGUT = 0;
constexpr size_t OFF_WDNT = OFF_WGUT + SZ_WGUT;
constexpr size_t OFF_WINT = OFF_WDNT + SZ_WDNT;
constexpr size_t OFF_WOUTT = OFF_WINT + SZ_WINT;
constexpr size_t OFF_XN = OFF_WOUTT + SZ_WOUTT;
constexpr size_t OFF_Z = OFF_XN + SZ_XN;
constexpr size_t OFF_QR = OFF_Z + SZ_Z;
constexpr size_t OFF_KR = OFF_QR + SZ_QKV;
constexpr size_t OFF_VV = OFF_KR + SZ_QKV;
constexpr size_t OFF_IQ = OFF_VV + SZ_QKV;
constexpr size_t OFF_IK = OFF_IQ + SZ_IQ;
constexpr size_t OFF_IW = OFF_IK + SZ_IK;
constexpr size_t OFF_SV = OFF_IW + SZ_IW;
constexpr size_t OFF_G = OFF_SV + SZ_SV;
constexpr size_t OFF_BONUS = OFF_G + SZ_G;
constexpr size_t OFF_Y = OFF_BONUS + SZ_BONUS;
constexpr size_t OFF_SP = OFF_Y + SZ_Y;
constexpr size_t OFF_SL = OFF_SP + SZ_SMAT;
constexpr size_t OFF_SI = OFF_SL + SZ_SMAT;
constexpr size_t OFF_SEL = OFF_SI + SZ_SMAT;
constexpr size_t OFF_MIX = OFF_SEL + SZ_SEL;
constexpr size_t OFF_H1 = OFF_MIX + SZ_MIX;
constexpr size_t OFF_TOKE = OFF_H1 + SZ_H1;
constexpr size_t OFF_TOKG = OFF_TOKE + SZ_TOK;
constexpr size_t OFF_TOKP = OFF_TOKG + SZ_TOK;
constexpr size_t OFF_ROWTOK = OFF_TOKP + SZ_TOK;
constexpr size_t OFF_CNT = OFF_ROWTOK + SZ_ROWTOK;
constexpr size_t WS_NEEDED = OFF_CNT + 4096;

struct Params {
  const float* x; const int* positions; const float* norm1_w; const float* w_in;
  const float* q_norm_w; const float* k_norm_w; const float* rwkv_mu; const float* rwkv_w0;
  const float* rwkv_w2; const float* rwkv_a0; const float* rwkv_a2; const float* rwkv_g2;
  const float* rwkv_k_k; const float* rwkv_k_a; const float* rwkv_r_k; const float* rwkv_ln_w;
  const float* rwkv_ln_b; const float* w_out; const float* norm2_w; const float* router_w;
  const float* router_b; const float* exp_w_gu; const float* exp_b_gu; const float* exp_w_down;
  const float* exp_b_down;
  float* out;
  char* ws;
};

__device__ __forceinline__ u16 f2bf(float f) {
  u32 u = __float_as_uint(f);
  u += 0x7FFFu + ((u >> 16) & 1u);
  return (u16)(u >> 16);
}
__device__ __forceinline__ float bf2f(u16 h) { return __uint_as_float(((u32)h) << 16); }
__device__ __forceinline__ u32 pack2bf(float a, float b) { return (u32)f2bf(a) | ((u32)f2bf(b) << 16); }
__device__ __forceinline__ float wave_sum(float v) {
#pragma unroll
  for (int o = 32; o >= 1; o >>= 1) v += __shfl_xor(v, o);
  return v;
}
__device__ __forceinline__ float sigmoidf_(float x) { return 1.f / (1.f + __expf(-x)); }

__device__ __forceinline__ void sincos_big(float ang, float& s, float& c) {
  double a = (double)ang * 0.15915494309189535;
  double r = a - rint(a);
  float rf = (float)r;
  s = __builtin_amdgcn_sinf(rf);
  c = __builtin_amdgcn_cosf(rf);
}

__device__ void phase_init(const Params& p) {
  int* cnt = (int*)(p.ws + OFF_CNT);
  int* rowtok = (int*)(p.ws + OFF_ROWTOK);
  int gtid = blockIdx.x * NTHREADS + threadIdx.x;
  int gsz = gridDim.x * NTHREADS;
  if (gtid < 64) cnt[gtid] = 0;
  for (int i = gtid; i < ROWCAP; i += gsz) rowtok[i] = -1;
}

__device__ void transpose_convert(const float* src, u16* dst, int R, int C, int Cpad, int nbatch, char* smem) {
  float* tile = (float*)smem;
  int tr = R / 64, tc = Cpad / 64;
  int ntile = tr * tc * nbatch;
  int tid = threadIdx.x;
  for (int id = blockIdx.x; id < ntile; id += gridDim.x) {
    int b = id / (tr * tc), rem = id % (tr * tc);
    int r0 = (rem / tc) * 64, c0 = (rem % tc) * 64;
    const float* s = src + (size_t)b * R * C;
    u16* d = dst + (size_t)b * Cpad * R;
#pragma unroll
    for (int i = 0; i < 8; ++i) {
      int r = (tid >> 6) + 8 * i, c = tid & 63;
      float v = (c0 + c < C) ? s[(size_t)(r0 + r) * C + c0 + c] : 0.f;
      tile[r * 65 + c] = v;
    }
    __syncthreads();
    {
      int cc = tid >> 3, rg = tid & 7;
      u32 w[4];
#pragma unroll
      for (int i = 0; i < 4; ++i) w[i] = pack2bf(tile[(rg * 8 + 2 * i) * 65 + cc], tile[(rg * 8 + 2 * i + 1) * 65 + cc]);
      uint4 o; o.x = w[0]; o.y = w[1]; o.z = w[2]; o.w = w[3];
      *(uint4*)(d + (size_t)(c0 + cc) * R + r0 + rg * 8) = o;
    }
    __syncthreads();
  }
}

__device__ void phase_norm1(const Params& p) {
  u16* xn = (u16*)(p.ws + OFF_XN);
  int lane = threadIdx.x & 63, wid = threadIdx.x >> 6;
  int gw = blockIdx.x * 8 + wid, nw = gridDim.x * 8;
  for (int t = gw; t < T; t += nw) {
    const float4* xr = (const float4*)(p.x + (size_t)t * D);
    float4 v[4]; float ss = 0.f;
#pragma unroll
    for (int i = 0; i < 4; ++i) { v[i] = xr[lane + 64 * i]; ss += v[i].x * v[i].x + v[i].y * v[i].y + v[i].z * v[i].z + v[i].w * v[i].w; }
    ss = wave_sum(ss);
    float rstd = rsqrtf(ss * (1.f / D) + 1e-6f);
#pragma unroll
    for (int i = 0; i < 4; ++i) {
      float4 w = ((const float4*)p.norm1_w)[lane + 64 * i];
      uint2 o; o.x = pack2bf(v[i].x * rstd * w.x, v[i].y * rstd * w.y); o.y = pack2bf(v[i].z * rstd * w.z, v[i].w * rstd * w.w);
      *(uint2*)(xn + (size_t)t * D + (lane + 64 * i) * 4) = o;
    }
  }
}

enum { EPI_Z = 0, EPI_H1 = 1, EPI_GU = 2, EPI_DN = 3 };

struct GemmTile {
  const u16* A; int lda;
  const int* rowtok;
  int rowbase;
  const u16* Bt;
  int K; int n0;
  float* outf; u16* outh; const float* resid; const float* bias; int ldo;
};

template <int EPI, bool GATHER>
__device__ void gemm_tile(const GemmTile& g, char* smem) {
  const int tid = threadIdx.x, lane = tid & 63, wid = tid >> 6;
  const int wr = wid >> 1, wc = wid & 1, fr = lane & 15, fq = lane >> 4;
  const int K = g.K;
  const int ldrow = tid >> 3, ldc = tid & 7;
  const u16* ap[4]; bool aval[4];
#pragma unroll
  for (int i = 0; i < 4; ++i) {
    int r = g.rowbase + ldrow + 64 * i;
    if (GATHER) { int tk = g.rowtok[r]; aval[i] = tk >= 0; ap[i] = g.A + (size_t)(tk < 0 ? 0 : tk) * g.lda + ldc * 8; }
    else { aval[i] = true; ap[i] = g.A + (size_t)r * g.lda + ldc * 8; }
  }
  const u16* bp[2];
#pragma unroll
  for (int i = 0; i < 2; ++i) {
    int j = ldrow + 64 * i;
    int br = (EPI == EPI_GU) ? (((j >> 5) & 1) * 1024 + g.n0 + (j >> 6) * 32 + (j & 31)) : (g.n0 + j);
    bp[i] = g.Bt + (size_t)br * K + ldc * 8;
  }
  const int swz = ((ldc ^ (ldrow & 7)) << 4);
  uint4 ra[4], rb[2];
  auto gload = [&](int kt) {
#pragma unroll
    for (int i = 0; i < 4; ++i) { ra[i] = aval[i] ? *(const uint4*)(ap[i] + kt * 64) : make_uint4(0, 0, 0, 0); }
#pragma unroll
    for (int i = 0; i < 2; ++i) rb[i] = *(const uint4*)(bp[i] + kt * 64);
  };
  auto lwrite = [&](int buf) {
#pragma unroll
    for (int i = 0; i < 4; ++i) *(uint4*)(smem + buf * 49152 + (ldrow + 64 * i) * 128 + swz) = ra[i];
#pragma unroll
    for (int i = 0; i < 2; ++i) *(uint4*)(smem + buf * 49152 + 32768 + (ldrow + 64 * i) * 128 + swz) = rb[i];
  };
  f32x4 acc[4][4];
#pragma unroll
  for (int m = 0; m < 4; ++m)
#pragma unroll
    for (int n = 0; n < 4; ++n) acc[m][n] = (f32x4){0.f, 0.f, 0.f, 0.f};
  const int nk = K / 64;
  gload(0);
  lwrite(0);
  __syncthreads();
  for (int kt = 0; kt < nk; ++kt) {
    const int cur = kt & 1;
    if (kt + 1 < nk) gload(kt + 1);
#pragma unroll
    for (int kk = 0; kk < 2; ++kk) {
      bf16x8 af[4], bfr[4];
      const int cs = (((kk * 4 + fq) ^ (fr & 7)) << 4);
#pragma unroll
      for (int m = 0; m < 4; ++m) af[m] = *(const bf16x8*)(smem + cur * 49152 + (wr * 64 + m * 16 + fr) * 128 + cs);
#pragma unroll
      for (int n = 0; n < 4; ++n) bfr[n] = *(const bf16x8*)(smem + cur * 49152 + 32768 + (wc * 64 + n * 16 + fr) * 128 + cs);
#pragma unroll
      for (int m = 0; m < 4; ++m)
#pragma unroll
        for (int n = 0; n < 4; ++n) acc[m][n] = __builtin_amdgcn_mfma_f32_16x16x32_bf16(af[m], bfr[n], acc[m][n], 0, 0, 0);
    }
    if (kt + 1 < nk) lwrite(cur ^ 1);
    __syncthreads();
  }
#pragma unroll
  for (int m = 0; m < 4; ++m) {
#pragma unroll
    for (int j = 0; j < 4; ++j) {
      const int row = g.rowbase + wr * 64 + m * 16 + fq * 4 + j;
      if (EPI == EPI_Z) {
#pragma unroll
        for (int n = 0; n < 4; ++n) g.outf[(size_t)row * g.ldo + g.n0 + wc * 64 + n * 16 + fr] = acc[m][n][j];
      } else if (EPI == EPI_H1) {
#pragma unroll
        for (int n = 0; n < 4; ++n) {
          size_t o = (size_t)row * g.ldo + g.n0 + wc * 64 + n * 16 + fr;
          g.outf[o] = g.resid[o] + acc[m][n][j];
        }
      } else if (EPI == EPI_GU) {
#pragma unroll
        for (int n = 0; n < 2; ++n) {
          const int col = g.n0 + wc * 32 + n * 16 + fr;
          float glu = acc[m][n][j] + g.bias[col];
          float lin = acc[m][n + 2][j] + g.bias[1024 + col];
          glu = fminf(glu, 7.f);
          lin = fminf(fmaxf(lin, -7.f), 7.f);
          float a = (lin + 1.f) * glu * sigmoidf_(1.702f * glu);
          g.outh[(size_t)row * g.ldo + col] = f2bf(a);
        }
      } else {
#pragma unroll
        for (int n = 0; n < 4; ++n) {
          const int col = g.n0 + wc * 64 + n * 16 + fr;
          g.outh[(size_t)row * g.ldo + col] = f2bf(acc[m][n][j] + g.bias[col]);
        }
      }
    }
  }
}

__device__ void phase_gemm_in(const Params& p, char* smem) {
  GemmTile g{};
  g.A = (const u16*)(p.ws + OFF_XN); g.lda = D; g.rowtok = nullptr;
  g.Bt = (const u16*)(p.ws + OFF_WINT); g.K = D;
  g.outf = (float*)(p.ws + OFF_Z); g.ldo = DINP;
  constexpr int NT = DINP / 128, MT = T / 256;
  for (int id = blockIdx.x; id < NT * MT; id += gridDim.x) {
    g.rowbase = (id / NT) * 256; g.n0 = (id % NT) * 128;
    gemm_tile<EPI_Z, false>(g, smem);
  }
}

__device__ void phase_post_attn(const Params& p) {
  const float* z = (const float*)(p.ws + OFF_Z);
  u16* qr = (u16*)(p.ws + OFF_QR); u16* kr = (u16*)(p.ws + OFF_KR); u16* vv = (u16*)(p.ws + OFF_VV);
  u16* iq = (u16*)(p.ws + OFF_IQ); u16* ik = (u16*)(p.ws + OFF_IK); float* iw = (float*)(p.ws + OFF_IW);
  const float INVF8[8] = {1.0f, 0.1939227432012558f, 0.03760603070259094f, 0.007292664609849453f,
                          0.0014142135623842478f, 0.00027424818836152554f, 5.318296098266728e-05f, 1.0313386155758053e-05f};
  const float INVF4[4] = {1.0f, 0.03760603070259094f, 0.0014142135623842478f, 5.318296098266728e-05f};
  int lane = threadIdx.x & 63, wid = threadIdx.x >> 6;
  int gw = blockIdx.x * 8 + wid, nw = gridDim.x * 8;
  const int sub = lane & 7;
  for (int t = gw; t < T; t += nw) {
    const float* zr = z + (size_t)t * DINP;
    const float pos = (float)p.positions[t];
    float cs8[8], sn8[8];
#pragma unroll
    for (int i = 0; i < 8; ++i) sincos_big(pos * INVF8[i], sn8[i], cs8[i]);
#pragma unroll
    for (int which = 0; which < 2; ++which) {
      const float* src = zr + (which ? C_K : C_Q) + lane * 8;
      const float* nw_ = (which ? p.k_norm_w : p.q_norm_w) + sub * 8;
      float4 a = *(const float4*)src, b = *(const float4*)(src + 4);
      float v[8] = {a.x, a.y, a.z, a.w, b.x, b.y, b.z, b.w};
      float ss = 0.f;
#pragma unroll
      for (int i = 0; i < 8; ++i) ss += v[i] * v[i];
      ss += __shfl_xor(ss, 1); ss += __shfl_xor(ss, 2); ss += __shfl_xor(ss, 4);
      float rstd = rsqrtf(ss * (1.f / 64.f) + 1e-6f);
      float y[8], o[8];
#pragma unroll
      for (int i = 0; i < 8; ++i) y[i] = v[i] * rstd * nw_[i];
#pragma unroll
      for (int i = 0; i < 8; ++i) {
        float oth = __shfl_xor(y[i], 1);
        float r0 = y[i] * cs8[i] - oth * sn8[i];
        float r1 = y[i] * cs8[i] + oth * sn8[i];
        o[i] = (sub == 0) ? r0 : ((sub == 1) ? r1 : y[i]);
      }
      const float sc = which ? 1.f : (0.125f * 1.4426950408889634f);
      uint4 w; w.x = pack2bf(o[0] * sc, o[1] * sc); w.y = pack2bf(o[2] * sc, o[3] * sc); w.z = pack2bf(o[4] * sc, o[5] * sc); w.w = pack2bf(o[6] * sc, o[7] * sc);
      *(uint4*)((which ? kr : qr) + (size_t)t * 512 + lane * 8) = w;
    }
    {
      const float* src = zr + C_V + lane * 8;
      float4 a = *(const float4*)src, b = *(const float4*)(src + 4);
      uint4 w; w.x = pack2bf(a.x, a.y); w.y = pack2bf(a.z, a.w); w.z = pack2bf(b.x, b.y); w.w = pack2bf(b.z, b.w);
      *(uint4*)(vv + (size_t)t * 512 + lane * 8) = w;
    }
    float cs4[4], sn4[4];
#pragma unroll
    for (int i = 0; i < 4; ++i) sincos_big(pos * INVF4[i], sn4[i], cs4[i]);
    {
      float4 a = *(const float4*)(zr + C_IQ + lane * 4);
      float y[4] = {a.x, a.y, a.z, a.w}, o[4];
#pragma unroll
      for (int i = 0; i < 4; ++i) {
        float oth = __shfl_xor(y[i], 1);
        float r0 = y[i] * cs4[i] - oth * sn4[i];
        float r1 = y[i] * cs4[i] + oth * sn4[i];
        o[i] = (sub == 0) ? r0 : ((sub == 1) ? r1 : y[i]);
      }
      uint2 w; w.x = pack2bf(o[0], o[1]); w.y = pack2bf(o[2], o[3]);
      *(uint2*)(iq + (size_t)t * 256 + lane * 4) = w;
    }
    {
      float4 a = (lane < 8) ? *(const float4*)(zr + C_IK + lane * 4) : make_float4(0, 0, 0, 0);
      float y[4] = {a.x, a.y, a.z, a.w}, o[4];
#pragma unroll
      for (int i = 0; i < 4; ++i) {
        float oth = __shfl_xor(y[i], 1);
        float r0 = y[i] * cs4[i] - oth * sn4[i];
        float r1 = y[i] * cs4[i] + oth * sn4[i];
        o[i] = (sub == 0) ? r0 : ((sub == 1) ? r1 : y[i]);
      }
      if (lane < 8) {
        uint2 w; w.x = pack2bf(o[0], o[1]); w.y = pack2bf(o[2], o[3]);
        *(uint2*)(ik + (size_t)t * 32 + lane * 4) = w;
        iw[(size_t)t * 8 + lane] = zr[C_IW + lane];
      }
    }
  }
}

__device__ void phase_post_rwkv(const Params& p, char* smem) {
  const float* z = (const float*)(p.ws + OFF_Z);
  float* sv = (float*)(p.ws + OFF_SV); float* G = (float*)(p.ws + OFF_G); float* BON = (float*)(p.ws + OFF_BONUS);
  float* lora = (float*)smem;
  const int tid = threadIdx.x, lane = tid & 63, h = tid >> 6, c = tid;
  const float mu_r = p.rwkv_mu[c], mu_k = p.rwkv_mu[512 + c], mu_v = p.rwkv_mu[1024 + c];
  const float w0 = p.rwkv_w0[c], a0 = p.rwkv_a0[c], kkw = p.rwkv_k_k[c], kaw = p.rwkv_k_a[c], rkw = p.rwkv_r_k[c];
  for (int tg = blockIdx.x; tg < T / 8; tg += gridDim.x) {
    const int t0 = tg * 8;
#pragma unroll
    for (int i = 0; i < 2; ++i) {
      int item = tid + 512 * i, tok = item >> 7, j = item & 127, t = t0 + tok;
      int col = C_RW + 1536 + j;
      float zc = z[(size_t)t * DINP + col];
      float zp = (t > 0) ? z[(size_t)(t - 1) * DINP + col] : 0.f;
      float xs = zc + (zp - zc) * p.rwkv_mu[1536 + j];
      float o = (j < 32) ? tanhf(xs) : ((j < 64) ? xs : sigmoidf_(xs));
      lora[tok * 128 + j] = o;
    }
    __syncthreads();
    float aw[8], aa[8], ag[8];
#pragma unroll
    for (int k = 0; k < 8; ++k) { aw[k] = 0.f; aa[k] = 0.f; ag[k] = 0.f; }
    for (int j = 0; j < 32; ++j) {
      float w = p.rwkv_w2[j * 512 + c], a = p.rwkv_a2[j * 512 + c];
#pragma unroll
      for (int k = 0; k < 8; ++k) { aw[k] += lora[k * 128 + j] * w; aa[k] += lora[k * 128 + 32 + j] * a; }
    }
    for (int j = 0; j < 64; ++j) {
      float gg = p.rwkv_g2[j * 512 + c];
#pragma unroll
      for (int k = 0; k < 8; ++k) ag[k] += lora[k * 128 + 64 + j] * gg;
    }
#pragma unroll
    for (int k = 0; k < 8; ++k) {
      const int t = t0 + k;
      const float* zr = z + (size_t)t * DINP + C_RW;
      const float* zq = zr - DINP;
      float rc = zr[c], kc = zr[512 + c], vc = zr[1024 + c];
      float rp = 0.f, kp = 0.f, vp = 0.f;
      if (t > 0) { rp = zq[c]; kp = zq[512 + c]; vp = zq[1024 + c]; }
      float r = rc + (rp - rc) * mu_r, kx = kc + (kp - kc) * mu_k, v = vc + (vp - vc) * mu_v;
      float xw = -(w0 + aw[k]);
      float sp = fmaxf(xw, 0.f) + log1pf(__expf(-fabsf(xw)));
      float logw = -sp - 0.5f;
      float decay = __expf(-__expf(logw));
      float a = sigmoidf_(a0 + aa[k]);
      float kk = kx * kkw;
      float ss = wave_sum(kk * kk);
      kk *= rsqrtf(fmaxf(ss, 1e-24f));
      float kmod = kx * (1.f + (a - 1.f) * kaw);
      float bon = wave_sum(r * kmod * rkw);
      float* o = sv + ((size_t)t * 8 + h) * 384 + lane;
      o[0] = decay; o[64] = kk; o[128] = kk * a; o[192] = kmod; o[256] = r; o[320] = v;
      G[(size_t)t * 512 + c] = ag[k];
      if (lane == 0) BON[(size_t)t * 8 + h] = bon;
    }
    __syncthreads();
  }
}

template <int MODE>
__device__ void scan_task(const Params& p, int h, int c, float* wl  ) {
  const int lane = threadIdx.x & 63;
  const float* sv = (const float*)(p.ws + OFF_SV);
  float S[64];
  if (MODE == 0) {
#pragma unroll
    for (int j = 0; j < 64; ++j) S[j] = (j == lane) ? 1.f : 0.f;
  } else if (MODE == 1) {
#pragma unroll
    for (int j = 0; j < 64; ++j) S[j] = 0.f;
  } else {
    const float4* si = (const float4*)((const float*)(p.ws + OFF_SI) + ((size_t)(h * NCH + c) * 64 + lane) * 64);
#pragma unroll
    for (int j = 0; j < 16; ++j) { float4 v = si[j]; S[4 * j] = v.x; S[4 * j + 1] = v.y; S[4 * j + 2] = v.z; S[4 * j + 3] = v.w; }
  }
  float* Y = (float*)(p.ws + OFF_Y);
  const float* src = sv + ((size_t)(c * CHL) * 8 + h) * 384;
  const int f0 = lane, f1 = lane + 64, f2 = lane + 128, f3 = lane + 192, f4 = lane + 256, f5 = lane + 320;
  const int go0 = (f0 / 96) * 3072 + (f0 % 96) * 4, go1 = (f1 / 96) * 3072 + (f1 % 96) * 4, go2 = (f2 / 96) * 3072 + (f2 % 96) * 4;
  const int go3 = (f3 / 96) * 3072 + (f3 % 96) * 4, go4 = (f4 / 96) * 3072 + (f4 % 96) * 4, go5 = (f5 / 96) * 3072 + (f5 % 96) * 4;
#define SCAN_GLOAD(base) do { rg0 = *(const float4*)((base) + go0); rg1 = *(const float4*)((base) + go1); rg2 = *(const float4*)((base) + go2); \
    rg3 = *(const float4*)((base) + go3); rg4 = *(const float4*)((base) + go4); rg5 = *(const float4*)((base) + go5); } while (0)
#define SCAN_LWRITE(dst) do { *(float4*)((dst) + f0 * 4) = rg0; *(float4*)((dst) + f1 * 4) = rg1; *(float4*)((dst) + f2 * 4) = rg2; \
    *(float4*)((dst) + f3 * 4) = rg3; *(float4*)((dst) + f4 * 4) = rg4; *(float4*)((dst) + f5 * 4) = rg5; } while (0)
  float4 rg0, rg1, rg2, rg3, rg4, rg5;
  SCAN_GLOAD(src);
  SCAN_LWRITE(wl);
  constexpr int NG = CHL / 4;
  for (int g = 0; g < NG; ++g) {
    if (g + 1 < NG) SCAN_GLOAD(src + (size_t)(g + 1) * 4 * 3072);
    const float* Lb = wl + (g & 1) * 1536;
#pragma unroll 1
    for (int st = 0; st < 4; ++st) {
      const float4* pv = (const float4*)(Lb + st * 384);
      float sa0 = 0.f, sa1 = 0.f, sa2 = 0.f, sa3 = 0.f;
#pragma unroll
      for (int j = 0; j < 16; ++j) {
        float4 k4 = pv[16 + j];
        sa0 += S[4 * j] * k4.x; sa1 += S[4 * j + 1] * k4.y; sa2 += S[4 * j + 2] * k4.z; sa3 += S[4 * j + 3] * k4.w;
      }
      const float nsa = -((sa0 + sa1) + (sa2 + sa3));
      float vi = 0.f;
      if (MODE != 0) vi = Lb[st * 384 + 320 + lane];
#pragma unroll
      for (int j = 0; j < 16; ++j) {
        float4 w4 = pv[j], b4 = pv[32 + j];
        S[4 * j] = S[4 * j] * w4.x + nsa * b4.x; S[4 * j + 1] = S[4 * j + 1] * w4.y + nsa * b4.y;
        S[4 * j + 2] = S[4 * j + 2] * w4.z + nsa * b4.z; S[4 * j + 3] = S[4 * j + 3] * w4.w + nsa * b4.w;
        if (MODE != 0) {
          float4 k4 = pv[48 + j];
          S[4 * j] += vi * k4.x; S[4 * j + 1] += vi * k4.y; S[4 * j + 2] += vi * k4.z; S[4 * j + 3] += vi * k4.w;
        }
      }
      if (MODE == 2) {
        float y0 = 0.f, y1 = 0.f, y2 = 0.f, y3 = 0.f;
#pragma unroll
        for (int j = 0; j < 16; ++j) {
          float4 r4 = pv[64 + j];
          y0 += S[4 * j] * r4.x; y1 += S[4 * j + 1] * r4.y; y2 += S[4 * j + 2] * r4.z; y3 += S[4 * j + 3] * r4.w;
        }
        Y[(size_t)(c * CHL + g * 4 + st) * 512 + h * 64 + lane] = (y0 + y1) + (y2 + y3);
      }
    }
    if (g + 1 < NG) { float* Ln = wl + ((g + 1) & 1) * 1536; SCAN_LWRITE(Ln); }
  }
  if (MODE != 2) {
    float4* o = (float4*)((float*)(p.ws + (MODE == 0 ? OFF_SP : OFF_SL)) + ((size_t)(h * NCH + c) * 64 + lane) * 64);
#pragma unroll
    for (int j = 0; j < 16; ++j) o[j] = make_float4(S[4 * j], S[4 * j + 1], S[4 * j + 2], S[4 * j + 3]);
  }
}

__device__ void phase_scan_a(const Params& p, char* smem) {
  int wid = threadIdx.x >> 6;
  float* wl = (float*)smem + wid * 3072;
  int gw = blockIdx.x * 8 + wid, nw = gridDim.x * 8;
  for (int task = gw; task < 8 * NCH * 2; task += nw) {
    int which = task & 1, hc = task >> 1, h = hc % 8, c = hc / 8;
    if (which == 0) scan_task<0>(p, h, c, wl); else scan_task<1>(p, h, c, wl);
  }
}

__device__ void phase_scan_b_impl(const Params& p, char* smem) {
  const int h = blockIdx.x, tid = threadIdx.x;
  float* Ss = (float*)smem;
  float* Ps = Ss + 64 * 65;
  const float* SP = (const float*)(p.ws + OFF_SP) + (size_t)h * NCH * 4096;
  const float* SL = (const float*)(p.ws + OFF_SL) + (size_t)h * NCH * 4096;
  float* SI = (float*)(p.ws + OFF_SI) + (size_t)h * NCH * 4096;
  const int i = tid >> 3, jg = tid & 7;
  for (int e = tid; e < 4096; e += 512) { Ss[(e >> 6) * 65 + (e & 63)] = 0.f; SI[e] = 0.f; }
  for (int c = 0; c < NCH - 1; ++c) {
    for (int e = tid; e < 4096; e += 512) Ps[e] = SP[(size_t)c * 4096 + e];
    __syncthreads();
    float acc[8];
#pragma unroll
    for (int u = 0; u < 8; ++u) acc[u] = SL[(size_t)c * 4096 + i * 64 + jg * 8 + u];
    for (int k = 0; k < 64; ++k) {
      float s = Ss[i * 65 + k];
      float4 p0 = *(const float4*)(Ps + k * 64 + jg * 8), p1 = *(const float4*)(Ps + k * 64 + jg * 8 + 4);
      acc[0] += s * p0.x; acc[1] += s * p0.y; acc[2] += s * p0.z; acc[3] += s * p0.w;
      acc[4] += s * p1.x; acc[5] += s * p1.y; acc[6] += s * p1.z; acc[7] += s * p1.w;
    }
    __syncthreads();
#pragma unroll
    for (int u = 0; u < 8; ++u) { Ss[i * 65 + jg * 8 + u] = acc[u]; SI[(size_t)(c + 1) * 4096 + i * 64 + jg * 8 + u] = acc[u]; }
    __syncthreads();
  }
}

__device__ void phase_scan_b(const Params& p, char* smem) { if (blockIdx.x < 8) phase_scan_b_impl(p, smem); }

__device__ void phase_scan_c(const Params& p, char* smem) {
  int wid = threadIdx.x >> 6;
  float* wl = (float*)smem + wid * 3072;
  int gw = blockIdx.x * 8 + wid, nw = gridDim.x * 8;
  for (int task = gw; task < 8 * NCH; task += nw) scan_task<2>(p, task % 8, task / 8, wl);
}

__device__ void phase_rwkv_out(const Params& p) {
  const float* Y = (const float*)(p.ws + OFF_Y); const float* sv = (const float*)(p.ws + OFF_SV);
  const float* G = (const float*)(p.ws + OFF_G); const float* BON = (const float*)(p.ws + OFF_BONUS);
  u16* mix = (u16*)(p.ws + OFF_MIX);
  const int tid = threadIdx.x, lane = tid & 63, h = tid >> 6;
  const float lw = p.rwkv_ln_w[tid], lb = p.rwkv_ln_b[tid];
  for (int t = blockIdx.x; t < T; t += gridDim.x) {
    float y = Y[(size_t)t * 512 + tid];
    float mean = wave_sum(y) * (1.f / 64.f);
    float d = y - mean;
    float var = wave_sum(d * d) * (1.f / 64.f);
    float o = d * rsqrtf(var + 64e-5f) * lw + lb;
    float v = sv[((size_t)t * 8 + h) * 384 + 320 + lane];
    o = (o + BON[(size_t)t * 8 + h] * v) * G[(size_t)t * 512 + tid];
    mix[(size_t)t * 1024 + 512 + tid] = f2bf(o);
  }
}

__device__ __forceinline__ u16 score_key(float s) {
  s = fminf(fmaxf(s, -60000.f), 60000.f);
  u16 b = __half_as_ushort(__float2half_rn(s));
  return (b & 0x8000u) ? (u16)(~b) : (u16)(b | 0x8000u);
}

__device__ void topk_select(const u16* keys, u32* hq, u32* h2, int t, u16* selout, int lane) {
  const int n = t + 1;
  u32 ssum = 0;
#pragma unroll
  for (int d = 0; d < 16; ++d) { u32 v = hq[16 * lane + d]; ssum += (v & 0xFFFFu) + (v >> 16); }
  u32 suf = ssum;
#pragma unroll
  for (int off = 1; off < 64; off <<= 1) { u32 o = __shfl_down(suf, off); if (lane + off < 64) suf += o; }
  unsigned long long m = __ballot(suf >= 256u);
  const int Ls = 63 - __clzll(m);
  const u32 above = __shfl(suf, Ls) - __shfl(ssum, Ls);
  u32 c1 = 0;
  if (lane < 32) { u32 v = hq[16 * Ls + (lane >> 1)]; c1 = (lane & 1) ? (v >> 16) : (v & 0xFFFFu); }
  u32 suf2 = c1;
#pragma unroll
  for (int off = 1; off < 32; off <<= 1) { u32 o = __shfl_down(suf2, off); if (lane + off < 64) suf2 += o; }
  unsigned long long m2 = __ballot((lane < 32) && (above + suf2 >= 256u));
  const int js = 63 - __clzll(m2);
  const u32 Bs = (u32)(32 * Ls + js);
  const u32 cnt_above = above + __shfl(suf2, js) - __shfl(c1, js);
  const int niter = (n + 511) >> 9;
  for (int it = 0; it < niter; ++it) {
    const int base = it * 512 + lane * 8;
    uint4 kv = *(const uint4*)(keys + base);
    u32 w[4] = {kv.x, kv.y, kv.z, kv.w};
#pragma unroll
    for (int e = 0; e < 8; ++e) {
      u32 k = (w[e >> 1] >> ((e & 1) * 16)) & 0xFFFFu;
      if ((base + e < n) && ((k >> 5) == Bs)) atomicAdd(&h2[k & 31u], 1u);
    }
  }
  __threadfence_block();
  const u32 need = 256u - cnt_above;
  u32 c2 = (lane < 32) ? h2[lane] : 0u;
  u32 suf3 = c2;
#pragma unroll
  for (int off = 1; off < 32; off <<= 1) { u32 o = __shfl_down(suf3, off); if (lane + off < 64) suf3 += o; }
  unsigned long long m3 = __ballot((lane < 32) && (suf3 >= need));
  const int vs = 63 - __clzll(m3);
  const u32 Kstar = (Bs << 5) | (u32)vs;
  const u32 cnt_gt = cnt_above + __shfl(suf3, vs) - __shfl(c2, vs);
  const u32 need_eq = 256u - cnt_gt;
  u32 base_gt = 0, base_eq = 0;
  for (int it = 0; it < niter; ++it) {
    const int base = it * 512 + lane * 8;
    uint4 kv = *(const uint4*)(keys + base);
    u32 w[4] = {kv.x, kv.y, kv.z, kv.w};
    u32 gtm = 0, eqm = 0;
#pragma unroll
    for (int e = 0; e < 8; ++e) {
      u32 k = (w[e >> 1] >> ((e & 1) * 16)) & 0xFFFFu;
      bool valid = (base + e < n);
      if (valid && k > Kstar) gtm |= (1u << e);
      if (valid && k == Kstar) eqm |= (1u << e);
    }
    u32 packed = __popc(gtm) | (__popc(eqm) << 16);
    u32 incl = packed;
#pragma unroll
    for (int off = 1; off < 64; off <<= 1) { u32 o = __shfl_up(incl, off); if (lane >= off) incl += o; }
    u32 excl = incl - packed;
    u32 tot = __shfl(incl, 63);
    u32 gb = base_gt + (excl & 0xFFFFu), eb = base_eq + (excl >> 16);
#pragma unroll
    for (int e = 0; e < 8; ++e) {
      u32 bit = 1u << e;
      u32 g_before = gb + __popc(gtm & (bit - 1u));
      u32 e_before = eb + __popc(eqm & (bit - 1u));
      if (gtm & bit) selout[g_before + min(e_before, need_eq)] = (u16)(base + e);
      else if ((eqm & bit) && e_before < need_eq) selout[g_before + e_before] = (u16)(base + e);
    }
    base_gt += tot & 0xFFFFu; base_eq += tot >> 16;
  }
}

__device__ void phase_topk(const Params& p, char* smem) {
  u16* keys = (u16*)smem;
  u32* hist = (u32*)(smem + 131072);
  u32* hist2 = hist + 4096;
  const u16* iq = (const u16*)(p.ws + OFF_IQ); const u16* ik = (const u16*)(p.ws + OFF_IK);
  const float* iw = (const float*)(p.ws + OFF_IW);
  u16* sel = (u16*)(p.ws + OFF_SEL);
  const int tid = threadIdx.x, lane = tid & 63, wid = tid >> 6;
  const int r = lane & 31, hh = lane >> 5;
  const int ngroups = (T - 256) / 4;
  const int nrounds = (ngroups + gridDim.x - 1) / gridDim.x;
  for (int rr = 0; rr < nrounds; ++rr) {
    const int gsel = rr * gridDim.x + ((rr & 1) ? (gridDim.x - 1 - blockIdx.x) : blockIdx.x);
    if (gsel >= ngroups) continue;
    const int t0 = 256 + gsel * 4;
    for (int i = tid; i < 4096 + 128; i += NTHREADS) hist[i] = 0u;
    __syncthreads();
    const u16* iqp = iq + ((size_t)(t0 + (r & 3)) * 8 + (r >> 2)) * 32 + 8 * hh;
    const bf16x8 a0 = *(const bf16x8*)iqp, a1 = *(const bf16x8*)(iqp + 16);
    float wq[16];
#pragma unroll
    for (int i = 0; i < 16; ++i) wq[i] = iw[(size_t)(t0 + (i & 3)) * 8 + 2 * (i >> 2) + hh];
    const int ntiles = (t0 + 4 + 31) >> 5;
    for (int kt = wid; kt < ntiles; kt += 8) {
      const int key = kt * 32 + r;
      const u16* ikp = ik + (size_t)key * 32 + 8 * hh;
      const bf16x8 b0 = *(const bf16x8*)ikp, b1 = *(const bf16x8*)(ikp + 16);
      f32x16 acc;
#pragma unroll
      for (int i = 0; i < 16; ++i) acc[i] = 0.f;
      acc = __builtin_amdgcn_mfma_f32_32x32x16_bf16(a0, b0, acc, 0, 0, 0);
      acc = __builtin_amdgcn_mfma_f32_32x32x16_bf16(a1, b1, acc, 0, 0, 0);
      float s0 = 0.f, s1 = 0.f, s2 = 0.f, s3 = 0.f;
#pragma unroll
      for (int i = 0; i < 16; i += 4) {
        s0 += wq[i] * fmaxf(acc[i], 0.f); s1 += wq[i + 1] * fmaxf(acc[i + 1], 0.f);
        s2 += wq[i + 2] * fmaxf(acc[i + 2], 0.f); s3 += wq[i + 3] * fmaxf(acc[i + 3], 0.f);
      }
      s0 += __shfl_xor(s0, 32); s1 += __shfl_xor(s1, 32); s2 += __shfl_xor(s2, 32); s3 += __shfl_xor(s3, 32);
      const float sa = hh ? s2 : s0, sb = hh ? s3 : s1;
      const int qa = hh * 2, qb = hh * 2 + 1;
      {
        bool valid = key <= t0 + qa;
        u16 k16 = valid ? score_key(sa) : (u16)0;
        keys[qa * 16384 + key] = k16;
        if (valid) { u32 bin = k16 >> 5; atomicAdd(&hist[qa * 1024 + (bin >> 1)], (bin & 1u) ? 0x10000u : 1u); }
      }
      {
        bool valid = key <= t0 + qb;
        u16 k16 = valid ? score_key(sb) : (u16)0;
        keys[qb * 16384 + key] = k16;
        if (valid) { u32 bin = k16 >> 5; atomicAdd(&hist[qb * 1024 + (bin >> 1)], (bin & 1u) ? 0x10000u : 1u); }
      }
    }
    __syncthreads();
    if (wid < 4) topk_select(keys + wid * 16384, hist + wid * 1024, hist2 + wid * 32, t0 + wid, sel + (size_t)(t0 + wid) * 256, lane);
    __syncthreads();
  }
}

__device__ void phase_attn(const Params& p) {
  const u16* qr = (const u16*)(p.ws + OFF_QR); const u16* kr = (const u16*)(p.ws + OFF_KR); const u16* vv = (const u16*)(p.ws + OFF_VV);
  const u16* sel = (const u16*)(p.ws + OFF_SEL);
  u16* mix = (u16*)(p.ws + OFF_MIX);
  const int lane = threadIdx.x & 63, wid = threadIdx.x >> 6;
  const int gw = blockIdx.x * 8 + wid, nw = gridDim.x * 8;
  for (int ti = gw; ti < T; ti += nw) {
    const int t = ti;
    const int nsel = (t + 1 < 256) ? (t + 1) : 256;
    int myidx[4];
#pragma unroll
    for (int m = 0; m < 4; ++m) {
      int pos = lane + 64 * m;
      myidx[m] = (pos < nsel) ? ((t < 256) ? pos : (int)sel[(size_t)t * 256 + pos]) : 0;
    }
    float q[8];
    {
      uint4 w = *(const uint4*)(qr + (size_t)t * 512 + lane * 8);
      u32 ww[4] = {w.x, w.y, w.z, w.w};
#pragma unroll
      for (int i = 0; i < 4; ++i) { q[2 * i] = __uint_as_float(ww[i] << 16); q[2 * i + 1] = __uint_as_float(ww[i] & 0xFFFF0000u); }
    }
    float mrun = -INFINITY, lrun = 0.f, acc[8];
#pragma unroll
    for (int i = 0; i < 8; ++i) acc[i] = 0.f;
#pragma unroll
    for (int m = 0; m < 4; ++m) {
      if (m * 64 < nsel) {
        for (int jj = 0; jj < 64; jj += 4) {
          if (m * 64 + jj >= nsel) break;
          float sc[4]; uint4 vrow[4];
#pragma unroll
          for (int u = 0; u < 4; ++u) {
            const int idx = __shfl(myidx[m], jj + u);
            uint4 kw = *(const uint4*)(kr + (size_t)idx * 512 + lane * 8);
            vrow[u] = *(const uint4*)(vv + (size_t)idx * 512 + lane * 8);
            u32 ww[4] = {kw.x, kw.y, kw.z, kw.w};
            float d = 0.f;
#pragma unroll
            for (int i = 0; i < 4; ++i) { d += q[2 * i] * __uint_as_float(ww[i] << 16); d += q[2 * i + 1] * __uint_as_float(ww[i] & 0xFFFF0000u); }
            d += __shfl_xor(d, 1); d += __shfl_xor(d, 2); d += __shfl_xor(d, 4);
            sc[u] = (m * 64 + jj + u < nsel) ? d : -INFINITY;
          }
          float mnew = fmaxf(fmaxf(fmaxf(sc[0], sc[1]), fmaxf(sc[2], sc[3])), mrun);
          float corr = exp2f(mrun - mnew);
          lrun *= corr;
#pragma unroll
          for (int i = 0; i < 8; ++i) acc[i] *= corr;
#pragma unroll
          for (int u = 0; u < 4; ++u) {
            float pu = exp2f(sc[u] - mnew);
            lrun += pu;
            u32 ww[4] = {vrow[u].x, vrow[u].y, vrow[u].z, vrow[u].w};
#pragma unroll
            for (int i = 0; i < 4; ++i) { acc[2 * i] += pu * __uint_as_float(ww[i] << 16); acc[2 * i + 1] += pu * __uint_as_float(ww[i] & 0xFFFF0000u); }
          }
          mrun = mnew;
        }
      }
    }
    const float inv = 1.f / lrun;
    uint4 o; o.x = pack2bf(acc[0] * inv, acc[1] * inv); o.y = pack2bf(acc[2] * inv, acc[3] * inv);
    o.z = pack2bf(acc[4] * inv, acc[5] * inv); o.w = pack2bf(acc[6] * inv, acc[7] * inv);
    *(uint4*)(mix + (size_t)t * 1024 + lane * 8) = o;
  }
}

__device__ void phase_gemm_out(const Params& p, char* smem) {
  GemmTile g{};
  g.A = (const u16*)(p.ws + OFF_MIX); g.lda = 1024; g.rowtok = nullptr;
  g.Bt = (const u16*)(p.ws + OFF_WOUTT); g.K = 1024;
  g.outf = (float*)(p.ws + OFF_H1); g.resid = p.x; g.ldo = 1024;
  constexpr int NT = 1024 / 128, MT = T / 256;
  for (int id = blockIdx.x; id < NT * MT; id += gridDim.x) {
    g.rowbase = (id / NT) * 256; g.n0 = (id % NT) * 128;
    gemm_tile<EPI_H1, false>(g, smem);
  }
}

__device__ void phase_router(const Params& p, char* smem) {
  const float* h1 = (const float*)(p.ws + OFF_H1);
  u16* xn2 = (u16*)(p.ws + OFF_XN);
  int* toke = (int*)(p.ws + OFF_TOKE); float* tokg = (float*)(p.ws + OFF_TOKG); int* tokp = (int*)(p.ws + OFF_TOKP);
  int* cnt = (int*)(p.ws + OFF_CNT);
  const int lane = threadIdx.x & 63, wid = threadIdx.x >> 6;
  float* xs = (float*)smem + wid * 4096;
  const int gw = blockIdx.x * 8 + wid, nw = gridDim.x * 8;
  const int e = lane & 31, kh = lane >> 5;
  for (int tg = gw; tg < T / 4; tg += nw) {
    const int t0 = tg * 4;
#pragma unroll
    for (int u = 0; u < 4; ++u) {
      const float4* hr = (const float4*)(h1 + (size_t)(t0 + u) * D);
      float4 v[4]; float ss = 0.f;
#pragma unroll
      for (int i = 0; i < 4; ++i) { v[i] = hr[lane + 64 * i]; ss += v[i].x * v[i].x + v[i].y * v[i].y + v[i].z * v[i].z + v[i].w * v[i].w; }
      ss = wave_sum(ss);
      float rstd = rsqrtf(ss * (1.f / D) + 1e-6f);
#pragma unroll
      for (int i = 0; i < 4; ++i) {
        float4 w = ((const float4*)p.norm2_w)[lane + 64 * i];
        float4 y = make_float4(v[i].x * rstd * w.x, v[i].y * rstd * w.y, v[i].z * rstd * w.z, v[i].w * rstd * w.w);
        *(float4*)(xs + u * 1024 + (lane + 64 * i) * 4) = y;
        uint2 o; o.x = pack2bf(y.x, y.y); o.y = pack2bf(y.z, y.w);
        *(uint2*)(xn2 + (size_t)(t0 + u) * D + (lane + 64 * i) * 4) = o;
      }
    }
    __threadfence_block();
    float l0 = 0.f, l1 = 0.f, l2 = 0.f, l3 = 0.f;
    const float* rw = p.router_w + (size_t)kh * 512 * 32 + e;
    const float* xk = xs + kh * 512;
    for (int k = 0; k < 512; ++k) {
      float w = rw[k * 32];
      l0 += xk[k] * w; l1 += xk[1024 + k] * w; l2 += xk[2048 + k] * w; l3 += xk[3072 + k] * w;
    }
    l0 += __shfl_xor(l0, 32); l1 += __shfl_xor(l1, 32); l2 += __shfl_xor(l2, 32); l3 += __shfl_xor(l3, 32);
    const float rb = p.router_b[e];
    float lg[4] = {l0 + rb, l1 + rb, l2 + rb, l3 + rb};
#pragma unroll
    for (int u = 0; u < 4; ++u) {
      float val = lg[u];
      float tv[4]; int te[4];
#pragma unroll
      for (int k = 0; k < 4; ++k) {
        float bv = val; int bi = e;
#pragma unroll
        for (int off = 16; off >= 1; off >>= 1) {
          float ov = __shfl_xor(bv, off); int oi = __shfl_xor(bi, off);
          if (ov > bv || (ov == bv && oi < bi)) { bv = ov; bi = oi; }
        }
        tv[k] = bv; te[k] = bi;
        if (e == bi) val = -INFINITY;
      }
      float m = tv[0];
      float ex[4], s = 0.f;
#pragma unroll
      for (int k = 0; k < 4; ++k) { ex[k] = __expf(tv[k] - m); s += ex[k]; }
      if (lane < 4) {
        int ee = (lane == 0) ? te[0] : (lane == 1) ? te[1] : (lane == 2) ? te[2] : te[3];
        float gg = ((lane == 0) ? ex[0] : (lane == 1) ? ex[1] : (lane == 2) ? ex[2] : ex[3]) / s;
        int pos = atomicAdd(&cnt[ee], 1);
        toke[(size_t)(t0 + u) * 4 + lane] = ee; tokg[(size_t)(t0 + u) * 4 + lane] = gg; tokp[(size_t)(t0 + u) * 4 + lane] = pos;
      }
    }
    __threadfence_block();
  }
}

__device__ __forceinline__ int expert_tstart(const int* cnt, int e) {
  int s = 0;
  for (int i = 0; i < e; ++i) s += (cnt[i] + 255) >> 8;
  return s;
}

__device__ void phase_fill_rows(const Params& p) {
  const int* toke = (const int*)(p.ws + OFF_TOKE); const int* tokp = (const int*)(p.ws + OFF_TOKP);
  const int* cnt = (const int*)(p.ws + OFF_CNT);
  int* rowtok = (int*)(p.ws + OFF_ROWTOK);
  __shared__ int ts[NE];
  if (threadIdx.x < NE) ts[threadIdx.x] = expert_tstart(cnt, threadIdx.x);
  __syncthreads();
  int gtid = blockIdx.x * NTHREADS + threadIdx.x, gsz = gridDim.x * NTHREADS;
  for (int i = gtid; i < T * 4; i += gsz) rowtok[ts[toke[i]] * 256 + tokp[i]] = i >> 2;
}

__device__ void phase_gemm_gu(const Params& p, char* smem) {
  const int* cnt = (const int*)(p.ws + OFF_CNT);
  __shared__ int ts[NE + 1];
  if (threadIdx.x <= NE) ts[threadIdx.x] = expert_tstart(cnt, threadIdx.x);
  __syncthreads();
  const int ntiles = ts[NE];
  GemmTile g{};
  g.A = (const u16*)(p.ws + OFF_XN); g.lda = 1024; g.rowtok = (const int*)(p.ws + OFF_ROWTOK);
  g.K = 1024; g.outh = (u16*)(p.ws + OFF_Z); g.ldo = 1024;
  for (int id = blockIdx.x; id < ntiles * 16; id += gridDim.x) {
    const int tile = id >> 4, nt = id & 15;
    int e = 0;
    while (e < NE - 1 && ts[e + 1] <= tile) ++e;
    g.rowbase = tile * 256; g.n0 = nt * 64;
    g.Bt = (const u16*)(p.ws + OFF_WGUT) + (size_t)e * 2048 * 1024;
    g.bias = p.exp_b_gu + (size_t)e * 2048;
    gemm_tile<EPI_GU, true>(g, smem);
  }
}

__device__ void phase_gemm_dn(const Params& p, char* smem) {
  const int* cnt = (const int*)(p.ws + OFF_CNT);
  __shared__ int ts[NE + 1];
  if (threadIdx.x <= NE) ts[threadIdx.x] = expert_tstart(cnt, threadIdx.x);
  __syncthreads();
  const int ntiles = ts[NE];
  GemmTile g{};
  g.A = (const u16*)(p.ws + OFF_Z); g.lda = 1024; g.rowtok = nullptr;
  g.K = 1024; g.outh = (u16*)(p.ws + OFF_SV); g.ldo = 1024;
  for (int id = blockIdx.x; id < ntiles * 8; id += gridDim.x) {
    const int tile = id >> 3, nt = id & 7;
    int e = 0;
    while (e < NE - 1 && ts[e + 1] <= tile) ++e;
    g.rowbase = tile * 256; g.n0 = nt * 128;
    g.Bt = (const u16*)(p.ws + OFF_WDNT) + (size_t)e * 1024 * 1024;
    g.bias = p.exp_b_down + (size_t)e * 1024;
    gemm_tile<EPI_DN, false>(g, smem);
  }
}

__device__ void phase_combine(const Params& p) {
  const int* toke = (const int*)(p.ws + OFF_TOKE); const float* tokg = (const float*)(p.ws + OFF_TOKG); const int* tokp = (const int*)(p.ws + OFF_TOKP);
  const int* cnt = (const int*)(p.ws + OFF_CNT);
  const float* h1 = (const float*)(p.ws + OFF_H1); const u16* yb = (const u16*)(p.ws + OFF_SV);
  __shared__ int ts[NE];
  if (threadIdx.x < NE) ts[threadIdx.x] = expert_tstart(cnt, threadIdx.x);
  __syncthreads();
  const int tid = threadIdx.x;
  const int sub = tid & 127, tl = tid >> 7;
  for (int t0 = blockIdx.x * 4; t0 < T; t0 += gridDim.x * 4) {
    const int t = t0 + tl;
    float4 a = *(const float4*)(h1 + (size_t)t * D + sub * 8), b = *(const float4*)(h1 + (size_t)t * D + sub * 8 + 4);
    float o[8] = {a.x, a.y, a.z, a.w, b.x, b.y, b.z, b.w};
#pragma unroll
    for (int k = 0; k < 4; ++k) {
      const int e = toke[t * 4 + k]; const float gte = tokg[t * 4 + k];
      const size_t row = (size_t)ts[e] * 256 + tokp[t * 4 + k];
      uint4 w = *(const uint4*)(yb + row * 1024 + sub * 8);
      u32 ww[4] = {w.x, w.y, w.z, w.w};
#pragma unroll
      for (int i = 0; i < 4; ++i) { o[2 * i] += gte * __uint_as_float(ww[i] << 16); o[2 * i + 1] += gte * __uint_as_float(ww[i] & 0xFFFF0000u); }
    }
    *(float4*)(p.out + (size_t)t * D + sub * 8) = make_float4(o[0], o[1], o[2], o[3]);
    *(float4*)(p.out + (size_t)t * D + sub * 8 + 4) = make_float4(o[4], o[5], o[6], o[7]);
  }
}

enum { PH_INIT = 0, PH_PREP, PH_GEMM_IN, PH_POST, PH_SCAN_A, PH_TOPK, PH_SCAN_B, PH_SCAN_C, PH_ATTN, PH_RWKV_OUT, PH_GEMM_OUT, PH_ROUTER, PH_FILL, PH_GEMM_GU, PH_GEMM_DN, PH_COMBINE, PH_COUNT };

template <int PH>
__device__ __forceinline__ void run_phase(const Params& p, char* smem) {
  if (PH == PH_INIT) { phase_init(p); phase_norm1(p); }
  if (PH == PH_PREP) {
    transpose_convert(p.w_in, (u16*)(p.ws + OFF_WINT), 1024, DIN, DINP, 1, smem);
    transpose_convert(p.w_out, (u16*)(p.ws + OFF_WOUTT), 1024, 1024, 1024, 1, smem);
    transpose_convert(p.exp_w_gu, (u16*)(p.ws + OFF_WGUT), 1024, 2048, 2048, NE, smem);
    transpose_convert(p.exp_w_down, (u16*)(p.ws + OFF_WDNT), 1024, 1024, 1024, NE, smem);
  }
  if (PH == PH_GEMM_IN) phase_gemm_in(p, smem);
  if (PH == PH_POST) { phase_post_attn(p); phase_post_rwkv(p, smem); }
  if (PH == PH_SCAN_A) phase_scan_a(p, smem);
  if (PH == PH_TOPK) phase_topk(p, smem);
  if (PH == PH_SCAN_B) phase_scan_b(p, smem);
  if (PH == PH_SCAN_C) phase_scan_c(p, smem);
  if (PH == PH_ATTN) phase_attn(p);
  if (PH == PH_RWKV_OUT) phase_rwkv_out(p);
  if (PH == PH_GEMM_OUT) phase_gemm_out(p, smem);
  if (PH == PH_ROUTER) phase_router(p, smem);
  if (PH == PH_FILL) phase_fill_rows(p);
  if (PH == PH_GEMM_GU) phase_gemm_gu(p, smem);
  if (PH == PH_GEMM_DN) phase_gemm_dn(p, smem);
  if (PH == PH_COMBINE) phase_combine(p);
}

#ifndef FUSED
#define FUSED 1
#endif

template <int PH>
__global__ void __launch_bounds__(NTHREADS) phase_kernel(Params p) {
  extern __shared__ __attribute__((aligned(16))) char smem[];
  run_phase<PH>(p, smem);
}

template <int PH>
__device__ __forceinline__ void run_from(const Params& p, char* smem, cg::grid_group& grid) {
  run_phase<PH>(p, smem);
  if constexpr (PH + 1 < PH_COUNT) {
    grid.sync();
    run_from<PH + 1>(p, smem, grid);
  }
}

__global__ void __launch_bounds__(NTHREADS) fwd_megakernel(Params p) {
  extern __shared__ __attribute__((aligned(16))) char smem[];
  cg::grid_group grid = cg::this_grid();
  run_from<0>(p, smem, grid);
}

template <int PH>
static void launch_phase(const Params& p, int grid, hipStream_t stream) {
  static bool attr_set = false;
  if (!attr_set) { (void)hipFuncSetAttribute((const void*)phase_kernel<PH>, hipFuncAttributeMaxDynamicSharedMemorySize, LDS_BYTES); attr_set = true; }
  hipLaunchKernelGGL(phase_kernel<PH>, dim3(grid), dim3(NTHREADS), LDS_BYTES, stream, p);
}

template <int PH>
static void launch_all(const Params& p, int grid, hipStream_t stream) {
  launch_phase<PH>(p, grid, stream);
  if constexpr (PH + 1 < PH_COUNT) launch_all<PH + 1>(p, grid, stream);
}

extern "C" void kernel_launch(void* const* d_in, const int* in_sizes, int n_in, void* d_out, int out_size, void* d_ws, size_t ws_size,
                              hipStream_t stream) {
  if (ws_size < WS_NEEDED) { fprintf(stderr, "workspace too small: %zu < %zu\n", ws_size, (size_t)WS_NEEDED); return; }
  Params p{};
  p.x = (const float*)d_in[0]; p.positions = (const int*)d_in[1]; p.norm1_w = (const float*)d_in[2]; p.w_in = (const float*)d_in[3];
  p.q_norm_w = (const float*)d_in[4]; p.k_norm_w = (const float*)d_in[5]; p.rwkv_mu = (const float*)d_in[6]; p.rwkv_w0 = (const float*)d_in[7];
  p.rwkv_w2 = (const float*)d_in[8]; p.rwkv_a0 = (const float*)d_in[9]; p.rwkv_a2 = (const float*)d_in[10]; p.rwkv_g2 = (const float*)d_in[11];
  p.rwkv_k_k = (const float*)d_in[12]; p.rwkv_k_a = (const float*)d_in[13]; p.rwkv_r_k = (const float*)d_in[14]; p.rwkv_ln_w = (const float*)d_in[15];
  p.rwkv_ln_b = (const float*)d_in[16]; p.w_out = (const float*)d_in[17]; p.norm2_w = (const float*)d_in[18]; p.router_w = (const float*)d_in[19];
  p.router_b = (const float*)d_in[20]; p.exp_w_gu = (const float*)d_in[21]; p.exp_b_gu = (const float*)d_in[22]; p.exp_w_down = (const float*)d_in[23];
  p.exp_b_down = (const float*)d_in[24];
  p.out = (float*)d_out; p.ws = (char*)d_ws;
#if FUSED
  static int grid_blocks = 0;
  if (!grid_blocks) {
    (void)hipFuncSetAttribute((const void*)fwd_megakernel, hipFuncAttributeMaxDynamicSharedMemorySize, LDS_BYTES);
    int dev = 0, cus = 0, per_cu = 0;
    (void)hipGetDevice(&dev);
    (void)hipDeviceGetAttribute(&cus, hipDeviceAttributeMultiprocessorCount, dev);
    (void)hipOccupancyMaxActiveBlocksPerMultiprocessor(&per_cu, fwd_megakernel, NTHREADS, LDS_BYTES);
    if (per_cu < 1) { fprintf(stderr, "occupancy query returned %d\n", per_cu); per_cu = 1; }
    grid_blocks = cus;
  }
  void* args[] = {(void*)&p};
  hipError_t e = hipLaunchCooperativeKernel((void*)fwd_megakernel, dim3(grid_blocks), dim3(NTHREADS), args, LDS_BYTES, stream);
  if (e != hipSuccess) fprintf(stderr, "cooperative launch failed: %s (grid %d)\n", hipGetErrorString(e), grid_blocks);
#else
  launch_all<0>(p, 256, stream);
#endif
}
```

```cpp
#include <hip/hip_runtime.h>
#include <hip/hip_bf16.h>
#include <hip/hip_fp16.h>
#include <hip/hip_cooperative_groups.h>
#include <stdint.h>
#include <stdio.h>
namespace cg = cooperative_groups;

typedef unsigned short u16;
typedef unsigned int u32;
using bf16x8 = __attribute__((ext_vector_type(8))) short;
using f32x4 = __attribute__((ext_vector_type(4))) float;
using f32x16 = __attribute__((ext_vector_type(16))) float;

constexpr int T = 16384, D = 1024, DIN = 3496, DINP = 3584;
constexpr int NCH = 64, CHL = T / NCH;
constexpr int NE = 32, DFF = 1024;
constexpr int ROWCAP = 73728;
constexpr int C_Q = 0, C_K = 512, C_V = 1024, C_IQ = 1536, C_IK = 1792, C_IW = 1824, C_RW = 1832;
constexpr int NTHREADS = 512;
constexpr int LDS_BYTES = 152 * 1024;

constexpr size_t SZ_WGUT = (size_t)NE * 2048 * 1024 * 2;
constexpr size_t SZ_WDNT = (size_t)NE * 1024 * 1024 * 2;
constexpr size_t SZ_WINT = (size_t)DINP * 1024 * 2;
constexpr size_t SZ_WOUTT = (size_t)1024 * 1024 * 2;
constexpr size_t SZ_XN = (size_t)T * 1024 * 2;
constexpr size_t SZ_Z = (size_t)T * DINP * 4;
constexpr size_t SZ_QKV = (size_t)T * 512 * 2;
constexpr size_t SZ_IQ = (size_t)T * 256 * 2;
constexpr size_t SZ_IK = (size_t)T * 32 * 2;
constexpr size_t SZ_IW = (size_t)T * 8 * 4;
constexpr size_t SZ_SV = (size_t)T * 8 * 384 * 4;
constexpr size_t SZ_G = (size_t)T * 512 * 4;
constexpr size_t SZ_BONUS = (size_t)T * 8 * 4;
constexpr size_t SZ_Y = (size_t)T * 512 * 4;
constexpr size_t SZ_SMAT = (size_t)8 * NCH * 4096 * 4;
constexpr size_t SZ_SEL = (size_t)T * 256 * 2;
constexpr size_t SZ_MIX = (size_t)T * 1024 * 2;
constexpr size_t SZ_H1 = (size_t)T * 1024 * 4;
constexpr size_t SZ_TOK = (size_t)T * 4 * 4;
constexpr size_t SZ_ROWTOK = (size_t)ROWCAP * 4;

constexpr size_t OFF_WGUT = 0;
constexpr size_t OFF_WDNT = OFF_WGUT + SZ_WGUT;
constexpr size_t OFF_WINT = OFF_WDNT + SZ_WDNT;
constexpr size_t OFF_WOUTT = OFF_WINT + SZ_WINT;
constexpr size_t OFF_XN = OFF_WOUTT + SZ_WOUTT;
constexpr size_t OFF_Z = OFF_XN + SZ_XN;
constexpr size_t OFF_QR = OFF_Z + SZ_Z;
constexpr size_t OFF_KR = OFF_QR + SZ_QKV;
constexpr size_t OFF_VV = OFF_KR + SZ_QKV;
constexpr size_t OFF_IQ = OFF_VV + SZ_QKV;
constexpr size_t OFF_IK = OFF_IQ + SZ_IQ;
constexpr size_t OFF_IW = OFF_IK + SZ_IK;
constexpr size_t OFF_SV = OFF_IW + SZ_IW;
constexpr size_t OFF_G = OFF_SV + SZ_SV;
constexpr size_t OFF_BONUS = OFF_G + SZ_G;
constexpr size_t OFF_Y = OFF_BONUS + SZ_BONUS;
constexpr size_t OFF_SP = OFF_Y + SZ_Y;
constexpr size_t OFF_SL = OFF_SP + SZ_SMAT;
constexpr size_t OFF_SI = OFF_SL + SZ_SMAT;
constexpr size_t OFF_SEL = OFF_SI + SZ_SMAT;
constexpr size_t OFF_MIX = OFF_SEL + SZ_SEL;
constexpr size_t OFF_H1 = OFF_MIX + SZ_MIX;
constexpr size_t OFF_TOKE = OFF_H1 + SZ_H1;
constexpr size_t OFF_TOKG = OFF_TOKE + SZ_TOK;
constexpr size_t OFF_TOKP = OFF_TOKG + SZ_TOK;
constexpr size_t OFF_ROWTOK = OFF_TOKP + SZ_TOK;
constexpr size_t OFF_CNT = OFF_ROWTOK + SZ_ROWTOK;
constexpr size_t OFF_QSH = OFF_CNT + 4096;
constexpr size_t OFF_BAR = OFF_QSH + (size_t)T * 8 * 4;
constexpr size_t WS_NEEDED = OFF_BAR + 16384;

struct Params {
  const float* x; const int* positions; const float* norm1_w; const float* w_in;
  const float* q_norm_w; const float* k_norm_w; const float* rwkv_mu; const float* rwkv_w0;
  const float* rwkv_w2; const float* rwkv_a0; const float* rwkv_a2; const float* rwkv_g2;
  const float* rwkv_k_k; const float* rwkv_k_a; const float* rwkv_r_k; const float* rwkv_ln_w;
  const float* rwkv_ln_b; const float* w_out; const float* norm2_w; const float* router_w;
  const float* router_b; const float* exp_w_gu; const float* exp_b_gu; const float* exp_w_down;
  const float* exp_b_down;
  float* out;
  char* ws;
};

__device__ __forceinline__ u16 f2bf(float f) {
  u32 u = __float_as_uint(f);
  u += 0x7FFFu + ((u >> 16) & 1u);
  return (u16)(u >> 16);
}
__device__ __forceinline__ float bf2f(u16 h) { return __uint_as_float(((u32)h) << 16); }
__device__ __forceinline__ u32 pack2bf(float a, float b) { return (u32)f2bf(a) | ((u32)f2bf(b) << 16); }
__device__ __forceinline__ float wave_sum(float v) {
#pragma unroll
  for (int o = 32; o >= 1; o >>= 1) v += __shfl_xor(v, o);
  return v;
}
__device__ __forceinline__ float sigmoidf_(float x) { return 1.f / (1.f + __expf(-x)); }

__device__ __forceinline__ void sincos_big(float ang, float& s, float& c) {
  double a = (double)ang * 0.15915494309189535;
  double r = a - rint(a);
  float rf = (float)r;
  s = __builtin_amdgcn_sinf(rf);
  c = __builtin_amdgcn_cosf(rf);
}


#define XB_TMO      128
#define XB_XCNT(j)  (256  + 64 * (j))
#define XB_XSUB(j)  (1280 + 64 * (j))
#define XB_XGEN(j)  (2304 + 64 * (j))
#define XB_TOP      3328
#define XB_TOPGEN   3392
#define XCD_BAR_WORDS 3456
#define XB_SPIN_CAP (1u << 22)
#define LAS __attribute__((address_space(3)))
__device__ __forceinline__ unsigned xb_ld(unsigned* p)              { return __hip_atomic_load(p, __ATOMIC_RELAXED, __HIP_MEMORY_SCOPE_AGENT); }
__device__ __forceinline__ unsigned xb_add(unsigned* p, unsigned v) { return __hip_atomic_fetch_add(p, v, __ATOMIC_RELAXED, __HIP_MEMORY_SCOPE_AGENT); }
__device__ __forceinline__ unsigned xb_xcc_id() { return (unsigned)__builtin_amdgcn_s_getreg((3 << 11) | 20) & 0xFu; }
#define XB_SPIN(cond, bar) do { unsigned _sp = 0; while (cond) { __builtin_amdgcn_s_sleep(1); \
    if ((++_sp & 255u) == 0u) { if (xb_ld(&(bar)[XB_TMO])) break; if (_sp > XB_SPIN_CAP) { atomicAdd(&(bar)[XB_TMO], 1u); break; } } } } while (0)
struct XcdBarrier { unsigned* bar; unsigned x; volatile LAS unsigned* st; };
__device__ __forceinline__ XcdBarrier xcd_barrier_post(unsigned* bar, volatile LAS unsigned* st) {
  XcdBarrier b; b.bar = bar; b.x = xb_xcc_id(); b.st = st;
  if (threadIdx.x == 0) (void)xb_add(&bar[XB_XCNT(b.x)], 1u);
  return b;
}
__device__ __forceinline__ void xcd_barrier_complete(unsigned* bar, unsigned x, unsigned& nloc, unsigned& nx) {
  const unsigned G = gridDim.x * gridDim.y * gridDim.z;
  unsigned sum, cnt, mine, sp = 0u;
  for (;;) {
    sum = 0u; cnt = 0u; mine = 0u;
#pragma unroll
    for (unsigned j = 0; j < 16; ++j) { const unsigned c = xb_ld(&bar[XB_XCNT(j)]); sum += c; cnt += (c > 0u) ? 1u : 0u; mine = (j == x) ? c : mine; }
    if (sum == G) break;
    __builtin_amdgcn_s_sleep(1);
    if ((++sp & 255u) == 0u) { if (xb_ld(&bar[XB_TMO])) break; if (sp > XB_SPIN_CAP) { atomicAdd(&bar[XB_TMO], 1u); break; } }
  }
  nloc = mine > 0u ? mine : 1u; nx = cnt > 0u ? cnt : 1u;
}
__device__ __forceinline__ void xcd_barrier(const XcdBarrier& b) {
  asm volatile("s_waitcnt vmcnt(0)" ::: "memory");
  __syncthreads();
  if (threadIdx.x == 0) {
    unsigned* bar = b.bar;
    __builtin_amdgcn_s_waitcnt(0);
    unsigned nloc = b.st[0], nx = b.st[1];
    if (nloc == 0u) { xcd_barrier_complete(bar, b.x, nloc, nx); b.st[0] = nloc; b.st[1] = nx; }
    const unsigned old = xb_add(&bar[XB_XSUB(b.x)], 1u);
    const unsigned gen = old / nloc;
    if (old + 1u == (gen + 1u) * nloc) {
      __builtin_amdgcn_fence(__ATOMIC_RELEASE, "agent");
      asm volatile("s_waitcnt vmcnt(0)" ::: "memory");
      const unsigned og = xb_add(&bar[XB_TOP], 1u);
      const unsigned tg = og / nx;
      if (og + 1u == (tg + 1u) * nx) xb_add(&bar[XB_TOPGEN], 1u);
      else XB_SPIN(xb_ld(&bar[XB_TOPGEN]) == tg, bar);
      __builtin_amdgcn_fence(__ATOMIC_ACQUIRE, "agent");
      xb_add(&bar[XB_XGEN(b.x)], 1u);
      asm volatile("s_waitcnt vmcnt(0)" ::: "memory");
    } else {
      XB_SPIN(xb_ld(&bar[XB_XGEN(b.x)]) == gen, bar);
      __builtin_amdgcn_fence(__ATOMIC_ACQUIRE, "agent");
      asm volatile("s_waitcnt vmcnt(0)" ::: "memory");
    }
  }
  __syncthreads();
}

__device__ void phase_init(const Params& p) {
  int* cnt = (int*)(p.ws + OFF_CNT);
  int* rowtok = (int*)(p.ws + OFF_ROWTOK);
  int gtid = blockIdx.x * NTHREADS + threadIdx.x;
  int gsz = gridDim.x * NTHREADS;
  if (gtid < 64) cnt[gtid] = 0;
  for (int i = gtid; i < ROWCAP; i += gsz) rowtok[i] = -1;
}

__device__ void transpose_convert(const float* src, u16* dst, int R, int C, int Cpad, int nbatch, char* smem) {
  float* tile = (float*)smem;
  int tr = R / 64, tc = Cpad / 64;
  int ntile = tr * tc * nbatch;
  int tid = threadIdx.x;
  for (int id = blockIdx.x; id < ntile; id += gridDim.x) {
    int b = id / (tr * tc), rem = id % (tr * tc);
    int r0 = (rem / tc) * 64, c0 = (rem % tc) * 64;
    const float* s = src + (size_t)b * R * C;
    u16* d = dst + (size_t)b * Cpad * R;
#pragma unroll
    for (int i = 0; i < 8; ++i) {
      int r = (tid >> 6) + 8 * i, c = tid & 63;
      float v = (c0 + c < C) ? s[(size_t)(r0 + r) * C + c0 + c] : 0.f;
      tile[r * 65 + c] = v;
    }
    __syncthreads();
    {
      int cc = tid >> 3, rg = tid & 7;
      u32 w[4];
#pragma unroll
      for (int i = 0; i < 4; ++i) w[i] = pack2bf(tile[(rg * 8 + 2 * i) * 65 + cc], tile[(rg * 8 + 2 * i + 1) * 65 + cc]);
      uint4 o; o.x = w[0]; o.y = w[1]; o.z = w[2]; o.w = w[3];
      *(uint4*)(d + (size_t)(c0 + cc) * R + r0 + rg * 8) = o;
    }
    __syncthreads();
  }
}

__device__ void phase_norm1(const Params& p) {
  u16* xn = (u16*)(p.ws + OFF_XN);
  int lane = threadIdx.x & 63, wid = threadIdx.x >> 6;
  int gw = blockIdx.x * 8 + wid, nw = gridDim.x * 8;
  for (int t = gw; t < T; t += nw) {
    const float4* xr = (const float4*)(p.x + (size_t)t * D);
    float4 v[4]; float ss = 0.f;
#pragma unroll
    for (int i = 0; i < 4; ++i) { v[i] = xr[lane + 64 * i]; ss += v[i].x * v[i].x + v[i].y * v[i].y + v[i].z * v[i].z + v[i].w * v[i].w; }
    ss = wave_sum(ss);
    float rstd = rsqrtf(ss * (1.f / D) + 1e-6f);
#pragma unroll
    for (int i = 0; i < 4; ++i) {
      float4 w = ((const float4*)p.norm1_w)[lane + 64 * i];
      uint2 o; o.x = pack2bf(v[i].x * rstd * w.x, v[i].y * rstd * w.y); o.y = pack2bf(v[i].z * rstd * w.z, v[i].w * rstd * w.w);
      *(uint2*)(xn + (size_t)t * D + (lane + 64 * i) * 4) = o;
    }
  }
}

enum { EPI_Z = 0, EPI_H1 = 1, EPI_GU = 2, EPI_DN = 3 };

struct GemmTile {
  const u16* A; int lda;
  const int* rowtok;
  int rowbase;
  const u16* Bt;
  int K; int n0;
  float* outf; u16* outh; const float* resid; const float* bias; int ldo;
};

template <int EPI, bool GATHER>
__device__ void gemm_tile(const GemmTile& g, char* smem) {
  const int tid = threadIdx.x, lane = tid & 63, wid = tid >> 6;
  const int wr = wid >> 1, wc = wid & 1, fr = lane & 15, fq = lane >> 4;
  const int K = g.K;
  const int ldrow = tid >> 3, ldc = tid & 7;
  const u16* ap[4]; bool aval[4];
#pragma unroll
  for (int i = 0; i < 4; ++i) {
    int r = g.rowbase + ldrow + 64 * i;
    if (GATHER) { int tk = g.rowtok[r]; aval[i] = tk >= 0; ap[i] = g.A + (size_t)(tk < 0 ? 0 : tk) * g.lda + ldc * 8; }
    else { aval[i] = true; ap[i] = g.A + (size_t)r * g.lda + ldc * 8; }
  }
  const u16* bp[2];
#pragma unroll
  for (int i = 0; i < 2; ++i) {
    int j = ldrow + 64 * i;
    int br = (EPI == EPI_GU) ? (((j >> 5) & 1) * 1024 + g.n0 + (j >> 6) * 32 + (j & 31)) : (g.n0 + j);
    bp[i] = g.Bt + (size_t)br * K + ldc * 8;
  }
  const int swz = ((ldc ^ (ldrow & 7)) << 4);
  uint4 ra[4], rb[2];
  auto gload = [&](int kt) {
#pragma unroll
    for (int i = 0; i < 4; ++i) { ra[i] = aval[i] ? *(const uint4*)(ap[i] + kt * 64) : make_uint4(0, 0, 0, 0); }
#pragma unroll
    for (int i = 0; i < 2; ++i) rb[i] = *(const uint4*)(bp[i] + kt * 64);
  };
  auto lwrite = [&](int buf) {
#pragma unroll
    for (int i = 0; i < 4; ++i) *(uint4*)(smem + buf * 49152 + (ldrow + 64 * i) * 128 + swz) = ra[i];
#pragma unroll
    for (int i = 0; i < 2; ++i) *(uint4*)(smem + buf * 49152 + 32768 + (ldrow + 64 * i) * 128 + swz) = rb[i];
  };
  f32x4 acc[4][4];
#pragma unroll
  for (int m = 0; m < 4; ++m)
#pragma unroll
    for (int n = 0; n < 4; ++n) acc[m][n] = (f32x4){0.f, 0.f, 0.f, 0.f};
  const int nk = K / 64;
  gload(0);
  lwrite(0);
  __syncthreads();
  for (int kt = 0; kt < nk; ++kt) {
    const int cur = kt & 1;
    if (kt + 1 < nk) gload(kt + 1);
#pragma unroll
    for (int kk = 0; kk < 2; ++kk) {
      bf16x8 af[4], bfr[4];
      const int cs = (((kk * 4 + fq) ^ (fr & 7)) << 4);
#pragma unroll
      for (int m = 0; m < 4; ++m) af[m] = *(const bf16x8*)(smem + cur * 49152 + (wr * 64 + m * 16 + fr) * 128 + cs);
#pragma unroll
      for (int n = 0; n < 4; ++n) bfr[n] = *(const bf16x8*)(smem + cur * 49152 + 32768 + (wc * 64 + n * 16 + fr) * 128 + cs);
#pragma unroll
      for (int m = 0; m < 4; ++m)
#pragma unroll
        for (int n = 0; n < 4; ++n) acc[m][n] = __builtin_amdgcn_mfma_f32_16x16x32_bf16(af[m], bfr[n], acc[m][n], 0, 0, 0);
    }
    if (kt + 1 < nk) lwrite(cur ^ 1);
    __syncthreads();
  }
#pragma unroll
  for (int m = 0; m < 4; ++m) {
#pragma unroll
    for (int j = 0; j < 4; ++j) {
      const int row = g.rowbase + wr * 64 + m * 16 + fq * 4 + j;
      if (EPI == EPI_Z) {
#pragma unroll
        for (int n = 0; n < 4; ++n) g.outf[(size_t)row * g.ldo + g.n0 + wc * 64 + n * 16 + fr] = acc[m][n][j];
      } else if (EPI == EPI_H1) {
#pragma unroll
        for (int n = 0; n < 4; ++n) {
          size_t o = (size_t)row * g.ldo + g.n0 + wc * 64 + n * 16 + fr;
          g.outf[o] = g.resid[o] + acc[m][n][j];
        }
      } else if (EPI == EPI_GU) {
#pragma unroll
        for (int n = 0; n < 2; ++n) {
          const int col = g.n0 + wc * 32 + n * 16 + fr;
          float glu = acc[m][n][j] + g.bias[col];
          float lin = acc[m][n + 2][j] + g.bias[1024 + col];
          glu = fminf(glu, 7.f);
          lin = fminf(fmaxf(lin, -7.f), 7.f);
          float a = (lin + 1.f) * glu * sigmoidf_(1.702f * glu);
          g.outh[(size_t)row * g.ldo + col] = f2bf(a);
        }
      } else {
#pragma unroll
        for (int n = 0; n < 4; ++n) {
          const int col = g.n0 + wc * 64 + n * 16 + fr;
          g.outh[(size_t)row * g.ldo + col] = f2bf(acc[m][n][j] + g.bias[col]);
        }
      }
    }
  }
}

__device__ void phase_gemm_in(const Params& p, char* smem) {
  GemmTile g{};
  g.A = (const u16*)(p.ws + OFF_XN); g.lda = D; g.rowtok = nullptr;
  g.Bt = (const u16*)(p.ws + OFF_WINT); g.K = D;
  g.outf = (float*)(p.ws + OFF_Z); g.ldo = DINP;
  constexpr int NT = DINP / 128, MT = T / 256;
  for (int id = blockIdx.x; id < NT * MT; id += gridDim.x) {
    g.rowbase = (id / NT) * 256; g.n0 = (id % NT) * 128;
    gemm_tile<EPI_Z, false>(g, smem);
  }
}

__device__ void phase_post_attn(const Params& p) {
  const float* z = (const float*)(p.ws + OFF_Z);
  u16* qr = (u16*)(p.ws + OFF_QR); u16* kr = (u16*)(p.ws + OFF_KR); u16* vv = (u16*)(p.ws + OFF_VV);
  u16* iq = (u16*)(p.ws + OFF_IQ); u16* ik = (u16*)(p.ws + OFF_IK); float* iw = (float*)(p.ws + OFF_IW);
  const float INVF8[8] = {1.0f, 0.1939227432012558f, 0.03760603070259094f, 0.007292664609849453f,
                          0.0014142135623842478f, 0.00027424818836152554f, 5.318296098266728e-05f, 1.0313386155758053e-05f};
  const float INVF4[4] = {1.0f, 0.03760603070259094f, 0.0014142135623842478f, 5.318296098266728e-05f};
  int lane = threadIdx.x & 63, wid = threadIdx.x >> 6;
  int gw = blockIdx.x * 8 + wid, nw = gridDim.x * 8;
  const int sub = lane & 7;
  float* qsh = (float*)(p.ws + OFF_QSH);
  float kwmax = fabsf(p.k_norm_w[lane]);
#pragma unroll
  for (int o = 32; o >= 1; o >>= 1) kwmax = fmaxf(kwmax, __shfl_xor(kwmax, o));
  for (int t = gw; t < T; t += nw) {
    const float* zr = z + (size_t)t * DINP;
    const float pos = (float)p.positions[t];
    float cs8[8], sn8[8];
#pragma unroll
    for (int i = 0; i < 8; ++i) sincos_big(pos * INVF8[i], sn8[i], cs8[i]);
#pragma unroll
    for (int which = 0; which < 2; ++which) {
      const float* src = zr + (which ? C_K : C_Q) + lane * 8;
      const float* nw_ = (which ? p.k_norm_w : p.q_norm_w) + sub * 8;
      float4 a = *(const float4*)src, b = *(const float4*)(src + 4);
      float v[8] = {a.x, a.y, a.z, a.w, b.x, b.y, b.z, b.w};
      float ss = 0.f;
#pragma unroll
      for (int i = 0; i < 8; ++i) ss += v[i] * v[i];
      ss += __shfl_xor(ss, 1); ss += __shfl_xor(ss, 2); ss += __shfl_xor(ss, 4);
      float rstd = rsqrtf(ss * (1.f / 64.f) + 1e-6f);
      float y[8], o[8];
#pragma unroll
      for (int i = 0; i < 8; ++i) y[i] = v[i] * rstd * nw_[i];
#pragma unroll
      for (int i = 0; i < 8; ++i) {
        float oth = __shfl_xor(y[i], 1);
        float r0 = y[i] * cs8[i] - oth * sn8[i];
        float r1 = y[i] * cs8[i] + oth * sn8[i];
        o[i] = (sub == 0) ? r0 : ((sub == 1) ? r1 : y[i]);
      }
      const float sc = which ? 1.f : (0.125f * 1.4426950408889634f);
      u32 hw[4]; float n2 = 0.f;
#pragma unroll
      for (int i = 0; i < 4; ++i) {
        __half h0 = __float2half_rn(o[2 * i] * sc), h1 = __float2half_rn(o[2 * i + 1] * sc);
        float f0 = __half2float(h0), f1 = __half2float(h1);
        n2 += f0 * f0 + f1 * f1;
        hw[i] = (u32)__half_as_ushort(h0) | ((u32)__half_as_ushort(h1) << 16);
      }
      uint4 w; w.x = hw[0]; w.y = hw[1]; w.z = hw[2]; w.w = hw[3];
      const int hd = lane >> 3;
      *(uint4*)((which ? kr : qr) + ((size_t)hd * T + t) * 64 + sub * 8) = w;
      if (which == 0) {
        n2 += __shfl_xor(n2, 1); n2 += __shfl_xor(n2, 2); n2 += __shfl_xor(n2, 4);
        if (sub == 0) qsh[(size_t)hd * T + t] = sqrtf(n2) * 8.f * kwmax * 1.01f;
      }
    }
    {
      const float* src = zr + C_V + lane * 8;
      float4 a = *(const float4*)src, b = *(const float4*)(src + 4);
      float v[8] = {a.x, a.y, a.z, a.w, b.x, b.y, b.z, b.w};
      u32 hw[4];
#pragma unroll
      for (int i = 0; i < 4; ++i) hw[i] = (u32)__half_as_ushort(__float2half_rn(v[2 * i])) | ((u32)__half_as_ushort(__float2half_rn(v[2 * i + 1])) << 16);
      uint4 w; w.x = hw[0]; w.y = hw[1]; w.z = hw[2]; w.w = hw[3];
      *(uint4*)(vv + ((size_t)(lane >> 3) * T + t) * 64 + sub * 8) = w;
    }
    float cs4[4], sn4[4];
#pragma unroll
    for (int i = 0; i < 4; ++i) sincos_big(pos * INVF4[i], sn4[i], cs4[i]);
    {
      float4 a = *(const float4*)(zr + C_IQ + lane * 4);
      float y[4] = {a.x, a.y, a.z, a.w}, o[4];
#pragma unroll
      for (int i = 0; i < 4; ++i) {
        float oth = __shfl_xor(y[i], 1);
        float r0 = y[i] * cs4[i] - oth * sn4[i];
        float r1 = y[i] * cs4[i] + oth * sn4[i];
        o[i] = (sub == 0) ? r0 : ((sub == 1) ? r1 : y[i]);
      }
      uint2 w; w.x = pack2bf(o[0], o[1]); w.y = pack2bf(o[2], o[3]);
      *(uint2*)(iq + (size_t)t * 256 + lane * 4) = w;
    }
    {
      float4 a = (lane < 8) ? *(const float4*)(zr + C_IK + lane * 4) : make_float4(0, 0, 0, 0);
      float y[4] = {a.x, a.y, a.z, a.w}, o[4];
#pragma unroll
      for (int i = 0; i < 4; ++i) {
        float oth = __shfl_xor(y[i], 1);
        float r0 = y[i] * cs4[i] - oth * sn4[i];
        float r1 = y[i] * cs4[i] + oth * sn4[i];
        o[i] = (sub == 0) ? r0 : ((sub == 1) ? r1 : y[i]);
      }
      if (lane < 8) {
        uint2 w; w.x = pack2bf(o[0], o[1]); w.y = pack2bf(o[2], o[3]);
        *(uint2*)(ik + (size_t)t * 32 + lane * 4) = w;
        iw[(size_t)t * 8 + lane] = zr[C_IW + lane];
      }
    }
  }
}

__device__ void phase_post_rwkv(const Params& p, char* smem) {
  const float* z = (const float*)(p.ws + OFF_Z);
  float* sv = (float*)(p.ws + OFF_SV); float* G = (float*)(p.ws + OFF_G); float* BON = (float*)(p.ws + OFF_BONUS);
  float* lora = (float*)smem;
  const int tid = threadIdx.x, lane = tid & 63, h = tid >> 6, c = tid;
  const float mu_r = p.rwkv_mu[c], mu_k = p.rwkv_mu[512 + c], mu_v = p.rwkv_mu[1024 + c];
  const float w0 = p.rwkv_w0[c], a0 = p.rwkv_a0[c], kkw = p.rwkv_k_k[c], kaw = p.rwkv_k_a[c], rkw = p.rwkv_r_k[c];
  for (int tg = blockIdx.x; tg < T / 8; tg += gridDim.x) {
    const int t0 = tg * 8;
#pragma unroll
    for (int i = 0; i < 2; ++i) {
      int item = tid + 512 * i, tok = item >> 7, j = item & 127, t = t0 + tok;
      int col = C_RW + 1536 + j;
      float zc = z[(size_t)t * DINP + col];
      float zp = (t > 0) ? z[(size_t)(t - 1) * DINP + col] : 0.f;
      float xs = zc + (zp - zc) * p.rwkv_mu[1536 + j];
      float o = (j < 32) ? tanhf(xs) : ((j < 64) ? xs : sigmoidf_(xs));
      lora[tok * 128 + j] = o;
    }
    __syncthreads();
    float aw[8], aa[8], ag[8];
#pragma unroll
    for (int k = 0; k < 8; ++k) { aw[k] = 0.f; aa[k] = 0.f; ag[k] = 0.f; }
    for (int j = 0; j < 32; ++j) {
      float w = p.rwkv_w2[j * 512 + c], a = p.rwkv_a2[j * 512 + c];
#pragma unroll
      for (int k = 0; k < 8; ++k) { aw[k] += lora[k * 128 + j] * w; aa[k] += lora[k * 128 + 32 + j] * a; }
    }
    for (int j = 0; j < 64; ++j) {
      float gg = p.rwkv_g2[j * 512 + c];
#pragma unroll
      for (int k = 0; k < 8; ++k) ag[k] += lora[k * 128 + 64 + j] * gg;
    }
#pragma unroll
    for (int k = 0; k < 8; ++k) {
      const int t = t0 + k;
      const float* zr = z + (size_t)t * DINP + C_RW;
      const float* zq = zr - DINP;
      float rc = zr[c], kc = zr[512 + c], vc = zr[1024 + c];
      float rp = 0.f, kp = 0.f, vp = 0.f;
      if (t > 0) { rp = zq[c]; kp = zq[512 + c]; vp = zq[1024 + c]; }
      float r = rc + (rp - rc) * mu_r, kx = kc + (kp - kc) * mu_k, v = vc + (vp - vc) * mu_v;
      float xw = -(w0 + aw[k]);
      float sp = fmaxf(xw, 0.f) + log1pf(__expf(-fabsf(xw)));
      float logw = -sp - 0.5f;
      float decay = __expf(-__expf(logw));
      float a = sigmoidf_(a0 + aa[k]);
      float kk = kx * kkw;
      float ss = wave_sum(kk * kk);
      kk *= rsqrtf(fmaxf(ss, 1e-24f));
      float kmod = kx * (1.f + (a - 1.f) * kaw);
      float bon = wave_sum(r * kmod * rkw);
      float* o = sv + ((size_t)t * 8 + h) * 384 + lane;
      o[0] = decay; o[64] = kk; o[128] = kk * a; o[192] = kmod; o[256] = r; o[320] = v;
      G[(size_t)t * 512 + c] = ag[k];
      if (lane == 0) BON[(size_t)t * 8 + h] = bon;
    }
    __syncthreads();
  }
}

typedef float f2 __attribute__((ext_vector_type(2)));
#define SB_ __builtin_amdgcn_sched_barrier(0)
#define PIN16(o) asm volatile("" : "+v"(S2[o+0]), "+v"(S2[o+1]), "+v"(S2[o+2]), "+v"(S2[o+3]), "+v"(S2[o+4]), "+v"(S2[o+5]), "+v"(S2[o+6]), "+v"(S2[o+7]), \
    "+v"(S2[o+8]), "+v"(S2[o+9]), "+v"(S2[o+10]), "+v"(S2[o+11]), "+v"(S2[o+12]), "+v"(S2[o+13]), "+v"(S2[o+14]), "+v"(S2[o+15]) :: "memory")
#define PIN2(a, b) asm volatile("" : "+v"(a), "+v"(b) :: "memory")
#define SC_LO(v) ((f2){(v)[0], (v)[1]})
#define SC_HI(v) ((f2){(v)[2], (v)[3]})

__device__ __forceinline__ void sc_rd8(f32x4 (&B)[8], const f32x4* ptr) {
#pragma unroll
  for (int j = 0; j < 8; ++j) B[j] = ptr[j];
}

template <int MODE>
__device__ void scan_task(const Params& p, int h, int c, float* wl  ) {
  const int lane = threadIdx.x & 63;
  const float* sv = (const float*)(p.ws + OFF_SV);
  f2 S2[32];
  if (MODE == 0) {
#pragma unroll
    for (int j = 0; j < 32; ++j) S2[j] = (f2){(2 * j == lane) ? 1.f : 0.f, (2 * j + 1 == lane) ? 1.f : 0.f};
  } else if (MODE == 1) {
#pragma unroll
    for (int j = 0; j < 32; ++j) S2[j] = (f2){0.f, 0.f};
  } else {
    const float4* si = (const float4*)((const float*)(p.ws + OFF_SI) + ((size_t)(h * NCH + c) * 64 + lane) * 64);
#pragma unroll
    for (int j = 0; j < 16; ++j) { float4 v = si[j]; S2[2 * j] = (f2){v.x, v.y}; S2[2 * j + 1] = (f2){v.z, v.w}; }
  }
  float* Y = (float*)(p.ws + OFF_Y);
  const float* src = sv + ((size_t)(c * CHL) * 8 + h) * 384;
  const int f0 = lane, f1 = lane + 64, f2_ = lane + 128, f3 = lane + 192, f4 = lane + 256, f5 = lane + 320;
  const int go0 = (f0 / 96) * 3072 + (f0 % 96) * 4, go1 = (f1 / 96) * 3072 + (f1 % 96) * 4, go2 = (f2_ / 96) * 3072 + (f2_ % 96) * 4;
  const int go3 = (f3 / 96) * 3072 + (f3 % 96) * 4, go4 = (f4 / 96) * 3072 + (f4 % 96) * 4, go5 = (f5 / 96) * 3072 + (f5 % 96) * 4;
#define SCAN_DMA(base, ldsbuf) do { \
    __builtin_amdgcn_global_load_lds((const unsigned*)((base) + go0), (LAS unsigned*)(ldsbuf), 16, 0, 0); \
    __builtin_amdgcn_global_load_lds((const unsigned*)((base) + go1), (LAS unsigned*)((ldsbuf) + 256), 16, 0, 0); \
    __builtin_amdgcn_global_load_lds((const unsigned*)((base) + go2), (LAS unsigned*)((ldsbuf) + 512), 16, 0, 0); \
    __builtin_amdgcn_global_load_lds((const unsigned*)((base) + go3), (LAS unsigned*)((ldsbuf) + 768), 16, 0, 0); \
    __builtin_amdgcn_global_load_lds((const unsigned*)((base) + go4), (LAS unsigned*)((ldsbuf) + 1024), 16, 0, 0); \
    __builtin_amdgcn_global_load_lds((const unsigned*)((base) + go5), (LAS unsigned*)((ldsbuf) + 1280), 16, 0, 0); } while (0)
  SCAN_DMA(src, wl);
  constexpr int NG = CHL / 4;
  f32x4 X[8], Yb[8];
  for (int g = 0; g < NG; ++g) {
    asm volatile("s_waitcnt vmcnt(0)" ::: "memory");
    if (g + 1 < NG) SCAN_DMA(src + (size_t)(g + 1) * 4 * 3072, wl + ((g + 1) & 1) * 1536);
    const float* Lb = wl + (g & 1) * 1536;
    sc_rd8(X, (const f32x4*)Lb + 16);
    SB_;
#pragma unroll 1
    for (int st = 0; st < 4; ++st) {
      const f32x4* pv = (const f32x4*)(Lb + st * 384);
      f2 da = (f2){0.f, 0.f}, db = (f2){0.f, 0.f};
      sc_rd8(Yb, pv + 24); SB_;
#pragma unroll
      for (int j = 0; j < 8; ++j) { da += S2[2 * j] * SC_LO(X[j]); db += S2[2 * j + 1] * SC_HI(X[j]); }
      PIN2(da, db);
      SB_;
      sc_rd8(X, pv + 0); SB_;
#pragma unroll
      for (int j = 0; j < 8; ++j) { da += S2[16 + 2 * j] * SC_LO(Yb[j]); db += S2[16 + 2 * j + 1] * SC_HI(Yb[j]); }
      PIN2(da, db);
      float vi = 0.f;
      if (MODE != 0) vi = Lb[st * 384 + 320 + lane];
      SB_;
      const float nsa = -((da[0] + da[1]) + (db[0] + db[1]));
      const f2 nsa2 = (f2){nsa, nsa};
      sc_rd8(Yb, pv + 8); SB_;
#pragma unroll
      for (int j = 0; j < 8; ++j) { S2[2 * j] *= SC_LO(X[j]); S2[2 * j + 1] *= SC_HI(X[j]); }
      PIN16(0);
      SB_;
      sc_rd8(X, pv + 32); SB_;
#pragma unroll
      for (int j = 0; j < 8; ++j) { S2[16 + 2 * j] *= SC_LO(Yb[j]); S2[16 + 2 * j + 1] *= SC_HI(Yb[j]); }
      PIN16(16);
      SB_;
      sc_rd8(Yb, pv + 40); SB_;
#pragma unroll
      for (int j = 0; j < 8; ++j) { S2[2 * j] += nsa2 * SC_LO(X[j]); S2[2 * j + 1] += nsa2 * SC_HI(X[j]); }
      PIN16(0);
      SB_;
      if (MODE != 0) sc_rd8(X, pv + 48); else sc_rd8(X, pv + 96 + 16);
      SB_;
#pragma unroll
      for (int j = 0; j < 8; ++j) { S2[16 + 2 * j] += nsa2 * SC_LO(Yb[j]); S2[16 + 2 * j + 1] += nsa2 * SC_HI(Yb[j]); }
      PIN16(16);
      SB_;
      if (MODE != 0) {
        const f2 vi2 = (f2){vi, vi};
        sc_rd8(Yb, pv + 56); SB_;
#pragma unroll
        for (int j = 0; j < 8; ++j) { S2[2 * j] += vi2 * SC_LO(X[j]); S2[2 * j + 1] += vi2 * SC_HI(X[j]); }
      PIN16(0);
        SB_;
        if (MODE == 2) sc_rd8(X, pv + 64); else sc_rd8(X, pv + 96 + 16);
        SB_;
#pragma unroll
        for (int j = 0; j < 8; ++j) { S2[16 + 2 * j] += vi2 * SC_LO(Yb[j]); S2[16 + 2 * j + 1] += vi2 * SC_HI(Yb[j]); }
      PIN16(16);
        SB_;
      }
      if (MODE == 2) {
        f2 ya = (f2){0.f, 0.f}, yb = (f2){0.f, 0.f};
        sc_rd8(Yb, pv + 72); SB_;
#pragma unroll
        for (int j = 0; j < 8; ++j) { ya += S2[2 * j] * SC_LO(X[j]); yb += S2[2 * j + 1] * SC_HI(X[j]); }
      PIN2(ya, yb);
        SB_;
        sc_rd8(X, pv + 96 + 16);
        SB_;
#pragma unroll
        for (int j = 0; j < 8; ++j) { ya += S2[16 + 2 * j] * SC_LO(Yb[j]); yb += S2[16 + 2 * j + 1] * SC_HI(Yb[j]); }
      PIN2(ya, yb);
        SB_;
        Y[(size_t)(c * CHL + g * 4 + st) * 512 + h * 64 + lane] = (ya[0] + ya[1]) + (yb[0] + yb[1]);
      }
    }
  }
  if (MODE != 2) {
    float4* o = (float4*)((float*)(p.ws + (MODE == 0 ? OFF_SP : OFF_SL)) + ((size_t)(h * NCH + c) * 64 + lane) * 64);
#pragma unroll
    for (int j = 0; j < 16; ++j) o[j] = make_float4(S2[2 * j][0], S2[2 * j][1], S2[2 * j + 1][0], S2[2 * j + 1][1]);
  }
}

__device__ void phase_scan_a(const Params& p, char* smem) {
  const int wid = __builtin_amdgcn_readfirstlane(threadIdx.x >> 6);
  float* wl = (float*)smem + wid * 3072;
  const int nw = gridDim.x * 8;
  for (int id = wid * (int)gridDim.x + (int)blockIdx.x; id < 8 * NCH; id += nw) scan_task<0>(p, id & 7, id >> 3, wl);
  for (int id = wid * (int)gridDim.x + (int)blockIdx.x; id < 16 * NCH; id += nw) { if (id >= 8 * NCH) scan_task<1>(p, id & 7, (id - 8 * NCH) >> 3, wl); }
}

__device__ void phase_scan_b_impl(const Params& p, char* smem) {
  const int h = blockIdx.x, tid = threadIdx.x;
  float* Ss = (float*)smem;
  float* Ps = Ss + 64 * 65;
  const float* SP = (const float*)(p.ws + OFF_SP) + (size_t)h * NCH * 4096;
  const float* SL = (const float*)(p.ws + OFF_SL) + (size_t)h * NCH * 4096;
  float* SI = (float*)(p.ws + OFF_SI) + (size_t)h * NCH * 4096;
  const int i = tid >> 3, jg = tid & 7;
  for (int e = tid; e < 4096; e += 512) { Ss[(e >> 6) * 65 + (e & 63)] = 0.f; SI[e] = 0.f; }
  for (int c = 0; c < NCH - 1; ++c) {
    for (int e = tid; e < 4096; e += 512) Ps[e] = SP[(size_t)c * 4096 + e];
    __syncthreads();
    float acc[8];
#pragma unroll
    for (int u = 0; u < 8; ++u) acc[u] = SL[(size_t)c * 4096 + i * 64 + jg * 8 + u];
    for (int k = 0; k < 64; ++k) {
      float s = Ss[i * 65 + k];
      float4 p0 = *(const float4*)(Ps + k * 64 + jg * 8), p1 = *(const float4*)(Ps + k * 64 + jg * 8 + 4);
      acc[0] += s * p0.x; acc[1] += s * p0.y; acc[2] += s * p0.z; acc[3] += s * p0.w;
      acc[4] += s * p1.x; acc[5] += s * p1.y; acc[6] += s * p1.z; acc[7] += s * p1.w;
    }
    __syncthreads();
#pragma unroll
    for (int u = 0; u < 8; ++u) { Ss[i * 65 + jg * 8 + u] = acc[u]; SI[(size_t)(c + 1) * 4096 + i * 64 + jg * 8 + u] = acc[u]; }
    __syncthreads();
  }
}

__device__ void phase_scan_b(const Params& p, char* smem) { if (blockIdx.x < 8) phase_scan_b_impl(p, smem); }

__device__ void phase_scan_c(const Params& p, char* smem) {
  const int wid = __builtin_amdgcn_readfirstlane(threadIdx.x >> 6);
  float* wl = (float*)smem + wid * 3072;
  const int nw = gridDim.x * 8;
  for (int id = wid * (int)gridDim.x + (int)blockIdx.x; id < 8 * NCH; id += nw) scan_task<2>(p, id & 7, id >> 3, wl);
}

__device__ void phase_rwkv_out(const Params& p) {
  const float* Y = (const float*)(p.ws + OFF_Y); const float* sv = (const float*)(p.ws + OFF_SV);
  const float* G = (const float*)(p.ws + OFF_G); const float* BON = (const float*)(p.ws + OFF_BONUS);
  u16* mix = (u16*)(p.ws + OFF_MIX);
  const int tid = threadIdx.x, lane = tid & 63, h = tid >> 6;
  const float lw = p.rwkv_ln_w[tid], lb = p.rwkv_ln_b[tid];
  for (int t = blockIdx.x; t < T; t += gridDim.x) {
    float y = Y[(size_t)t * 512 + tid];
    float mean = wave_sum(y) * (1.f / 64.f);
    float d = y - mean;
    float var = wave_sum(d * d) * (1.f / 64.f);
    float o = d * rsqrtf(var + 64e-5f) * lw + lb;
    float v = sv[((size_t)t * 8 + h) * 384 + 320 + lane];
    o = (o + BON[(size_t)t * 8 + h] * v) * G[(size_t)t * 512 + tid];
    mix[(size_t)t * 1024 + 512 + tid] = f2bf(o);
  }
}

__device__ __forceinline__ u16 score_key(float s) {
  s = fminf(fmaxf(s, -60000.f), 60000.f);
  u16 b = __half_as_ushort(__float2half_rn(s));
  return (b & 0x8000u) ? (u16)(~b) : (u16)(b | 0x8000u);
}

__device__ void topk_select(const u16* keys, u32* hq, u32* h2, int t, u16* selout, int lane) {
  const int n = t + 1;
  u32 ssum = 0;
#pragma unroll
  for (int d = 0; d < 16; ++d) { u32 v = hq[16 * lane + d]; ssum += (v & 0xFFFFu) + (v >> 16); }
  u32 suf = ssum;
#pragma unroll
  for (int off = 1; off < 64; off <<= 1) { u32 o = __shfl_down(suf, off); if (lane + off < 64) suf += o; }
  unsigned long long m = __ballot(suf >= 256u);
  const int Ls = 63 - __clzll(m);
  const u32 above = __shfl(suf, Ls) - __shfl(ssum, Ls);
  u32 c1 = 0;
  if (lane < 32) { u32 v = hq[16 * Ls + (lane >> 1)]; c1 = (lane & 1) ? (v >> 16) : (v & 0xFFFFu); }
  u32 suf2 = c1;
#pragma unroll
  for (int off = 1; off < 32; off <<= 1) { u32 o = __shfl_down(suf2, off); if (lane + off < 64) suf2 += o; }
  unsigned long long m2 = __ballot((lane < 32) && (above + suf2 >= 256u));
  const int js = 63 - __clzll(m2);
  const u32 Bs = (u32)(32 * Ls + js);
  const u32 cnt_above = above + __shfl(suf2, js) - __shfl(c1, js);
  const int niter = (n + 511) >> 9;
  for (int it = 0; it < niter; ++it) {
    const int base = it * 512 + lane * 8;
    uint4 kv = *(const uint4*)(keys + base);
    u32 w[4] = {kv.x, kv.y, kv.z, kv.w};
#pragma unroll
    for (int e = 0; e < 8; ++e) {
      u32 k = (w[e >> 1] >> ((e & 1) * 16)) & 0xFFFFu;
      if ((base + e < n) && ((k >> 5) == Bs)) atomicAdd(&h2[k & 31u], 1u);
    }
  }
  __threadfence_block();
  const u32 need = 256u - cnt_above;
  u32 c2 = (lane < 32) ? h2[lane] : 0u;
  u32 suf3 = c2;
#pragma unroll
  for (int off = 1; off < 32; off <<= 1) { u32 o = __shfl_down(suf3, off); if (lane + off < 64) suf3 += o; }
  unsigned long long m3 = __ballot((lane < 32) && (suf3 >= need));
  const int vs = 63 - __clzll(m3);
  const u32 Kstar = (Bs << 5) | (u32)vs;
  const u32 cnt_gt = cnt_above + __shfl(suf3, vs) - __shfl(c2, vs);
  const u32 need_eq = 256u - cnt_gt;
  u32 base_gt = 0, base_eq = 0;
  for (int it = 0; it < niter; ++it) {
    const int base = it * 512 + lane * 8;
    uint4 kv = *(const uint4*)(keys + base);
    u32 w[4] = {kv.x, kv.y, kv.z, kv.w};
    u32 gtm = 0, eqm = 0;
#pragma unroll
    for (int e = 0; e < 8; ++e) {
      u32 k = (w[e >> 1] >> ((e & 1) * 16)) & 0xFFFFu;
      bool valid = (base + e < n);
      if (valid && k > Kstar) gtm |= (1u << e);
      if (valid && k == Kstar) eqm |= (1u << e);
    }
    u32 packed = __popc(gtm) | (__popc(eqm) << 16);
    u32 incl = packed;
#pragma unroll
    for (int off = 1; off < 64; off <<= 1) { u32 o = __shfl_up(incl, off); if (lane >= off) incl += o; }
    u32 excl = incl - packed;
    u32 tot = __shfl(incl, 63);
    u32 gb = base_gt + (excl & 0xFFFFu), eb = base_eq + (excl >> 16);
#pragma unroll
    for (int e = 0; e < 8; ++e) {
      u32 bit = 1u << e;
      u32 g_before = gb + __popc(gtm & (bit - 1u));
      u32 e_before = eb + __popc(eqm & (bit - 1u));
      if (gtm & bit) selout[g_before + min(e_before, need_eq)] = (u16)(base + e);
      else if ((eqm & bit) && e_before < need_eq) selout[g_before + e_before] = (u16)(base + e);
    }
    base_gt += tot & 0xFFFFu; base_eq += tot >> 16;
  }
}

__device__ void phase_topk(const Params& p, char* smem) {
  u16* keys = (u16*)smem;
  u32* hist = (u32*)(smem + 131072);
  u32* hist2 = hist + 4096;
  const u16* iq = (const u16*)(p.ws + OFF_IQ); const u16* ik = (const u16*)(p.ws + OFF_IK);
  const float* iw = (const float*)(p.ws + OFF_IW);
  u16* sel = (u16*)(p.ws + OFF_SEL);
  const int tid = threadIdx.x, lane = tid & 63, wid = tid >> 6;
  const int r = lane & 31, hh = lane >> 5;
  const int ngroups = (T - 256) / 4;
  const int nrounds = (ngroups + gridDim.x - 1) / gridDim.x;
  for (int rr = 0; rr < nrounds; ++rr) {
    const int gsel = rr * gridDim.x + ((rr & 1) ? (gridDim.x - 1 - blockIdx.x) : blockIdx.x);
    if (gsel >= ngroups) continue;
    const int t0 = 256 + gsel * 4;
    for (int i = tid; i < 4096 + 128; i += NTHREADS) hist[i] = 0u;
    __syncthreads();
    const u16* iqp = iq + ((size_t)(t0 + (r & 3)) * 8 + (r >> 2)) * 32 + 8 * hh;
    const bf16x8 a0 = *(const bf16x8*)iqp, a1 = *(const bf16x8*)(iqp + 16);
    float wq[16];
#pragma unroll
    for (int i = 0; i < 16; ++i) wq[i] = iw[(size_t)(t0 + (i & 3)) * 8 + 2 * (i >> 2) + hh];
    const int ntiles = (t0 + 4 + 31) >> 5;
#define TK_LOAD(KT, B0, B1) do { if ((KT) < ntiles) { const u16* ikp_ = ik + (size_t)((KT) * 32 + r) * 32 + 8 * hh; \
      B0 = *(const bf16x8*)ikp_; B1 = *(const bf16x8*)(ikp_ + 16); } } while (0)
#define TK_PROC(KT, B0, B1) do { \
      const int key = (KT) * 32 + r; \
      f32x16 acc; \
      _Pragma("unroll") for (int i_ = 0; i_ < 16; ++i_) acc[i_] = 0.f; \
      acc = __builtin_amdgcn_mfma_f32_32x32x16_bf16(a0, B0, acc, 0, 0, 0); \
      acc = __builtin_amdgcn_mfma_f32_32x32x16_bf16(a1, B1, acc, 0, 0, 0); \
      float s0 = 0.f, s1 = 0.f, s2 = 0.f, s3 = 0.f; \
      _Pragma("unroll") for (int i_ = 0; i_ < 16; i_ += 4) { \
        s0 += wq[i_] * fmaxf(acc[i_], 0.f); s1 += wq[i_ + 1] * fmaxf(acc[i_ + 1], 0.f); \
        s2 += wq[i_ + 2] * fmaxf(acc[i_ + 2], 0.f); s3 += wq[i_ + 3] * fmaxf(acc[i_ + 3], 0.f); } \
      auto sw01 = __builtin_amdgcn_permlane32_swap(__float_as_uint(s0), __float_as_uint(s1), false, false); \
      auto sw23 = __builtin_amdgcn_permlane32_swap(__float_as_uint(s2), __float_as_uint(s3), false, false); \
      const float sa = __uint_as_float(sw01[0]) + __uint_as_float(sw01[1]);     \
      const float sb = __uint_as_float(sw23[0]) + __uint_as_float(sw23[1]);     \
      { const int qa = hh; bool valid = key <= t0 + qa; u16 k16 = valid ? score_key(sa) : (u16)0; keys[qa * 16384 + key] = k16; \
        if (valid) { u32 bin = k16 >> 5; atomicAdd(&hist[qa * 1024 + (bin >> 1)], (bin & 1u) ? 0x10000u : 1u); } } \
      { const int qb = 2 + hh; bool valid = key <= t0 + qb; u16 k16 = valid ? score_key(sb) : (u16)0; keys[qb * 16384 + key] = k16; \
        if (valid) { u32 bin = k16 >> 5; atomicAdd(&hist[qb * 1024 + (bin >> 1)], (bin & 1u) ? 0x10000u : 1u); } } \
    } while (0)
    {
      bf16x8 bA0, bA1, bB0, bB1, bC0, bC1, bD0, bD1;
      bA0 = bA1 = bB0 = bB1 = bC0 = bC1 = bD0 = bD1 = a0;
      int kt = wid;
      TK_LOAD(kt, bA0, bA1); TK_LOAD(kt + 8, bB0, bB1); TK_LOAD(kt + 16, bC0, bC1); TK_LOAD(kt + 24, bD0, bD1);
      for (; kt < ntiles; kt += 32) {
        TK_PROC(kt, bA0, bA1); TK_LOAD(kt + 32, bA0, bA1);
        if (kt + 8 < ntiles) { TK_PROC(kt + 8, bB0, bB1); TK_LOAD(kt + 40, bB0, bB1); }
        if (kt + 16 < ntiles) { TK_PROC(kt + 16, bC0, bC1); TK_LOAD(kt + 48, bC0, bC1); }
        if (kt + 24 < ntiles) { TK_PROC(kt + 24, bD0, bD1); TK_LOAD(kt + 56, bD0, bD1); }
      }
    }
    __syncthreads();
    if (wid < 4) topk_select(keys + wid * 16384, hist + wid * 1024, hist2 + wid * 32, t0 + wid, sel + (size_t)(t0 + wid) * 256, lane);
    __syncthreads();
  }
}

typedef _Float16 h2_t __attribute__((ext_vector_type(2)));
__device__ __forceinline__ float dot2h(u32 a, u32 b, float c) { return __builtin_amdgcn_fdot2(__builtin_bit_cast(h2_t, a), __builtin_bit_cast(h2_t, b), c, false); }
__device__ __forceinline__ float hlo(u32 a) { return (float)(__builtin_bit_cast(h2_t, a)[0]); }
__device__ __forceinline__ float hhi(u32 a) { return (float)(__builtin_bit_cast(h2_t, a)[1]); }

__device__ __forceinline__ float dpp_xor1(float v) {
  return __uint_as_float(__builtin_amdgcn_update_dpp(0u, __float_as_uint(v), 0xB1, 0xF, 0xF, true));
}

__device__ void phase_attn(const Params& p, char* smem) {
  const u16* qh = (const u16*)(p.ws + OFF_QR); const u16* kh = (const u16*)(p.ws + OFF_KR); const u16* vh = (const u16*)(p.ws + OFF_VV);
  const u16* sel = (const u16*)(p.ws + OFF_SEL); const float* qsh = (const float*)(p.ws + OFF_QSH);
  u16* mix = (u16*)(p.ws + OFF_MIX);
  uint4* sK = (uint4*)smem;
  uint4* sV = (uint4*)(smem + 65536);
  const int tid = threadIdx.x;
  const int ql = tid >> 1, hp = tid & 1, rot = (tid >> 1) & 3;
  for (int it2 = 0; it2 < 2; ++it2) {
    const int item0 = it2 ? (511 - (int)blockIdx.x) : (int)blockIdx.x;
    for (int item = item0; item >= 0 && item < 512; item += (it2 ? -(int)gridDim.x : (int)gridDim.x)) {
      if (it2 == 0 && item >= 256) break;
      if (it2 == 1 && item < 256) break;
      const int h = item & 7, qb = item >> 3;
      const int t = qb * 256 + ql;
      const uint4* qp = (const uint4*)(qh + ((size_t)h * T + t) * 64) + 4 * hp;
      const uint4 q0 = qp[(0 + rot) & 3], q1 = qp[(1 + rot) & 3], q2 = qp[(2 + rot) & 3], q3 = qp[(3 + rot) & 3];
      const float nshift = -0.5f * qsh[(size_t)h * T + t];
      float acc[32];
#pragma unroll
      for (int i = 0; i < 32; ++i) acc[i] = 0.f;
      float lsum = 0.f;
      const int nsel = (t + 1 < 256) ? (t + 1) : 256;
      const bool dense = t < 256;
      const uint4* sp = (const uint4*)(sel + (size_t)t * 256);
      uint4 cur = make_uint4(0, 0, 0, 0), nxt = make_uint4(0, 0, 0, 0);
      if (!dense) { cur = sp[0]; nxt = sp[1]; }
      int ptr = 0;
      int nextidx = dense ? 0 : (int)(cur.x & 0xFFFFu);
      const int nchunks = (qb >> 1) + 1;
      const int o0 = 4 * hp + ((0 + rot) & 3), o1 = 4 * hp + ((1 + rot) & 3), o2 = 4 * hp + ((2 + rot) & 3), o3 = 4 * hp + ((3 + rot) & 3);
      for (int c = 0; c < nchunks; ++c) {
        __syncthreads();
        {
          const uint4* kg = (const uint4*)(kh + ((size_t)h * T + c * 512) * 64) + tid;
          const uint4* vg = (const uint4*)(vh + ((size_t)h * T + c * 512) * 64) + tid;
          uint4 t0 = kg[0], t1 = kg[512], t2 = kg[1024], t3 = kg[1536], t4 = kg[2048], t5 = kg[2560], t6 = kg[3072], t7 = kg[3584];
          uint4 u0 = vg[0], u1 = vg[512], u2 = vg[1024], u3 = vg[1536], u4 = vg[2048], u5 = vg[2560], u6 = vg[3072], u7 = vg[3584];
          __builtin_amdgcn_sched_barrier(0);
          uint4* dk = sK + tid; uint4* dv = sV + tid;
          dk[0] = t0; dk[512] = t1; dk[1024] = t2; dk[1536] = t3; dk[2048] = t4; dk[2560] = t5; dk[3072] = t6; dk[3584] = t7;
          dv[0] = u0; dv[512] = u1; dv[1024] = u2; dv[1536] = u3; dv[2048] = u4; dv[2560] = u5; dv[3072] = u6; dv[3584] = u7;
        }
        __syncthreads();
        const int cbase = c * 512, cend = cbase + 512;
        while (ptr < nsel && nextidx < cend) {
          const int lk = nextidx - cbase;
          const uint4* krow = sK + lk * 8;
          const uint4* vrow = sV + lk * 8;
          float d = nshift;
#define ATT_DOT(Q, O) { const uint4 kv = krow[O]; d = dot2h(Q.x, kv.x, d); d = dot2h(Q.y, kv.y, d); d = dot2h(Q.z, kv.z, d); d = dot2h(Q.w, kv.w, d); }
          ATT_DOT(q0, o0) ATT_DOT(q1, o1) ATT_DOT(q2, o2) ATT_DOT(q3, o3)
          d += dpp_xor1(d);
          const float pe = exp2f(d);
          lsum += pe;
#define ATT_PV(J, O) { const uint4 vv4 = vrow[O]; \
            acc[8 * J + 0] = __builtin_fmaf(pe, hlo(vv4.x), acc[8 * J + 0]); acc[8 * J + 1] = __builtin_fmaf(pe, hhi(vv4.x), acc[8 * J + 1]); \
            acc[8 * J + 2] = __builtin_fmaf(pe, hlo(vv4.y), acc[8 * J + 2]); acc[8 * J + 3] = __builtin_fmaf(pe, hhi(vv4.y), acc[8 * J + 3]); \
            acc[8 * J + 4] = __builtin_fmaf(pe, hlo(vv4.z), acc[8 * J + 4]); acc[8 * J + 5] = __builtin_fmaf(pe, hhi(vv4.z), acc[8 * J + 5]); \
            acc[8 * J + 6] = __builtin_fmaf(pe, hlo(vv4.w), acc[8 * J + 6]); acc[8 * J + 7] = __builtin_fmaf(pe, hhi(vv4.w), acc[8 * J + 7]); }
          ATT_PV(0, o0) ATT_PV(1, o1) ATT_PV(2, o2) ATT_PV(3, o3)
          ++ptr;
          if (dense) nextidx = ptr;
          else {
            cur.x = (cur.x >> 16) | (cur.y << 16); cur.y = (cur.y >> 16) | (cur.z << 16); cur.z = (cur.z >> 16) | (cur.w << 16); cur.w >>= 16;
            if ((ptr & 7) == 0) { cur = nxt; if (ptr + 8 < 256) nxt = sp[(ptr >> 3) + 1]; }
            nextidx = (int)(cur.x & 0xFFFFu);
          }
        }
      }
      const float inv = 1.f / lsum;
      u16* orow = mix + (size_t)t * 1024 + h * 64;
#define ATT_OUT(J, O) { uint4 o; o.x = pack2bf(acc[8 * J] * inv, acc[8 * J + 1] * inv); o.y = pack2bf(acc[8 * J + 2] * inv, acc[8 * J + 3] * inv); \
        o.z = pack2bf(acc[8 * J + 4] * inv, acc[8 * J + 5] * inv); o.w = pack2bf(acc[8 * J + 6] * inv, acc[8 * J + 7] * inv); *(uint4*)(orow + (O) * 8) = o; }
      ATT_OUT(0, o0) ATT_OUT(1, o1) ATT_OUT(2, o2) ATT_OUT(3, o3)
    }
  }
}

__device__ void phase_gemm_out(const Params& p, char* smem) {
  GemmTile g{};
  g.A = (const u16*)(p.ws + OFF_MIX); g.lda = 1024; g.rowtok = nullptr;
  g.Bt = (const u16*)(p.ws + OFF_WOUTT); g.K = 1024;
  g.outf = (float*)(p.ws + OFF_H1); g.resid = p.x; g.ldo = 1024;
  constexpr int NT = 1024 / 128, MT = T / 256;
  for (int id = blockIdx.x; id < NT * MT; id += gridDim.x) {
    g.rowbase = (id / NT) * 256; g.n0 = (id % NT) * 128;
    gemm_tile<EPI_H1, false>(g, smem);
  }
}

__device__ void phase_router(const Params& p, char* smem) {
  const float* h1 = (const float*)(p.ws + OFF_H1);
  u16* xn2 = (u16*)(p.ws + OFF_XN);
  int* toke = (int*)(p.ws + OFF_TOKE); float* tokg = (float*)(p.ws + OFF_TOKG); int* tokp = (int*)(p.ws + OFF_TOKP);
  int* cnt = (int*)(p.ws + OFF_CNT);
  const int lane = threadIdx.x & 63, wid = threadIdx.x >> 6;
  float* xs = (float*)smem + wid * 4096;
  const int gw = blockIdx.x * 8 + wid, nw = gridDim.x * 8;
  const int e = lane & 31, kh = lane >> 5;
  for (int tg = gw; tg < T / 4; tg += nw) {
    const int t0 = tg * 4;
#pragma unroll
    for (int u = 0; u < 4; ++u) {
      const float4* hr = (const float4*)(h1 + (size_t)(t0 + u) * D);
      float4 v[4]; float ss = 0.f;
#pragma unroll
      for (int i = 0; i < 4; ++i) { v[i] = hr[lane + 64 * i]; ss += v[i].x * v[i].x + v[i].y * v[i].y + v[i].z * v[i].z + v[i].w * v[i].w; }
      ss = wave_sum(ss);
      float rstd = rsqrtf(ss * (1.f / D) + 1e-6f);
#pragma unroll
      for (int i = 0; i < 4; ++i) {
        float4 w = ((const float4*)p.norm2_w)[lane + 64 * i];
        float4 y = make_float4(v[i].x * rstd * w.x, v[i].y * rstd * w.y, v[i].z * rstd * w.z, v[i].w * rstd * w.w);
        *(float4*)(xs + u * 1024 + (lane + 64 * i) * 4) = y;
        uint2 o; o.x = pack2bf(y.x, y.y); o.y = pack2bf(y.z, y.w);
        *(uint2*)(xn2 + (size_t)(t0 + u) * D + (lane + 64 * i) * 4) = o;
      }
    }
    __threadfence_block();
    float l0 = 0.f, l1 = 0.f, l2 = 0.f, l3 = 0.f;
    const float* rw = p.router_w + (size_t)kh * 512 * 32 + e;
    const float* xk = xs + kh * 512;
    for (int k = 0; k < 512; ++k) {
      float w = rw[k * 32];
      l0 += xk[k] * w; l1 += xk[1024 + k] * w; l2 += xk[2048 + k] * w; l3 += xk[3072 + k] * w;
    }
    l0 += __shfl_xor(l0, 32); l1 += __shfl_xor(l1, 32); l2 += __shfl_xor(l2, 32); l3 += __shfl_xor(l3, 32);
    const float rb = p.router_b[e];
    float lg[4] = {l0 + rb, l1 + rb, l2 + rb, l3 + rb};
#pragma unroll
    for (int u = 0; u < 4; ++u) {
      float val = lg[u];
      float tv[4]; int te[4];
#pragma unroll
      for (int k = 0; k < 4; ++k) {
        float bv = val; int bi = e;
#pragma unroll
        for (int off = 16; off >= 1; off >>= 1) {
          float ov = __shfl_xor(bv, off); int oi = __shfl_xor(bi, off);
          if (ov > bv || (ov == bv && oi < bi)) { bv = ov; bi = oi; }
        }
        tv[k] = bv; te[k] = bi;
        if (e == bi) val = -INFINITY;
      }
      float m = tv[0];
      float ex[4], s = 0.f;
#pragma unroll
      for (int k = 0; k < 4; ++k) { ex[k] = __expf(tv[k] - m); s += ex[k]; }
      if (lane < 4) {
        int ee = (lane == 0) ? te[0] : (lane == 1) ? te[1] : (lane == 2) ? te[2] : te[3];
        float gg = ((lane == 0) ? ex[0] : (lane == 1) ? ex[1] : (lane == 2) ? ex[2] : ex[3]) / s;
        int pos = atomicAdd(&cnt[ee], 1);
        toke[(size_t)(t0 + u) * 4 + lane] = ee; tokg[(size_t)(t0 + u) * 4 + lane] = gg; tokp[(size_t)(t0 + u) * 4 + lane] = pos;
      }
    }
    __threadfence_block();
  }
}

__device__ __forceinline__ int expert_tstart(const int* cnt, int e) {
  int s = 0;
  for (int i = 0; i < e; ++i) s += (cnt[i] + 255) >> 8;
  return s;
}

__device__ void phase_fill_rows(const Params& p) {
  const int* toke = (const int*)(p.ws + OFF_TOKE); const int* tokp = (const int*)(p.ws + OFF_TOKP);
  const int* cnt = (const int*)(p.ws + OFF_CNT);
  int* rowtok = (int*)(p.ws + OFF_ROWTOK);
  __shared__ int ts[NE];
  if (threadIdx.x < NE) ts[threadIdx.x] = expert_tstart(cnt, threadIdx.x);
  __syncthreads();
  int gtid = blockIdx.x * NTHREADS + threadIdx.x, gsz = gridDim.x * NTHREADS;
  for (int i = gtid; i < T * 4; i += gsz) rowtok[ts[toke[i]] * 256 + tokp[i]] = i >> 2;
}

__device__ void phase_gemm_gu(const Params& p, char* smem) {
  const int* cnt = (const int*)(p.ws + OFF_CNT);
  __shared__ int ts[NE + 1];
  if (threadIdx.x <= NE) ts[threadIdx.x] = expert_tstart(cnt, threadIdx.x);
  __syncthreads();
  const int ntiles = ts[NE];
  GemmTile g{};
  g.A = (const u16*)(p.ws + OFF_XN); g.lda = 1024; g.rowtok = (const int*)(p.ws + OFF_ROWTOK);
  g.K = 1024; g.outh = (u16*)(p.ws + OFF_Z); g.ldo = 1024;
  for (int id = blockIdx.x; id < ntiles * 16; id += gridDim.x) {
    const int tile = id >> 4, nt = id & 15;
    int e = 0;
    while (e < NE - 1 && ts[e + 1] <= tile) ++e;
    g.rowbase = tile * 256; g.n0 = nt * 64;
    g.Bt = (const u16*)(p.ws + OFF_WGUT) + (size_t)e * 2048 * 1024;
    g.bias = p.exp_b_gu + (size_t)e * 2048;
    gemm_tile<EPI_GU, true>(g, smem);
  }
}

__device__ void phase_gemm_dn(const Params& p, char* smem) {
  const int* cnt = (const int*)(p.ws + OFF_CNT);
  __shared__ int ts[NE + 1];
  if (threadIdx.x <= NE) ts[threadIdx.x] = expert_tstart(cnt, threadIdx.x);
  __syncthreads();
  const int ntiles = ts[NE];
  GemmTile g{};
  g.A = (const u16*)(p.ws + OFF_Z); g.lda = 1024; g.rowtok = nullptr;
  g.K = 1024; g.outh = (u16*)(p.ws + OFF_SV); g.ldo = 1024;
  for (int id = blockIdx.x; id < ntiles * 8; id += gridDim.x) {
    const int tile = id >> 3, nt = id & 7;
    int e = 0;
    while (e < NE - 1 && ts[e + 1] <= tile) ++e;
    g.rowbase = tile * 256; g.n0 = nt * 128;
    g.Bt = (const u16*)(p.ws + OFF_WDNT) + (size_t)e * 1024 * 1024;
    g.bias = p.exp_b_down + (size_t)e * 1024;
    gemm_tile<EPI_DN, false>(g, smem);
  }
}

__device__ void phase_combine(const Params& p) {
  const int* toke = (const int*)(p.ws + OFF_TOKE); const float* tokg = (const float*)(p.ws + OFF_TOKG); const int* tokp = (const int*)(p.ws + OFF_TOKP);
  const int* cnt = (const int*)(p.ws + OFF_CNT);
  const float* h1 = (const float*)(p.ws + OFF_H1); const u16* yb = (const u16*)(p.ws + OFF_SV);
  __shared__ int ts[NE];
  if (threadIdx.x < NE) ts[threadIdx.x] = expert_tstart(cnt, threadIdx.x);
  __syncthreads();
  const int tid = threadIdx.x;
  const int sub = tid & 127, tl = tid >> 7;
  for (int t0 = blockIdx.x * 4; t0 < T; t0 += gridDim.x * 4) {
    const int t = t0 + tl;
    float4 a = *(const float4*)(h1 + (size_t)t * D + sub * 8), b = *(const float4*)(h1 + (size_t)t * D + sub * 8 + 4);
    float o[8] = {a.x, a.y, a.z, a.w, b.x, b.y, b.z, b.w};
#pragma unroll
    for (int k = 0; k < 4; ++k) {
      const int e = toke[t * 4 + k]; const float gte = tokg[t * 4 + k];
      const size_t row = (size_t)ts[e] * 256 + tokp[t * 4 + k];
      uint4 w = *(const uint4*)(yb + row * 1024 + sub * 8);
      u32 ww[4] = {w.x, w.y, w.z, w.w};
#pragma unroll
      for (int i = 0; i < 4; ++i) { o[2 * i] += gte * __uint_as_float(ww[i] << 16); o[2 * i + 1] += gte * __uint_as_float(ww[i] & 0xFFFF0000u); }
    }
    *(float4*)(p.out + (size_t)t * D + sub * 8) = make_float4(o[0], o[1], o[2], o[3]);
    *(float4*)(p.out + (size_t)t * D + sub * 8 + 4) = make_float4(o[4], o[5], o[6], o[7]);
  }
}

enum { PH_INIT = 0, PH_PREP, PH_GEMM_IN, PH_POST, PH_SCAN_A, PH_TOPK, PH_SCAN_B, PH_SCAN_C, PH_ATTN, PH_RWKV_OUT, PH_GEMM_OUT, PH_ROUTER, PH_FILL, PH_GEMM_GU, PH_GEMM_DN, PH_COMBINE, PH_COUNT };

template <int PH>
__device__ __forceinline__ void run_phase(const Params& p, char* smem) {
  if (PH == PH_INIT) { phase_init(p); phase_norm1(p); }
  if (PH == PH_PREP) {
    transpose_convert(p.w_in, (u16*)(p.ws + OFF_WINT), 1024, DIN, DINP, 1, smem);
    transpose_convert(p.w_out, (u16*)(p.ws + OFF_WOUTT), 1024, 1024, 1024, 1, smem);
    transpose_convert(p.exp_w_gu, (u16*)(p.ws + OFF_WGUT), 1024, 2048, 2048, NE, smem);
    transpose_convert(p.exp_w_down, (u16*)(p.ws + OFF_WDNT), 1024, 1024, 1024, NE, smem);
  }
  if (PH == PH_GEMM_IN) phase_gemm_in(p, smem);
  if (PH == PH_POST) { phase_post_attn(p); phase_post_rwkv(p, smem); }
  if (PH == PH_SCAN_A) phase_scan_a(p, smem);
  if (PH == PH_TOPK) phase_topk(p, smem);
  if (PH == PH_SCAN_B) phase_scan_b(p, smem);
  if (PH == PH_SCAN_C) phase_scan_c(p, smem);
  if (PH == PH_ATTN) phase_attn(p, smem);
  if (PH == PH_RWKV_OUT) phase_rwkv_out(p);
  if (PH == PH_GEMM_OUT) phase_gemm_out(p, smem);
  if (PH == PH_ROUTER) phase_router(p, smem);
  if (PH == PH_FILL) phase_fill_rows(p);
  if (PH == PH_GEMM_GU) phase_gemm_gu(p, smem);
  if (PH == PH_GEMM_DN) phase_gemm_dn(p, smem);
  if (PH == PH_COMBINE) phase_combine(p);
}

#ifndef FUSED
#define FUSED 1
#endif

template <int PH>
__global__ void __launch_bounds__(NTHREADS) phase_kernel(Params p) {
  extern __shared__ __attribute__((aligned(16))) char smem[];
  run_phase<PH>(p, smem);
}

template <int PH>
__device__ __forceinline__ void run_from(const Params& p, char* smem, cg::grid_group& grid, const XcdBarrier& xb) {
#ifdef REPEAT_PH
  if constexpr (PH == REPEAT_PH) { run_phase<PH>(p, smem); xcd_barrier(xb); }
#endif
  run_phase<PH>(p, smem);
  if constexpr (PH + 1 < PH_COUNT) {
    if constexpr (PH == 0) grid.sync(); else xcd_barrier(xb);
    run_from<PH + 1>(p, smem, grid, xb);
  }
}

__global__ void __launch_bounds__(NTHREADS) fwd_megakernel(Params p) {
  extern __shared__ __attribute__((aligned(16))) char smem[];
  __shared__ uint4 xb_words;
  cg::grid_group grid = cg::this_grid();
  if (threadIdx.x == 0) xb_words = make_uint4(0u, 0u, 0u, 0u);
  __syncthreads();
  XcdBarrier xb = xcd_barrier_post((unsigned*)(p.ws + OFF_BAR), (volatile LAS unsigned*)&xb_words);
  run_from<0>(p, smem, grid, xb);
}

template <int PH>
static void launch_phase(const Params& p, int grid, hipStream_t stream) {
  static bool attr_set = false;
  if (!attr_set) { (void)hipFuncSetAttribute((const void*)phase_kernel<PH>, hipFuncAttributeMaxDynamicSharedMemorySize, LDS_BYTES); attr_set = true; }
  hipLaunchKernelGGL(phase_kernel<PH>, dim3(grid), dim3(NTHREADS), LDS_BYTES, stream, p);
}

template <int PH>
static void launch_all(const Params& p, int grid, hipStream_t stream) {
  launch_phase<PH>(p, grid, stream);
  if constexpr (PH + 1 < PH_COUNT) launch_all<PH + 1>(p, grid, stream);
}

extern "C" void kernel_launch(void* const* d_in, const int* in_sizes, int n_in, void* d_out, int out_size, void* d_ws, size_t ws_size,
                              hipStream_t stream) {
  if (ws_size < WS_NEEDED) { fprintf(stderr, "workspace too small: %zu < %zu\n", ws_size, (size_t)WS_NEEDED); return; }
  Params p{};
  p.x = (const float*)d_in[0]; p.positions = (const int*)d_in[1]; p.norm1_w = (const float*)d_in[2]; p.w_in = (const float*)d_in[3];
  p.q_norm_w = (const float*)d_in[4]; p.k_norm_w = (const float*)d_in[5]; p.rwkv_mu = (const float*)d_in[6]; p.rwkv_w0 = (const float*)d_in[7];
  p.rwkv_w2 = (const float*)d_in[8]; p.rwkv_a0 = (const float*)d_in[9]; p.rwkv_a2 = (const float*)d_in[10]; p.rwkv_g2 = (const float*)d_in[11];
  p.rwkv_k_k = (const float*)d_in[12]; p.rwkv_k_a = (const float*)d_in[13]; p.rwkv_r_k = (const float*)d_in[14]; p.rwkv_ln_w = (const float*)d_in[15];
  p.rwkv_ln_b = (const float*)d_in[16]; p.w_out = (const float*)d_in[17]; p.norm2_w = (const float*)d_in[18]; p.router_w = (const float*)d_in[19];
  p.router_b = (const float*)d_in[20]; p.exp_w_gu = (const float*)d_in[21]; p.exp_b_gu = (const float*)d_in[22]; p.exp_w_down = (const float*)d_in[23];
  p.exp_b_down = (const float*)d_in[24];
  p.out = (float*)d_out; p.ws = (char*)d_ws;
#if FUSED
  static int grid_blocks = 0;
  if (!grid_blocks) {
    (void)hipFuncSetAttribute((const void*)fwd_megakernel, hipFuncAttributeMaxDynamicSharedMemorySize, LDS_BYTES);
    int dev = 0, cus = 0, per_cu = 0;
    (void)hipGetDevice(&dev);
    (void)hipDeviceGetAttribute(&cus, hipDeviceAttributeMultiprocessorCount, dev);
    (void)hipOccupancyMaxActiveBlocksPerMultiprocessor(&per_cu, fwd_megakernel, NTHREADS, LDS_BYTES);
    if (per_cu < 1) { fprintf(stderr, "occupancy query returned %d\n", per_cu); per_cu = 1; }
    grid_blocks = cus;
  }
  (void)hipMemsetAsync((char*)d_ws + OFF_BAR, 0, 16384, stream);
  void* args[] = {(void*)&p};
  hipError_t e = hipLaunchCooperativeKernel((void*)fwd_megakernel, dim3(grid_blocks), dim3(NTHREADS), args, LDS_BYTES, stream);
  if (e != hipSuccess) fprintf(stderr, "cooperative launch failed: %s (grid %d)\n", hipGetErrorString(e), grid_blocks);
#else
  launch_all<0>(p, 256, stream);
#endif
}
```

```cpp
#include <hip/hip_runtime.h>
#include <hip/hip_bf16.h>
#include <hip/hip_fp16.h>
#include <hip/hip_cooperative_groups.h>
#include <stdint.h>
#include <stdio.h>
namespace cg = cooperative_groups;

typedef unsigned short u16;
typedef unsigned int u32;
using bf16x8 = __attribute__((ext_vector_type(8))) short;
using f32x4 = __attribute__((ext_vector_type(4))) float;
using f32x16 = __attribute__((ext_vector_type(16))) float;

constexpr int T = 16384, D = 1024, DIN = 3496, DINP = 3584;
constexpr int NCH = 128, CHL = T / NCH;
constexpr int NE = 32, DFF = 1024;
constexpr int ROWCAP = 73728;
constexpr int C_Q = 0, C_K = 512, C_V = 1024, C_IQ = 1536, C_IK = 1792, C_IW = 1824, C_RW = 1832;
constexpr int NTHREADS = 512;
constexpr int LDS_BYTES = 159 * 1024;

constexpr size_t SZ_WGUT = (size_t)NE * 2048 * 1024 * 2;
constexpr size_t SZ_WDNT = (size_t)NE * 1024 * 1024 * 2;
constexpr size_t SZ_WINT = (size_t)DINP * 1024 * 2;
constexpr size_t SZ_WOUTT = (size_t)1024 * 1024 * 2;
constexpr size_t SZ_XN = (size_t)T * 1024 * 2;
constexpr size_t SZ_Z = (size_t)T * DINP * 4;
constexpr size_t SZ_QKV = (size_t)T * 512 * 2;
constexpr size_t SZ_IQ = (size_t)T * 256 * 2;
constexpr size_t SZ_IK = (size_t)T * 32 * 2;
constexpr size_t SZ_IW = (size_t)T * 8 * 4;
constexpr size_t SZ_SV = (size_t)T * 8 * 384 * 4;
constexpr size_t SZ_G = (size_t)T * 512 * 4;
constexpr size_t SZ_BONUS = (size_t)T * 8 * 4;
constexpr size_t SZ_Y = (size_t)T * 512 * 4;
constexpr size_t SZ_SMAT = (size_t)8 * NCH * 4096 * 4;
constexpr size_t SZ_SEL = (size_t)T * 256 * 2;
constexpr size_t SZ_MIX = (size_t)T * 1024 * 2;
constexpr size_t SZ_H1 = (size_t)T * 1024 * 4;
constexpr size_t SZ_TOK = (size_t)T * 4 * 4;
constexpr size_t SZ_ROWTOK = (size_t)ROWCAP * 4;

constexpr size_t OFF_WGUT = 0;
constexpr size_t OFF_WDNT = OFF_WGUT + SZ_WGUT;
constexpr size_t OFF_WINT = OFF_WDNT + SZ_WDNT;
constexpr size_t OFF_WOUTT = OFF_WINT + SZ_WINT;
constexpr size_t OFF_XN = OFF_WOUTT + SZ_WOUTT;
constexpr size_t OFF_Z = OFF_XN + SZ_XN;
constexpr size_t OFF_QR = OFF_Z + SZ_Z;
constexpr size_t OFF_KR = OFF_QR + SZ_QKV;
constexpr size_t OFF_VV = OFF_KR + SZ_QKV;
constexpr size_t OFF_IQ = OFF_VV + SZ_QKV;
constexpr size_t OFF_IK = OFF_IQ + SZ_IQ;
constexpr size_t OFF_IW = OFF_IK + SZ_IK;
constexpr size_t OFF_SV = OFF_IW + SZ_IW;
constexpr size_t OFF_G = OFF_SV + SZ_SV;
constexpr size_t OFF_BONUS = OFF_G + SZ_G;
constexpr size_t OFF_Y = OFF_BONUS + SZ_BONUS;
constexpr size_t OFF_SP = OFF_Y + SZ_Y;
constexpr size_t OFF_SL = OFF_SP + SZ_SMAT;
constexpr size_t OFF_SI = OFF_SL + SZ_SMAT;
constexpr size_t OFF_SEL = OFF_SI + SZ_SMAT;
constexpr size_t OFF_MIX = OFF_SEL + SZ_SEL;
constexpr size_t OFF_H1 = OFF_MIX + SZ_MIX;
constexpr size_t OFF_TOKE = OFF_H1 + SZ_H1;
constexpr size_t OFF_TOKG = OFF_TOKE + SZ_TOK;
constexpr size_t OFF_TOKP = OFF_TOKG + SZ_TOK;
constexpr size_t OFF_ROWTOK = OFF_TOKP + SZ_TOK;
constexpr size_t OFF_CNT = OFF_ROWTOK + SZ_ROWTOK;
constexpr size_t OFF_QSH = OFF_CNT + 4096;
constexpr size_t OFF_BAR = OFF_QSH + (size_t)T * 8 * 4;
constexpr size_t WS_NEEDED = OFF_BAR + 16384;

struct Params {
  const float* x; const int* positions; const float* norm1_w; const float* w_in;
  const float* q_norm_w; const float* k_norm_w; const float* rwkv_mu; const float* rwkv_w0;
  const float* rwkv_w2; const float* rwkv_a0; const float* rwkv_a2; const float* rwkv_g2;
  const float* rwkv_k_k; const float* rwkv_k_a; const float* rwkv_r_k; const float* rwkv_ln_w;
  const float* rwkv_ln_b; const float* w_out; const float* norm2_w; const float* router_w;
  const float* router_b; const float* exp_w_gu; const float* exp_b_gu; const float* exp_w_down;
  const float* exp_b_down;
  float* out;
  char* ws;
};

__device__ __forceinline__ u16 f2bf(float f) {
  u32 u = __float_as_uint(f);
  u += 0x7FFFu + ((u >> 16) & 1u);
  return (u16)(u >> 16);
}
__device__ __forceinline__ float bf2f(u16 h) { return __uint_as_float(((u32)h) << 16); }
__device__ __forceinline__ u32 pack2bf(float a, float b) { return (u32)f2bf(a) | ((u32)f2bf(b) << 16); }
__device__ __forceinline__ float wave_sum(float v) {
#pragma unroll
  for (int o = 32; o >= 1; o >>= 1) v += __shfl_xor(v, o);
  return v;
}
__device__ __forceinline__ float sigmoidf_(float x) { return 1.f / (1.f + __expf(-x)); }

__device__ __forceinline__ void sincos_big(float ang, float& s, float& c) {
  double a = (double)ang * 0.15915494309189535;
  double r = a - rint(a);
  float rf = (float)r;
  s = __builtin_amdgcn_sinf(rf);
  c = __builtin_amdgcn_cosf(rf);
}


#define XB_TMO      128
#define XB_XCNT(j)  (256  + 64 * (j))
#define XB_XSUB(j)  (1280 + 64 * (j))
#define XB_XGEN(j)  (2304 + 64 * (j))
#define XB_TOP      3328
#define XB_TOPGEN   3392
#define XCD_BAR_WORDS 3456
#define XB_SPIN_CAP (1u << 22)
#define LAS __attribute__((address_space(3)))
__device__ __forceinline__ unsigned xb_ld(unsigned* p)              { return __hip_atomic_load(p, __ATOMIC_RELAXED, __HIP_MEMORY_SCOPE_AGENT); }
__device__ __forceinline__ unsigned xb_add(unsigned* p, unsigned v) { return __hip_atomic_fetch_add(p, v, __ATOMIC_RELAXED, __HIP_MEMORY_SCOPE_AGENT); }
__device__ __forceinline__ unsigned xb_xcc_id() { return (unsigned)__builtin_amdgcn_s_getreg((3 << 11) | 20) & 0xFu; }
#define XB_SPIN(cond, bar) do { unsigned _sp = 0; while (cond) { __builtin_amdgcn_s_sleep(1); \
    if ((++_sp & 255u) == 0u) { if (xb_ld(&(bar)[XB_TMO])) break; if (_sp > XB_SPIN_CAP) { atomicAdd(&(bar)[XB_TMO], 1u); break; } } } } while (0)
struct XcdBarrier { unsigned* bar; unsigned x; volatile LAS unsigned* st; };
__device__ __forceinline__ XcdBarrier xcd_barrier_post(unsigned* bar, volatile LAS unsigned* st) {
  XcdBarrier b; b.bar = bar; b.x = xb_xcc_id(); b.st = st;
  if (threadIdx.x == 0) (void)xb_add(&bar[XB_XCNT(b.x)], 1u);
  return b;
}
__device__ __forceinline__ void xcd_barrier_complete(unsigned* bar, unsigned x, unsigned& nloc, unsigned& nx) {
  const unsigned G = gridDim.x * gridDim.y * gridDim.z;
  unsigned sum, cnt, mine, sp = 0u;
  for (;;) {
    sum = 0u; cnt = 0u; mine = 0u;
#pragma unroll
    for (unsigned j = 0; j < 16; ++j) { const unsigned c = xb_ld(&bar[XB_XCNT(j)]); sum += c; cnt += (c > 0u) ? 1u : 0u; mine = (j == x) ? c : mine; }
    if (sum == G) break;
    __builtin_amdgcn_s_sleep(1);
    if ((++sp & 255u) == 0u) { if (xb_ld(&bar[XB_TMO])) break; if (sp > XB_SPIN_CAP) { atomicAdd(&bar[XB_TMO], 1u); break; } }
  }
  nloc = mine > 0u ? mine : 1u; nx = cnt > 0u ? cnt : 1u;
}
__device__ __forceinline__ void xcd_barrier(const XcdBarrier& b) {
  asm volatile("s_waitcnt vmcnt(0)" ::: "memory");
  __syncthreads();
  if (threadIdx.x == 0) {
    unsigned* bar = b.bar;
    __builtin_amdgcn_s_waitcnt(0);
    unsigned nloc = b.st[0], nx = b.st[1];
    if (nloc == 0u) { xcd_barrier_complete(bar, b.x, nloc, nx); b.st[0] = nloc; b.st[1] = nx; }
    const unsigned old = xb_add(&bar[XB_XSUB(b.x)], 1u);
    const unsigned gen = old / nloc;
    if (old + 1u == (gen + 1u) * nloc) {
      __builtin_amdgcn_fence(__ATOMIC_RELEASE, "agent");
      asm volatile("s_waitcnt vmcnt(0)" ::: "memory");
      const unsigned og = xb_add(&bar[XB_TOP], 1u);
      const unsigned tg = og / nx;
      if (og + 1u == (tg + 1u) * nx) xb_add(&bar[XB_TOPGEN], 1u);
      else XB_SPIN(xb_ld(&bar[XB_TOPGEN]) == tg, bar);
      __builtin_amdgcn_fence(__ATOMIC_ACQUIRE, "agent");
      xb_add(&bar[XB_XGEN(b.x)], 1u);
      asm volatile("s_waitcnt vmcnt(0)" ::: "memory");
    } else {
      XB_SPIN(xb_ld(&bar[XB_XGEN(b.x)]) == gen, bar);
      __builtin_amdgcn_fence(__ATOMIC_ACQUIRE, "agent");
      asm volatile("s_waitcnt vmcnt(0)" ::: "memory");
    }
  }
  __syncthreads();
}


#ifndef PROBE_ID
#define PROBE_ID 0
#endif
#define PROF_BLOCK 100
#define PROF_AMP 4
#define g_prof (*(unsigned long long*)(smem + 157 * 1024 + 16))
#define PROF_T0(id) unsigned long long _pt0_##id = 0; if (PROBE_ID == (id) && blockIdx.x == PROF_BLOCK && threadIdx.x == 0) _pt0_##id = __builtin_amdgcn_s_memrealtime();
#define PROF_T1(id) if (PROBE_ID == (id) && blockIdx.x == PROF_BLOCK && threadIdx.x == 0) g_prof += __builtin_amdgcn_s_memrealtime() - _pt0_##id;

__device__ void phase_init(const Params& p) {
  int* cnt = (int*)(p.ws + OFF_CNT);
  int* rowtok = (int*)(p.ws + OFF_ROWTOK);
  int gtid = blockIdx.x * NTHREADS + threadIdx.x;
  int gsz = gridDim.x * NTHREADS;
  if (gtid < 64) cnt[gtid] = 0;
  for (int i = gtid; i < ROWCAP; i += gsz) rowtok[i] = -1;
}

__device__ void transpose_convert(const float* src, u16* dst, int R, int C, int Cpad, int nbatch, char* smem, int bid, int nblk) {
  float* tile = (float*)smem;
  int tr = R / 64, tc = Cpad / 64;
  int ntile = tr * tc * nbatch;
  int tid = threadIdx.x;
  for (int id = bid; id < ntile; id += nblk) {
    int b = id / (tr * tc), rem = id % (tr * tc);
    int r0 = (rem / tc) * 64, c0 = (rem % tc) * 64;
    const float* s = src + (size_t)b * R * C;
    u16* d = dst + (size_t)b * Cpad * R;
#pragma unroll
    for (int i = 0; i < 8; ++i) {
      int r = (tid >> 6) + 8 * i, c = tid & 63;
      float v = (c0 + c < C) ? s[(size_t)(r0 + r) * C + c0 + c] : 0.f;
      tile[r * 65 + c] = v;
    }
    __syncthreads();
    {
      int cc = tid >> 3, rg = tid & 7;
      u32 w[4];
#pragma unroll
      for (int i = 0; i < 4; ++i) w[i] = pack2bf(tile[(rg * 8 + 2 * i) * 65 + cc], tile[(rg * 8 + 2 * i + 1) * 65 + cc]);
      uint4 o; o.x = w[0]; o.y = w[1]; o.z = w[2]; o.w = w[3];
      *(uint4*)(d + (size_t)(c0 + cc) * R + r0 + rg * 8) = o;
    }
    __syncthreads();
  }
}

__device__ void phase_norm1(const Params& p) {
  u16* xn = (u16*)(p.ws + OFF_XN);
  int lane = threadIdx.x & 63, wid = threadIdx.x >> 6;
  int gw = blockIdx.x * 8 + wid, nw = gridDim.x * 8;
  for (int t = gw; t < T; t += nw) {
    const float4* xr = (const float4*)(p.x + (size_t)t * D);
    float4 v[4]; float ss = 0.f;
#pragma unroll
    for (int i = 0; i < 4; ++i) { v[i] = xr[lane + 64 * i]; ss += v[i].x * v[i].x + v[i].y * v[i].y + v[i].z * v[i].z + v[i].w * v[i].w; }
    ss = wave_sum(ss);
    float rstd = rsqrtf(ss * (1.f / D) + 1e-6f);
#pragma unroll
    for (int i = 0; i < 4; ++i) {
      float4 w = ((const float4*)p.norm1_w)[lane + 64 * i];
      uint2 o; o.x = pack2bf(v[i].x * rstd * w.x, v[i].y * rstd * w.y); o.y = pack2bf(v[i].z * rstd * w.z, v[i].w * rstd * w.w);
      *(uint2*)(xn + (size_t)t * D + (lane + 64 * i) * 4) = o;
    }
  }
}

namespace g8 {
constexpr int BM = 256, BK = 64, HALF = 128, HTB = HALF * BK * 2, STAGE_BYTES = 8 * HTB;
__device__ __forceinline__ int lds_byte(int r, int c) { const int st = (r >> 4) * 2 + (c >> 5), rr = r & 15, cc = c & 31, ob = rr * 64 + cc * 2; return st * 1024 + (ob ^ (((ob >> 9) & 1) << 5)); }
__device__ __forceinline__ void stage_rc(int b, int& R, int& C) { const int st = b / 1024, sb = b % 1024, swz = sb ^ (((sb >> 9) & 1) << 5); R = (st >> 1) * 16 + swz / 64; C = (st & 1) * 32 + (swz % 64) / 2; }

struct Unit {
  const char* A;
  const char* B;
  unsigned hstepB;
  int row0;
  int col0;
  int aux;
};

template <class Sched, class Epi, bool GATHER>
__device__ __forceinline__ void gemm_phase(LAS unsigned char* lds, const int K, const Sched& S, const Epi& E, const int* __restrict__ rowtok) {
  const int tid = threadIdx.x, wid = __builtin_amdgcn_readfirstlane(tid >> 6), lane = tid & 63, wr = wid >> 2, wc = wid & 3, fr = lane & 15, fq = lane >> 4;
  const int nt = K / BK;
  int R0, C0, R1, C1;
  stage_rc(tid * 16, R0, C0); stage_rc(tid * 16 + 8192, R1, C1);
  const unsigned voffB0 = (unsigned)(R0 * K + C0) * 2u, voffB1 = (unsigned)(R1 * K + C1) * 2u;
  unsigned ac00, ac01, ac10, ac11, an00, an01, an10, an11;
#define G8_AOFF(u, o00, o01, o10, o11) do { \
    if (GATHER) { int t00 = rowtok[(u).row0 + R0], t01 = rowtok[(u).row0 + R1], t10 = rowtok[(u).row0 + HALF + R0], t11 = rowtok[(u).row0 + HALF + R1]; \
      t00 = t00 < 0 ? 0 : t00; t01 = t01 < 0 ? 0 : t01; t10 = t10 < 0 ? 0 : t10; t11 = t11 < 0 ? 0 : t11; \
      o00 = (unsigned)(t00 * K + C0) * 2u; o01 = (unsigned)(t01 * K + C1) * 2u; o10 = (unsigned)(t10 * K + C0) * 2u; o11 = (unsigned)(t11 * K + C1) * 2u; } \
    else { o00 = (unsigned)(R0 * K + C0) * 2u; o01 = (unsigned)(R1 * K + C1) * 2u; o10 = (unsigned)((HALF + R0) * K + C0) * 2u; o11 = (unsigned)((HALF + R1) * K + C1) * 2u; } } while (0)
  const size_t kstep = (size_t)(BK * 2);
  const unsigned ldsw = (unsigned)wid * 1024u;
  const int aoff = lds_byte(wr * 64 + fr, fq * 8), boff = lds_byte(wc * 32 + fr, fq * 8);
#define G8_SA(b, h) (((b) * 2 + (h)) * HTB)
#define G8_SB(b, h) ((4 + (b) * 2 + (h)) * HTB)
#define G8_STAGE(bufoff, gbase, v0, v1) do { \
    __builtin_amdgcn_global_load_lds((const unsigned*)((const char*)(gbase) + (v0)), (LAS unsigned*)(lds + (bufoff) + ldsw), 16, 0, 0); \
    __builtin_amdgcn_global_load_lds((const unsigned*)((const char*)(gbase) + (v1)), (LAS unsigned*)(lds + (bufoff) + ldsw + 8192), 16, 0, 0); } while (0)
#define G8_LDA(dst, b, h) do { _Pragma("unroll") for (int m = 0; m < 4; ++m) _Pragma("unroll") for (int k = 0; k < 2; ++k) dst[m][k] = *(const LAS bf16x8*)(lds + G8_SA(b, h) + aoff + m * 2048 + k * 1024); } while (0)
#define G8_LDB(dst, b, h) do { _Pragma("unroll") for (int n = 0; n < 2; ++n) _Pragma("unroll") for (int k = 0; k < 2; ++k) dst[n][k] = *(const LAS bf16x8*)(lds + G8_SB(b, h) + boff + n * 2048 + k * 1024); } while (0)
#define G8_MMA(ai, bj, At_, Bt_) do { __builtin_amdgcn_s_setprio(1); _Pragma("unroll") for (int m = 0; m < 4; ++m) _Pragma("unroll") for (int n = 0; n < 2; ++n) _Pragma("unroll") for (int k = 0; k < 2; ++k) \
    acc[ai][bj][m][n] = __builtin_amdgcn_mfma_f32_16x16x32_bf16(Bt_[n][k], At_[m][k], acc[ai][bj][m][n], 0, 0, 0); __builtin_amdgcn_s_setprio(0); } while (0)
#define G8_WAIT_V(n) asm volatile("s_waitcnt vmcnt(" #n ")" ::: "memory")
#define G8_WAIT_L(n) asm volatile("s_waitcnt lgkmcnt(" #n ")" ::: "memory")
#define G8_BAR __builtin_amdgcn_s_barrier()
#define G8_SCHED __builtin_amdgcn_sched_barrier(0)
  Unit cur, nxt; int ui = 0;
  if (!S.next(0, cur)) return;
  f32x4 acc[2][2][4][2];
#pragma unroll
  for (int a = 0; a < 2; ++a)
#pragma unroll
    for (int b = 0; b < 2; ++b)
#pragma unroll
      for (int m = 0; m < 4; ++m)
#pragma unroll
        for (int n = 0; n < 2; ++n) acc[a][b][m][n] = (f32x4){0.f, 0.f, 0.f, 0.f};
  bf16x8 At[4][2], B0[2][2], B1[2][2];
  const char* cA = cur.A; const char* cB = cur.B; unsigned chB = cur.hstepB;
  G8_AOFF(cur, ac00, ac01, ac10, ac11);
  an00 = ac00; an01 = ac01; an10 = ac10; an11 = ac11;
  G8_STAGE(G8_SB(0, 0), cB, voffB0, voffB1); G8_STAGE(G8_SA(0, 0), cA, ac00, ac01); G8_STAGE(G8_SB(0, 1), cB + chB, voffB0, voffB1); G8_STAGE(G8_SA(0, 1), cA, ac10, ac11);
  if (wr == 1) G8_BAR;
  G8_WAIT_V(4); G8_BAR;
  G8_STAGE(G8_SB(1, 0), cB + kstep, voffB0, voffB1); G8_STAGE(G8_SA(1, 0), cA + kstep, ac00, ac01); G8_STAGE(G8_SB(1, 1), cB + chB + kstep, voffB0, voffB1);
  G8_WAIT_V(6); G8_BAR;
  for (;;) {
    const bool has_next = S.next(ui + 1, nxt);
    const char* nA = has_next ? nxt.A : cA; const char* nB = has_next ? nxt.B : cB; const unsigned nhB = has_next ? nxt.hstepB : chB;
    if (GATHER) { if (has_next) G8_AOFF(nxt, an00, an01, an10, an11); else { an00 = ac00; an01 = ac01; an10 = ac10; an11 = ac11; } }
    for (int t = 0; t < nt; t += 2) {
      const bool last = (t == nt - 2);
      const char* a1 = cA + (size_t)(t + 1) * kstep;
      const char* a2 = last ? nA : cA + (size_t)(t + 2) * kstep; const char* b2 = last ? nB : cB + (size_t)(t + 2) * kstep;
      const char* a3 = a2 + kstep; const char* b3 = b2 + kstep;
      const unsigned hb2 = last ? nhB : chB;
      const unsigned x00 = last ? an00 : ac00, x01 = last ? an01 : ac01, x10 = last ? an10 : ac10, x11 = last ? an11 : ac11;
      G8_LDB(B0, 0, 0); G8_SCHED; G8_LDA(At, 0, 0); G8_STAGE(G8_SA(1, 1), a1, ac10, ac11);
      G8_WAIT_L(8); G8_BAR; G8_WAIT_L(0); G8_MMA(0, 0, At, B0); G8_BAR; G8_SCHED;
      G8_LDB(B1, 0, 1); G8_STAGE(G8_SB(0, 0), b2, voffB0, voffB1);
      G8_BAR; G8_WAIT_L(0); G8_MMA(0, 1, At, B1); G8_BAR;
      G8_LDA(At, 0, 1); G8_STAGE(G8_SA(0, 0), a2, x00, x01);
      G8_BAR; G8_WAIT_L(0); G8_MMA(1, 0, At, B0); G8_BAR; G8_SCHED;
      G8_STAGE(G8_SB(0, 1), b2 + hb2, voffB0, voffB1);
      G8_WAIT_V(6); G8_BAR; G8_MMA(1, 1, At, B1); G8_BAR;
      G8_LDB(B0, 1, 0); G8_SCHED; G8_LDA(At, 1, 0); G8_STAGE(G8_SA(0, 1), a2, x10, x11);
      G8_WAIT_L(8); G8_BAR; G8_WAIT_L(0); G8_MMA(0, 0, At, B0); G8_BAR; G8_SCHED;
      G8_LDB(B1, 1, 1); G8_STAGE(G8_SB(1, 0), b3, voffB0, voffB1);
      G8_BAR; G8_WAIT_L(0); G8_MMA(0, 1, At, B1); G8_BAR;
      G8_LDA(At, 1, 1); G8_STAGE(G8_SA(1, 0), a3, x00, x01);
      G8_BAR; G8_WAIT_L(0); G8_MMA(1, 0, At, B0); G8_BAR; G8_SCHED;
      G8_STAGE(G8_SB(1, 1), b3 + hb2, voffB0, voffB1);
      G8_WAIT_V(6); G8_BAR; G8_MMA(1, 1, At, B1); G8_BAR;
    }
    E(acc, cur, wr, wc, fr, fq);
    if (!has_next) break;
#pragma unroll
    for (int a = 0; a < 2; ++a)
#pragma unroll
      for (int b = 0; b < 2; ++b)
#pragma unroll
        for (int m = 0; m < 4; ++m)
#pragma unroll
          for (int n = 0; n < 2; ++n) acc[a][b][m][n] = (f32x4){0.f, 0.f, 0.f, 0.f};
    cur = nxt; cA = nA; cB = nB; chB = nhB; ++ui;
    ac00 = an00; ac01 = an01; ac10 = an10; ac11 = an11;
  }
  G8_WAIT_V(0);
  if (wr == 0) G8_BAR;
  G8_BAR;
#undef G8_AOFF
#undef G8_SA
#undef G8_SB
#undef G8_STAGE
#undef G8_LDA
#undef G8_LDB
#undef G8_MMA
#undef G8_WAIT_V
#undef G8_WAIT_L
#undef G8_BAR
#undef G8_SCHED
}

struct SchedDense {
  const char* A; const char* Bt; int K, nM, nN, nwg, G, c;
  __device__ __forceinline__ bool next(int i, Unit& u) const {
    const int L = i * G + c; if (L >= nwg) return false;
    int wgid = L; { const int q = nwg / 8, r = nwg % 8, xcd = wgid % 8, off = wgid / 8; wgid = (xcd < r ? xcd * (q + 1) : r * (q + 1) + (xcd - r) * q) + off; }
    const int nig = 8 * nN, gid = wgid / nig, fm = gid * 8, gsz = (nM - fm) < 8 ? (nM - fm) : 8;
    const int pm = fm + ((wgid % nig) % gsz), pn = (wgid % nig) / gsz;
    u.A = A + (size_t)pm * BM * K * 2; u.B = Bt + (size_t)pn * BM * K * 2; u.hstepB = (unsigned)(HALF * K * 2);
    u.row0 = pm * BM; u.col0 = pn * BM; u.aux = 0; return true;
  }
};
template <int NCOLT, bool GU>
struct SchedMoE {
  const char* A; const char* W; int K; const int* ts; int G, c;
  __device__ __forceinline__ bool next(int i, Unit& u) const {
    const int id = i * G + c; const int ntiles = ts[NE];
    if (id >= ntiles * NCOLT) return false;
    const int tile = id / NCOLT, pn = id % NCOLT;
    int e = 0;
    while (e < NE - 1 && ts[e + 1] <= tile) ++e;
    u.row0 = tile * BM; u.aux = e;
    if (GU) { u.A = A; u.B = W + ((size_t)e * 2048 + pn * 128) * K * 2; u.hstepB = (unsigned)(1024 * K * 2); u.col0 = pn * 128; }
    else { u.A = A + (size_t)tile * BM * K * 2; u.B = W + ((size_t)e * 1024 + pn * 256) * K * 2; u.hstepB = (unsigned)(HALF * K * 2); u.col0 = pn * 256; }
    return true;
  }
};

struct EpiF32 {
  float* C; const float* resid; int ldc;
  __device__ __forceinline__ void operator()(const f32x4 (&acc)[2][2][4][2], const Unit& u, int wr, int wc, int fr, int fq) const {
    const int row0 = u.row0 + wr * 64 + fr, col0 = u.col0 + wc * 32 + 4 * fq;
#pragma unroll
    for (int ai = 0; ai < 2; ++ai)
#pragma unroll
      for (int m = 0; m < 4; ++m) {
        const size_t ro = (size_t)(row0 + ai * HALF + m * 16) * ldc + col0;
#pragma unroll
        for (int bj = 0; bj < 2; ++bj)
#pragma unroll
          for (int n = 0; n < 2; ++n) {
            f32x4 v = acc[ai][bj][m][n];
            if (resid) v += *(const f32x4*)(resid + ro + bj * HALF + n * 16);
            *(f32x4*)(C + ro + bj * HALF + n * 16) = v;
          }
      }
  }
};
struct EpiGU {
  u16* O; const float* bias_all;
  __device__ __forceinline__ void operator()(const f32x4 (&acc)[2][2][4][2], const Unit& u, int wr, int wc, int fr, int fq) const {
    const float* bias = bias_all + (size_t)u.aux * 2048;
    const int row0 = u.row0 + wr * 64 + fr, col0 = u.col0 + wc * 32 + 4 * fq;
    f32x4 bg[2], bl[2];
#pragma unroll
    for (int n = 0; n < 2; ++n) { bg[n] = *(const f32x4*)(bias + col0 + n * 16); bl[n] = *(const f32x4*)(bias + 1024 + col0 + n * 16); }
#pragma unroll
    for (int ai = 0; ai < 2; ++ai)
#pragma unroll
      for (int m = 0; m < 4; ++m) {
        u16* rowp = O + (size_t)(row0 + ai * HALF + m * 16) * 1024 + col0;
#pragma unroll
        for (int n = 0; n < 2; ++n) {
          const f32x4 g4 = acc[ai][0][m][n] + bg[n], l4 = acc[ai][1][m][n] + bl[n];
          float a[4];
#pragma unroll
          for (int j = 0; j < 4; ++j) {
            const float glu = fminf(g4[j], 7.f), lin = fminf(fmaxf(l4[j], -7.f), 7.f);
            a[j] = (lin + 1.f) * glu * (1.f / (1.f + __expf(-1.702f * glu)));
          }
          uint2 w; w.x = pack2bf(a[0], a[1]); w.y = pack2bf(a[2], a[3]);
          *(uint2*)(rowp + n * 16) = w;
        }
      }
  }
};
struct EpiDN {
  u16* O; const float* bias_all;
  __device__ __forceinline__ void operator()(const f32x4 (&acc)[2][2][4][2], const Unit& u, int wr, int wc, int fr, int fq) const {
    const float* bias = bias_all + (size_t)u.aux * 1024;
    const int row0 = u.row0 + wr * 64 + fr, col0 = u.col0 + wc * 32 + 4 * fq;
    f32x4 bv[2][2];
#pragma unroll
    for (int bj = 0; bj < 2; ++bj)
#pragma unroll
      for (int n = 0; n < 2; ++n) bv[bj][n] = *(const f32x4*)(bias + col0 + bj * HALF + n * 16);
#pragma unroll
    for (int ai = 0; ai < 2; ++ai)
#pragma unroll
      for (int m = 0; m < 4; ++m) {
        u16* rowp = O + (size_t)(row0 + ai * HALF + m * 16) * 1024 + col0;
#pragma unroll
        for (int bj = 0; bj < 2; ++bj)
#pragma unroll
          for (int n = 0; n < 2; ++n) {
            const f32x4 v = acc[ai][bj][m][n] + bv[bj][n];
            uint2 w; w.x = pack2bf(v[0], v[1]); w.y = pack2bf(v[2], v[3]);
            *(uint2*)(rowp + bj * HALF + n * 16) = w;
          }
      }
  }
};
}

constexpr int SM_TAIL = 157 * 1024;
__device__ void phase_gemm_in(const Params& p, char* smem) {
  g8::SchedDense S{(const char*)(p.ws + OFF_XN), (const char*)(p.ws + OFF_WINT), D, T / 256, DINP / 256, (T / 256) * (DINP / 256), (int)gridDim.x, (int)blockIdx.x};
  g8::EpiF32 E{(float*)(p.ws + OFF_Z), nullptr, DINP};
  g8::gemm_phase<g8::SchedDense, g8::EpiF32, false>((LAS unsigned char*)smem, D, S, E, nullptr);
}

__device__ void phase_post_attn(const Params& p) {
  const float* z = (const float*)(p.ws + OFF_Z);
  u16* qr = (u16*)(p.ws + OFF_QR); u16* kr = (u16*)(p.ws + OFF_KR); u16* vv = (u16*)(p.ws + OFF_VV);
  u16* iq = (u16*)(p.ws + OFF_IQ); u16* ik = (u16*)(p.ws + OFF_IK); float* iw = (float*)(p.ws + OFF_IW);
  const float INVF8[8] = {1.0f, 0.1939227432012558f, 0.03760603070259094f, 0.007292664609849453f,
                          0.0014142135623842478f, 0.00027424818836152554f, 5.318296098266728e-05f, 1.0313386155758053e-05f};
  const float INVF4[4] = {1.0f, 0.03760603070259094f, 0.0014142135623842478f, 5.318296098266728e-05f};
  int lane = threadIdx.x & 63, wid = threadIdx.x >> 6;
  int gw = blockIdx.x * 8 + wid, nw = gridDim.x * 8;
  const int sub = lane & 7;
  float* qsh = (float*)(p.ws + OFF_QSH);
  float kwmax = fabsf(p.k_norm_w[lane]);
#pragma unroll
  for (int o = 32; o >= 1; o >>= 1) kwmax = fmaxf(kwmax, __shfl_xor(kwmax, o));
  for (int t = gw; t < T; t += nw) {
    const float* zr = z + (size_t)t * DINP;
    const float pos = (float)p.positions[t];
    float cs8[8], sn8[8];
#pragma unroll
    for (int i = 0; i < 8; ++i) sincos_big(pos * INVF8[i], sn8[i], cs8[i]);
#pragma unroll
    for (int which = 0; which < 2; ++which) {
      const float* src = zr + (which ? C_K : C_Q) + lane * 8;
      const float* nw_ = (which ? p.k_norm_w : p.q_norm_w) + sub * 8;
      float4 a = *(const float4*)src, b = *(const float4*)(src + 4);
      float v[8] = {a.x, a.y, a.z, a.w, b.x, b.y, b.z, b.w};
      float ss = 0.f;
#pragma unroll
      for (int i = 0; i < 8; ++i) ss += v[i] * v[i];
      ss += __shfl_xor(ss, 1); ss += __shfl_xor(ss, 2); ss += __shfl_xor(ss, 4);
      float rstd = rsqrtf(ss * (1.f / 64.f) + 1e-6f);
      float y[8], o[8];
#pragma unroll
      for (int i = 0; i < 8; ++i) y[i] = v[i] * rstd * nw_[i];
#pragma unroll
      for (int i = 0; i < 8; ++i) {
        float oth = __shfl_xor(y[i], 1);
        float r0 = y[i] * cs8[i] - oth * sn8[i];
        float r1 = y[i] * cs8[i] + oth * sn8[i];
        o[i] = (sub == 0) ? r0 : ((sub == 1) ? r1 : y[i]);
      }
      const float sc = which ? 1.f : (0.125f * 1.4426950408889634f);
      u32 hw[4]; float n2 = 0.f;
#pragma unroll
      for (int i = 0; i < 4; ++i) {
        __half h0 = __float2half_rn(o[2 * i] * sc), h1 = __float2half_rn(o[2 * i + 1] * sc);
        float f0 = __half2float(h0), f1 = __half2float(h1);
        n2 += f0 * f0 + f1 * f1;
        hw[i] = (u32)__half_as_ushort(h0) | ((u32)__half_as_ushort(h1) << 16);
      }
      uint4 w; w.x = hw[0]; w.y = hw[1]; w.z = hw[2]; w.w = hw[3];
      const int hd = lane >> 3;
      *(uint4*)((which ? kr : qr) + ((size_t)hd * T + t) * 64 + sub * 8) = w;
      if (which == 0) {
        n2 += __shfl_xor(n2, 1); n2 += __shfl_xor(n2, 2); n2 += __shfl_xor(n2, 4);
        if (sub == 0) qsh[(size_t)hd * T + t] = sqrtf(n2) * 8.f * kwmax * 1.01f;
      }
    }
    {
      const float* src = zr + C_V + lane * 8;
      float4 a = *(const float4*)src, b = *(const float4*)(src + 4);
      float v[8] = {a.x, a.y, a.z, a.w, b.x, b.y, b.z, b.w};
      u32 hw[4];
#pragma unroll
      for (int i = 0; i < 4; ++i) hw[i] = (u32)__half_as_ushort(__float2half_rn(v[2 * i])) | ((u32)__half_as_ushort(__float2half_rn(v[2 * i + 1])) << 16);
      uint4 w; w.x = hw[0]; w.y = hw[1]; w.z = hw[2]; w.w = hw[3];
      *(uint4*)(vv + ((size_t)(lane >> 3) * T + t) * 64 + sub * 8) = w;
    }
    float cs4[4], sn4[4];
#pragma unroll
    for (int i = 0; i < 4; ++i) sincos_big(pos * INVF4[i], sn4[i], cs4[i]);
    {
      float4 a = *(const float4*)(zr + C_IQ + lane * 4);
      float y[4] = {a.x, a.y, a.z, a.w}, o[4];
#pragma unroll
      for (int i = 0; i < 4; ++i) {
        float oth = __shfl_xor(y[i], 1);
        float r0 = y[i] * cs4[i] - oth * sn4[i];
        float r1 = y[i] * cs4[i] + oth * sn4[i];
        o[i] = (sub == 0) ? r0 : ((sub == 1) ? r1 : y[i]);
      }
      uint2 w; w.x = pack2bf(o[0], o[1]); w.y = pack2bf(o[2], o[3]);
      *(uint2*)(iq + (size_t)t * 256 + lane * 4) = w;
    }
    {
      float4 a = (lane < 8) ? *(const float4*)(zr + C_IK + lane * 4) : make_float4(0, 0, 0, 0);
      float y[4] = {a.x, a.y, a.z, a.w}, o[4];
#pragma unroll
      for (int i = 0; i < 4; ++i) {
        float oth = __shfl_xor(y[i], 1);
        float r0 = y[i] * cs4[i] - oth * sn4[i];
        float r1 = y[i] * cs4[i] + oth * sn4[i];
        o[i] = (sub == 0) ? r0 : ((sub == 1) ? r1 : y[i]);
      }
      if (lane < 8) {
        uint2 w; w.x = pack2bf(o[0], o[1]); w.y = pack2bf(o[2], o[3]);
        *(uint2*)(ik + (size_t)(t >> 5) * 1024 + (size_t)(((lane >> 2) * 2 + ((lane >> 1) & 1)) * 256 + (t & 31) * 8 + (lane & 1) * 4)) = w;
        iw[(size_t)t * 8 + lane] = zr[C_IW + lane];
      }
    }
  }
}

__device__ void phase_post_rwkv(const Params& p, char* smem) {
  const float* z = (const float*)(p.ws + OFF_Z);
  float* sv = (float*)(p.ws + OFF_SV); float* G = (float*)(p.ws + OFF_G); float* BON = (float*)(p.ws + OFF_BONUS);
  float* lora = (float*)smem;
  const int tid = threadIdx.x, lane = tid & 63, h = tid >> 6, c = tid;
  const float mu_r = p.rwkv_mu[c], mu_k = p.rwkv_mu[512 + c], mu_v = p.rwkv_mu[1024 + c];
  const float w0 = p.rwkv_w0[c], a0 = p.rwkv_a0[c], kkw = p.rwkv_k_k[c], kaw = p.rwkv_k_a[c], rkw = p.rwkv_r_k[c];
  float wr2[32], ar2[32], gr2[64];
#pragma unroll
  for (int j = 0; j < 32; ++j) { wr2[j] = p.rwkv_w2[j * 512 + c]; ar2[j] = p.rwkv_a2[j * 512 + c]; }
#pragma unroll
  for (int j = 0; j < 64; ++j) gr2[j] = p.rwkv_g2[j * 512 + c];
  for (int tg = blockIdx.x; tg < T / 8; tg += gridDim.x) {
    const int t0 = tg * 8;
#pragma unroll
    for (int i = 0; i < 2; ++i) {
      int item = tid + 512 * i, tok = item >> 7, j = item & 127, t = t0 + tok;
      int col = C_RW + 1536 + j;
      float zc = z[(size_t)t * DINP + col];
      float zp = (t > 0) ? z[(size_t)(t - 1) * DINP + col] : 0.f;
      float xs = zc + (zp - zc) * p.rwkv_mu[1536 + j];
      float o = (j < 32) ? tanhf(xs) : ((j < 64) ? xs : sigmoidf_(xs));
      lora[tok * 128 + j] = o;
    }
    __syncthreads();
    float zr9[9], zk9[9], zv9[9];
#pragma unroll
    for (int k = 0; k < 9; ++k) {
      const int t = t0 - 1 + k;
      if (t >= 0) { const float* zp_ = z + (size_t)t * DINP + C_RW; zr9[k] = zp_[c]; zk9[k] = zp_[512 + c]; zv9[k] = zp_[1024 + c]; }
      else { zr9[k] = 0.f; zk9[k] = 0.f; zv9[k] = 0.f; }
    }
#pragma unroll
    for (int k = 0; k < 8; ++k) {
      const f32x4* lr = (const f32x4*)(lora + k * 128);
      float w0_ = 0.f, w1_ = 0.f, a0_ = 0.f, a1_ = 0.f, g0_ = 0.f, g1_ = 0.f;
#pragma unroll
      for (int j = 0; j < 8; ++j) {
        const f32x4 lw = lr[j];
        w0_ += lw[0] * wr2[4 * j] + lw[2] * wr2[4 * j + 2]; w1_ += lw[1] * wr2[4 * j + 1] + lw[3] * wr2[4 * j + 3];
      }
      asm volatile("" : "+v"(w0_), "+v"(w1_) :: "memory");
#pragma unroll
      for (int j = 0; j < 8; ++j) {
        const f32x4 la = lr[8 + j];
        a0_ += la[0] * ar2[4 * j] + la[2] * ar2[4 * j + 2]; a1_ += la[1] * ar2[4 * j + 1] + la[3] * ar2[4 * j + 3];
      }
      asm volatile("" : "+v"(a0_), "+v"(a1_) :: "memory");
#pragma unroll
      for (int j = 0; j < 8; ++j) {
        const f32x4 lg = lr[16 + j];
        g0_ += lg[0] * gr2[4 * j] + lg[2] * gr2[4 * j + 2]; g1_ += lg[1] * gr2[4 * j + 1] + lg[3] * gr2[4 * j + 3];
      }
      asm volatile("" : "+v"(g0_), "+v"(g1_) :: "memory");
#pragma unroll
      for (int j = 8; j < 16; ++j) {
        const f32x4 lg = lr[16 + j];
        g0_ += lg[0] * gr2[4 * j] + lg[2] * gr2[4 * j + 2]; g1_ += lg[1] * gr2[4 * j + 1] + lg[3] * gr2[4 * j + 3];
      }
      asm volatile("" : "+v"(g0_), "+v"(g1_) :: "memory");
      const float aw_k = w0_ + w1_, aa_k = a0_ + a1_, ag_k = g0_ + g1_;
      const int t = t0 + k;
      const float rc = zr9[k + 1], kc = zk9[k + 1], vc = zv9[k + 1];
      const float rp = zr9[k], kp = zk9[k], vp = zv9[k];
      float r = rc + (rp - rc) * mu_r, kx = kc + (kp - kc) * mu_k, v = vc + (vp - vc) * mu_v;
      float xw = -(w0 + aw_k);
      float sp = fmaxf(xw, 0.f) + log1pf(__expf(-fabsf(xw)));
      float logw = -sp - 0.5f;
      float decay = __expf(-__expf(logw));
      float a = sigmoidf_(a0 + aa_k);
      float kk = kx * kkw;
      float ss = wave_sum(kk * kk);
      kk *= rsqrtf(fmaxf(ss, 1e-24f));
      float kmod = kx * (1.f + (a - 1.f) * kaw);
      float bon = wave_sum(r * kmod * rkw);
      float* o = sv + ((size_t)t * 8 + h) * 384 + lane;
      o[0] = decay; o[64] = kk; o[128] = kk * a; o[192] = kmod; o[256] = r; o[320] = v;
      G[(size_t)t * 512 + c] = ag_k;
      if (lane == 0) BON[(size_t)t * 8 + h] = bon;
    }
    __syncthreads();
  }
}

typedef float f2 __attribute__((ext_vector_type(2)));
#define SB_ __builtin_amdgcn_sched_barrier(0)
#define PIN16(o) asm volatile("" : "+v"(S2[o+0]), "+v"(S2[o+1]), "+v"(S2[o+2]), "+v"(S2[o+3]), "+v"(S2[o+4]), "+v"(S2[o+5]), "+v"(S2[o+6]), "+v"(S2[o+7]), \
    "+v"(S2[o+8]), "+v"(S2[o+9]), "+v"(S2[o+10]), "+v"(S2[o+11]), "+v"(S2[o+12]), "+v"(S2[o+13]), "+v"(S2[o+14]), "+v"(S2[o+15]) :: "memory")
#define SC_LO(v) ((f2){(v)[0], (v)[1]})
#define SC_HI(v) ((f2){(v)[2], (v)[3]})

__device__ __forceinline__ float dpp_qp1(float v) { return __uint_as_float(__builtin_amdgcn_update_dpp(0u, __float_as_uint(v), 0xB1, 0xF, 0xF, true)); }
__device__ __forceinline__ float dpp_qp2(float v) { return __uint_as_float(__builtin_amdgcn_update_dpp(0u, __float_as_uint(v), 0x4E, 0xF, 0xF, true)); }
__device__ __forceinline__ float red4(float v) { v += dpp_qp1(v); v += dpp_qp2(v); return v; }

#define SCAN_DMA(base, ldsbuf) do { \
    __builtin_amdgcn_global_load_lds((const unsigned*)((base) + go0), (LAS unsigned*)(ldsbuf), 16, 0, 0); \
    __builtin_amdgcn_global_load_lds((const unsigned*)((base) + go1), (LAS unsigned*)((ldsbuf) + 256), 16, 0, 0); \
    __builtin_amdgcn_global_load_lds((const unsigned*)((base) + go2), (LAS unsigned*)((ldsbuf) + 512), 16, 0, 0); \
    __builtin_amdgcn_global_load_lds((const unsigned*)((base) + go3), (LAS unsigned*)((ldsbuf) + 768), 16, 0, 0); \
    __builtin_amdgcn_global_load_lds((const unsigned*)((base) + go4), (LAS unsigned*)((ldsbuf) + 1024), 16, 0, 0); \
    __builtin_amdgcn_global_load_lds((const unsigned*)((base) + go5), (LAS unsigned*)((ldsbuf) + 1280), 16, 0, 0); } while (0)

#define SCV_LD4(V, rec, q) do { const f32x4* rc_ = (const f32x4*)(rec) + (q) + 4 * cb; V[0] = rc_[0]; V[1] = rc_[1]; V[2] = rc_[2]; V[3] = rc_[3]; } while (0)
#define SCV_PAIR(V, jp) (((jp) & 1) ? SC_HI(V[(jp) >> 1]) : SC_LO(V[(jp) >> 1]))

template <int MODE>
__device__ void scan_task(const Params& p, int h, int c, float* wl  ) {
  const int lane = threadIdx.x & 63;
  const int ra = lane >> 2, cb = lane & 3;
  const float* sv = (const float*)(p.ws + OFF_SV);
  f2 S2[32];
  if (MODE == 0) {
#pragma unroll
    for (int i = 0; i < 4; ++i)
#pragma unroll
      for (int jp = 0; jp < 8; ++jp) S2[i * 8 + jp] = (f2){(4 * ra + i == 16 * cb + 2 * jp) ? 1.f : 0.f, (4 * ra + i == 16 * cb + 2 * jp + 1) ? 1.f : 0.f};
  } else if (MODE == 1) {
#pragma unroll
    for (int j = 0; j < 32; ++j) S2[j] = (f2){0.f, 0.f};
  } else {
    const float* si = (const float*)(p.ws + OFF_SI) + (size_t)(h * NCH + c) * 4096 + (4 * ra) * 64 + 16 * cb;
#pragma unroll
    for (int i = 0; i < 4; ++i)
#pragma unroll
      for (int q = 0; q < 4; ++q) { const float4 u = *(const float4*)(si + i * 64 + 4 * q); S2[i * 8 + 2 * q] = (f2){u.x, u.y}; S2[i * 8 + 2 * q + 1] = (f2){u.z, u.w}; }
  }
  float* Y = (float*)(p.ws + OFF_Y);
  const float* src = sv + ((size_t)(c * CHL) * 8 + h) * 384;
  const int f0 = lane, f1 = lane + 64, f2_ = lane + 128, f3 = lane + 192, f4 = lane + 256, f5 = lane + 320;
  const int go0 = (f0 / 96) * 3072 + (f0 % 96) * 4, go1 = (f1 / 96) * 3072 + (f1 % 96) * 4, go2 = (f2_ / 96) * 3072 + (f2_ % 96) * 4;
  const int go3 = (f3 / 96) * 3072 + (f3 % 96) * 4, go4 = (f4 / 96) * 3072 + (f4 % 96) * 4, go5 = (f5 / 96) * 3072 + (f5 % 96) * 4;
  SCAN_DMA(src, wl);
  constexpr int NG = CHL / 4;
  f32x4 KK[4], KN[4];
#define SCAN_STEP(KC, KNX, rec, nrec, tstep) do { \
    f32x4 W_[4], B_[4]; \
    SCV_LD4(W_, rec, 0); SCV_LD4(B_, rec, 32); SB_; \
    float d_[4]; \
    _Pragma("unroll") for (int i = 0; i < 4; ++i) { \
      f2 a_ = S2[i * 8] * SCV_PAIR(KC, 0); \
      _Pragma("unroll") for (int jp = 1; jp < 8; ++jp) a_ += S2[i * 8 + jp] * SCV_PAIR(KC, jp); \
      d_[i] = red4(a_[0] + a_[1]); } \
    asm volatile("" : "+v"(d_[0]), "+v"(d_[1]), "+v"(d_[2]), "+v"(d_[3]) :: "memory"); SB_; \
    f32x4 K_[4]; f32x4 R_[4]; f32x4 v4_ = {0.f, 0.f, 0.f, 0.f}; \
    if (MODE != 0) { SCV_LD4(K_, rec, 48); v4_ = ((const f32x4*)(rec))[80 + ra]; } \
    if (MODE == 2) SCV_LD4(R_, rec, 64); \
    if ((nrec) != nullptr) SCV_LD4(KNX, nrec, 16); \
    SB_; \
    _Pragma("unroll") for (int i = 0; i < 4; ++i) { \
      const f2 ns_ = (f2){-d_[i], -d_[i]}; \
      _Pragma("unroll") for (int jp = 0; jp < 8; ++jp) S2[i * 8 + jp] = S2[i * 8 + jp] * SCV_PAIR(W_, jp) + ns_ * SCV_PAIR(B_, jp); } \
    PIN16(0); PIN16(16); SB_; \
    if (MODE != 0) { \
      _Pragma("unroll") for (int i = 0; i < 4; ++i) { \
        const f2 vi_ = (f2){v4_[i], v4_[i]}; \
        _Pragma("unroll") for (int jp = 0; jp < 8; ++jp) S2[i * 8 + jp] += vi_ * SCV_PAIR(K_, jp); } \
      PIN16(0); PIN16(16); SB_; } \
    if (MODE == 2) { \
      float y_ = 0.f; \
      _Pragma("unroll") for (int i = 0; i < 4; ++i) { \
        f2 a_ = S2[i * 8] * SCV_PAIR(R_, 0); \
        _Pragma("unroll") for (int jp = 1; jp < 8; ++jp) a_ += S2[i * 8 + jp] * SCV_PAIR(R_, jp); \
        const float e_ = red4(a_[0] + a_[1]); \
        y_ = (cb == i) ? e_ : y_; } \
      Y[(size_t)(tstep) * 512 + h * 64 + lane] = y_;         \
      SB_; } \
  } while (0)
  for (int g = 0; g < NG; ++g) {
    asm volatile("s_waitcnt vmcnt(0)" ::: "memory");
    if (g + 1 < NG) SCAN_DMA(src + (size_t)(g + 1) * 4 * 3072, wl + ((g + 1) & 1) * 1536);
    const float* Lb = wl + (g & 1) * 1536;
    const int tb = c * CHL + g * 4;
    SCV_LD4(KK, Lb, 16); SB_;
    SCAN_STEP(KK, KN, Lb, Lb + 384, tb);
    SCAN_STEP(KN, KK, Lb + 384, Lb + 768, tb + 1);
    SCAN_STEP(KK, KN, Lb + 768, Lb + 1152, tb + 2);
    SCAN_STEP(KN, KK, Lb + 1152, (const float*)nullptr, tb + 3);
  }
  if (MODE != 2) {
    float* o = (float*)(p.ws + (MODE == 0 ? OFF_SP : OFF_SL)) + (size_t)(h * NCH + c) * 4096 + (4 * ra) * 64 + 16 * cb;
#pragma unroll
    for (int i = 0; i < 4; ++i)
#pragma unroll
      for (int q = 0; q < 4; ++q) *(float4*)(o + i * 64 + 4 * q) = make_float4(S2[i * 8 + 2 * q][0], S2[i * 8 + 2 * q][1], S2[i * 8 + 2 * q + 1][0], S2[i * 8 + 2 * q + 1][1]);
  }
#undef SCAN_STEP
}

__device__ void phase_scan_a(const Params& p, char* smem) {
  const int wid = __builtin_amdgcn_readfirstlane(threadIdx.x >> 6);
  float* wl = (float*)smem + wid * 3072;
  const int nw = gridDim.x * 8;
  for (int id = wid * (int)gridDim.x + (int)blockIdx.x; id < 8 * NCH; id += nw) scan_task<0>(p, id & 7, id >> 3, wl);
  for (int id = wid * (int)gridDim.x + (int)blockIdx.x; id < 16 * NCH; id += nw) { if (id >= 8 * NCH) scan_task<1>(p, id & 7, (id - 8 * NCH) >> 3, wl); }
}

__device__ __forceinline__ float rdlane(float v, int l) { return __uint_as_float(__builtin_amdgcn_readlane(__float_as_uint(v), l)); }

__device__ void scan_b_row(const Params& p, int h, int row, float* pbuf  ) {
  const int lane = threadIdx.x & 63;
  const float* SP = (const float*)(p.ws + OFF_SP) + (size_t)h * NCH * 4096;
  const float* SL = (const float*)(p.ws + OFF_SL) + (size_t)h * NCH * 4096 + row * 64 + lane;
  float* SI = (float*)(p.ws + OFF_SI) + (size_t)h * NCH * 4096 + row * 64 + lane;
  float sreg = 0.f;
  SI[0] = 0.f;
#define SB_DMA(c_, buf_) do { _Pragma("unroll") for (int i_ = 0; i_ < 16; ++i_) \
    __builtin_amdgcn_global_load_lds((const unsigned*)(SP + (size_t)(c_) * 4096 + (i_ * 64 + lane) * 4), (LAS unsigned*)((buf_) + i_ * 256), 16, 0, 0); } while (0)
  float lcur = SL[0];
  SB_DMA(0, pbuf);
  for (int c = 0; c < NCH - 1; ++c) {
    float* cb = pbuf + (c & 1) * 4096;
    float lnext = 0.f;
    if (c + 1 < NCH - 1) {
      lnext = SL[(size_t)(c + 1) * 4096];
      SB_DMA(c + 1, pbuf + ((c + 1) & 1) * 4096);
      asm volatile("s_waitcnt vmcnt(17)" ::: "memory");
    } else {
      asm volatile("s_waitcnt vmcnt(0)" ::: "memory");
    }
    float a0 = lcur, a1 = 0.f, a2 = 0.f, a3 = 0.f;
#pragma unroll
    for (int k = 0; k < 64; k += 4) {
      a0 = __builtin_fmaf(rdlane(sreg, k), cb[k * 64 + lane], a0); a1 = __builtin_fmaf(rdlane(sreg, k + 1), cb[(k + 1) * 64 + lane], a1);
      a2 = __builtin_fmaf(rdlane(sreg, k + 2), cb[(k + 2) * 64 + lane], a2); a3 = __builtin_fmaf(rdlane(sreg, k + 3), cb[(k + 3) * 64 + lane], a3);
    }
    sreg = (a0 + a1) + (a2 + a3);
    SI[(size_t)(c + 1) * 4096] = sreg;
    lcur = lnext;
  }
#undef SB_DMA
}

__device__ void transpose_convert_wave(const float* src, u16* dst, int R, int C, int nbatch, int id0, int id1, int wv, int nwaves) {
  const int lane = threadIdx.x & 63, ng = lane & 15, g = lane >> 4;
  const int tr = R / 64, tc = C / 64;
#pragma unroll 1
  for (int id = id0 + wv; id < id1; id += nwaves) {
    const int b = id / (tr * tc), rem = id % (tr * tc);
    const int r0 = (rem / tc) * 64, c0 = (rem % tc) * 64;
    const float* s = src + (size_t)b * R * C + (size_t)(r0 + 8 * g) * C + c0 + 4 * ng;
    u16* d = dst + (size_t)b * C * R + (size_t)(c0 + 4 * ng) * R + r0 + 8 * g;
#pragma unroll
    for (int hf = 0; hf < 2; ++hf) {
      float4 v[8];
#pragma unroll
      for (int i = 0; i < 8; ++i) v[i] = *(const float4*)(s + (size_t)(hf * 32 + i) * C);
      uint4 o0, o1, o2, o3;
      o0.x = pack2bf(v[0].x, v[1].x); o0.y = pack2bf(v[2].x, v[3].x); o0.z = pack2bf(v[4].x, v[5].x); o0.w = pack2bf(v[6].x, v[7].x);
      o1.x = pack2bf(v[0].y, v[1].y); o1.y = pack2bf(v[2].y, v[3].y); o1.z = pack2bf(v[4].y, v[5].y); o1.w = pack2bf(v[6].y, v[7].y);
      o2.x = pack2bf(v[0].z, v[1].z); o2.y = pack2bf(v[2].z, v[3].z); o2.z = pack2bf(v[4].z, v[5].z); o2.w = pack2bf(v[6].z, v[7].z);
      o3.x = pack2bf(v[0].w, v[1].w); o3.y = pack2bf(v[2].w, v[3].w); o3.z = pack2bf(v[4].w, v[5].w); o3.w = pack2bf(v[6].w, v[7].w);
      *(uint4*)(d + hf * 32) = o0; *(uint4*)(d + (size_t)R + hf * 32) = o1; *(uint4*)(d + (size_t)2 * R + hf * 32) = o2; *(uint4*)(d + (size_t)3 * R + hf * 32) = o3;
    }
  }
}
constexpr int PREP_GU_TILES = NE * 16 * 32, PREP_DN_TILES = NE * 16 * 16, PREP_TILES = PREP_GU_TILES + PREP_DN_TILES;
constexpr int PREP_SPLIT = 0;
__device__ void prep_expert_range(const Params& p, int lo, int hi, int wv, int nwaves) {
  if (lo < PREP_GU_TILES) transpose_convert_wave(p.exp_w_gu, (u16*)(p.ws + OFF_WGUT), 1024, 2048, NE, lo, hi < PREP_GU_TILES ? hi : PREP_GU_TILES, wv, nwaves);
  if (hi > PREP_GU_TILES) {
    const int l2 = (lo > PREP_GU_TILES ? lo : PREP_GU_TILES) - PREP_GU_TILES;
    transpose_convert_wave(p.exp_w_down, (u16*)(p.ws + OFF_WDNT), 1024, 1024, NE, l2, hi - PREP_GU_TILES, wv, nwaves);
  }
}

__device__ void scan_b_block(const Params& p, int h, int rg, float* ring  ) {
  const int lane = threadIdx.x & 63, w = __builtin_amdgcn_readfirstlane(threadIdx.x >> 6);
  const int row = rg * 8 + w;
  const float* SP = (const float*)(p.ws + OFF_SP) + (size_t)h * NCH * 4096;
  const float* SL = (const float*)(p.ws + OFF_SL) + (size_t)h * NCH * 4096 + row * 64 + lane;
  float* SI = (float*)(p.ws + OFF_SI) + (size_t)h * NCH * 4096 + row * 64 + lane;
  float sreg = 0.f;
  SI[0] = 0.f;
#define SBB_DMA(c_, buf_) do { \
    __builtin_amdgcn_global_load_lds((const unsigned*)(SP + (size_t)(c_) * 4096 + ((2 * w) * 64 + lane) * 4), (LAS unsigned*)((buf_) + (2 * w) * 256), 16, 0, 0); \
    __builtin_amdgcn_global_load_lds((const unsigned*)(SP + (size_t)(c_) * 4096 + ((2 * w + 1) * 64 + lane) * 4), (LAS unsigned*)((buf_) + (2 * w + 1) * 256), 16, 0, 0); } while (0)
  constexpr int LASTC = NCH - 2;
  float l0 = SL[0]; SBB_DMA(0, ring);
  float l1 = SL[(size_t)1 * 4096]; SBB_DMA(1, ring + 4096);
  for (int c = 0; c < NCH - 1; ++c) {
    asm volatile("s_waitcnt vmcnt(3)" ::: "memory");
    __builtin_amdgcn_s_barrier();
    const int cn = (c + 2 <= LASTC) ? (c + 2) : LASTC;
    const float l2 = SL[(size_t)cn * 4096];
    SBB_DMA(cn, ring + ((c + 2) % 3) * 4096);
    const float* cb = ring + (c % 3) * 4096;
    float a0 = l0, a1 = 0.f, a2 = 0.f, a3 = 0.f;
#pragma unroll
    for (int k = 0; k < 64; k += 4) {
      a0 = __builtin_fmaf(rdlane(sreg, k), cb[k * 64 + lane], a0); a1 = __builtin_fmaf(rdlane(sreg, k + 1), cb[(k + 1) * 64 + lane], a1);
      a2 = __builtin_fmaf(rdlane(sreg, k + 2), cb[(k + 2) * 64 + lane], a2); a3 = __builtin_fmaf(rdlane(sreg, k + 3), cb[(k + 3) * 64 + lane], a3);
    }
    sreg = (a0 + a1) + (a2 + a3);
    SI[(size_t)(c + 1) * 4096] = sreg;
    l0 = l1; l1 = l2;
  }
  asm volatile("s_waitcnt vmcnt(0)" ::: "memory");
  __syncthreads();
#undef SBB_DMA
}

__device__ void phase_scan_c(const Params& p, char* smem) {
  const int wid = __builtin_amdgcn_readfirstlane(threadIdx.x >> 6);
  const int nw = gridDim.x * 4;
  if (wid < 4) {
    float* wl = (float*)smem + wid * 3072;
    for (int id = wid * (int)gridDim.x + (int)blockIdx.x; id < 8 * NCH; id += nw) scan_task<2>(p, id & 7, id >> 3, wl);
  } else {
    prep_expert_range(p, PREP_SPLIT, PREP_TILES, (wid - 4) * (int)gridDim.x + (int)blockIdx.x, nw);
  }
}

__device__ void phase_rwkv_out(const Params& p) {
  const float* Y = (const float*)(p.ws + OFF_Y); const float* sv = (const float*)(p.ws + OFF_SV);
  const float* G = (const float*)(p.ws + OFF_G); const float* BON = (const float*)(p.ws + OFF_BONUS);
  u16* mix = (u16*)(p.ws + OFF_MIX);
  const int tid = threadIdx.x, lane = tid & 63, h = tid >> 6;
  const float lw = p.rwkv_ln_w[tid], lb = p.rwkv_ln_b[tid];
  for (int t = blockIdx.x; t < T; t += gridDim.x) {
    float y = Y[(size_t)t * 512 + tid];
    float mean = wave_sum(y) * (1.f / 64.f);
    float d = y - mean;
    float var = wave_sum(d * d) * (1.f / 64.f);
    float o = d * rsqrtf(var + 64e-5f) * lw + lb;
    float v = sv[((size_t)t * 8 + h) * 384 + 320 + lane];
    o = (o + BON[(size_t)t * 8 + h] * v) * G[(size_t)t * 512 + tid];
    mix[(size_t)t * 1024 + 512 + tid] = f2bf(o);
  }
}

typedef short s16x2 __attribute__((ext_vector_type(2)));
__device__ __forceinline__ float irelu(float x) { return __int_as_float(max(__float_as_int(x), 0)); }
__device__ __forceinline__ u16 score_key(float s) {
  s = fminf(fmaxf(s, -60000.f), 60000.f);
  u16 b = __half_as_ushort(__float2half_rn(s));
  return (b & 0x8000u) ? (u16)(~b) : (u16)(b | 0x8000u);
}

__device__ __forceinline__ void topk_level1(const u32* hq, int lane, u32& Bs, u32& cnt_above) {
  u32 ssum = 0;
#pragma unroll
  for (int d = 0; d < 16; ++d) ssum += hq[16 * lane + d];
  u32 suf = ssum;
#pragma unroll
  for (int off = 1; off < 64; off <<= 1) { u32 o = __shfl_down(suf, off); if (lane + off < 64) suf += o; }
  unsigned long long m = __ballot(suf >= 256u);
  const int Ls = 63 - __clzll(m);
  const u32 above = __shfl(suf, Ls) - __shfl(ssum, Ls);
  const u32 c1 = (lane < 16) ? hq[16 * Ls + lane] : 0u;
  u32 suf2 = c1;
#pragma unroll
  for (int off = 1; off < 16; off <<= 1) { u32 o = __shfl_down(suf2, off); if (lane + off < 64) suf2 += o; }
  unsigned long long m2 = __ballot((lane < 16) && (above + suf2 >= 256u));
  const int js = 63 - __clzll(m2);
  Bs = (u32)(16 * Ls + js);
  cnt_above = above + __shfl(suf2, js) - __shfl(c1, js);
}

constexpr int TK_CAP = 512;
__device__ __forceinline__ u32 topk_candidates(const u16* keys, int n, int c0, int c1, u32 Bs, u32* h2, u16* list, int lane) {
  u32 running = 0;
  for (int it = c0; it < c1; ++it) {
    const int base = it * 512 + lane;
#pragma unroll
    for (int e = 0; e < 8; ++e) {
      const int idx = base + e * 64;
      const u32 k = keys[idx];
      const u32 bin = k >> 6;
      const bool f = (idx < n) && (bin >= Bs);
      const unsigned long long m = __ballot(f);
      if (m) {
        const u32 r = running + __builtin_amdgcn_mbcnt_hi((u32)(m >> 32), __builtin_amdgcn_mbcnt_lo((u32)m, 0u));
        if (f) {
          if (r < (u32)TK_CAP) list[r] = (u16)idx;
          if (bin == Bs) atomicAdd(&h2[k & 63u], 1u);
        }
        running += (u32)__popcll(m);
      }
    }
  }
  return running;
}

__device__ __forceinline__ void topk_emit(const u16* keys, const u16* list, int cnt, u32 Kstar, u32 need_eq, u32& base_gt, u32& base_eq, u16* selout, int lane) {
  for (int i0 = 0; i0 < cnt; i0 += 64) {
    const int i = i0 + lane;
    const bool v = i < cnt;
    const u32 idx = v ? (u32)list[i] : 0u;
    const u32 k = keys[idx];
    const bool g = v && k > Kstar, q = v && k == Kstar;
    const unsigned long long mg = __ballot(g), me = __ballot(q);
    const u32 gb = base_gt + __builtin_amdgcn_mbcnt_hi((u32)(mg >> 32), __builtin_amdgcn_mbcnt_lo((u32)mg, 0u));
    const u32 eb = base_eq + __builtin_amdgcn_mbcnt_hi((u32)(me >> 32), __builtin_amdgcn_mbcnt_lo((u32)me, 0u));
    if (g) selout[gb + min(eb, need_eq)] = (u16)idx;
    else if (q && eb < need_eq) selout[gb + eb] = (u16)idx;
    base_gt += (u32)__popcll(mg); base_eq += (u32)__popcll(me);
  }
}

__device__ __forceinline__ u32 topk_pass1(const u16* keys, int n, int c0, int c1, u32 Bs, u32* h2, int lane) {
  u32 cg = 0;
  for (int it = c0; it < c1; ++it) {
    const int base = it * 512 + lane * 8;
    uint4 kv = *(const uint4*)(keys + base);
    u32 w[4] = {kv.x, kv.y, kv.z, kv.w};
#pragma unroll
    for (int e = 0; e < 8; ++e) {
      u32 k = (e & 1) ? (w[e >> 1] >> 16) : (w[e >> 1] & 0xFFFFu);
      const bool valid = (base + e < n);
      const u32 bin = k >> 6;
      if (valid && bin == Bs) atomicAdd(&h2[k & 63u], 1u);
      cg += (valid && bin > Bs) ? 1u : 0u;
    }
  }
#pragma unroll
  for (int o = 32; o >= 1; o >>= 1) cg += __shfl_xor(cg, o);
  return cg;
}

__device__ __forceinline__ void topk_pass2(const u16* keys, int n, int c0, int c1, u32 Kstar, u32 need_eq, u32 base_gt, u32 base_eq, u16* selout, int lane) {
  for (int it = c0; it < c1; ++it) {
    const int base = it * 512 + lane * 8;
    uint4 kv = *(const uint4*)(keys + base);
    u32 w[4] = {kv.x, kv.y, kv.z, kv.w};
    bool g[8], q[8];
    u32 lcg = 0, lce = 0, tg = 0, te = 0;
#pragma unroll
    for (int e = 0; e < 8; ++e) {
      u32 k = (e & 1) ? (w[e >> 1] >> 16) : (w[e >> 1] & 0xFFFFu);
      const bool valid = (base + e < n);
      g[e] = valid && k > Kstar; q[e] = valid && k == Kstar;
      const unsigned long long mg = __ballot(g[e]), me = __ballot(q[e]);
      lcg += __builtin_amdgcn_mbcnt_hi((u32)(mg >> 32), __builtin_amdgcn_mbcnt_lo((u32)mg, 0u));
      lce += __builtin_amdgcn_mbcnt_hi((u32)(me >> 32), __builtin_amdgcn_mbcnt_lo((u32)me, 0u));
      tg += __popcll(mg); te += __popcll(me);
    }
    u32 gb = base_gt + lcg, eb = base_eq + lce;
#pragma unroll
    for (int e = 0; e < 8; ++e) {
      if (g[e]) selout[gb + min(eb, need_eq)] = (u16)(base + e);
      else if (q[e] && eb < need_eq) selout[gb + eb] = (u16)(base + e);
      gb += g[e] ? 1u : 0u; eb += q[e] ? 1u : 0u;
    }
    base_gt += tg; base_eq += te;
  }
}

__device__ void phase_topk(const Params& p, char* smem) {
  u16* keys = (u16*)smem;
  u32* hist = (u32*)(smem + 131072);
  u32* hist2 = hist + 4096;
  const u16* iq = (const u16*)(p.ws + OFF_IQ); const u16* ik = (const u16*)(p.ws + OFF_IK);
  const float* iw = (const float*)(p.ws + OFF_IW);
  u16* sel = (u16*)(p.ws + OFF_SEL);
  const int tid = threadIdx.x, lane = tid & 63, wid = tid >> 6;
  const int r = lane & 31, hh = lane >> 5;
  const int ngroups = (T - 256) / 4;
  if (blockIdx.x < 64) scan_b_block(p, blockIdx.x >> 3, blockIdx.x & 7, (float*)smem);
  int* const queue = (int*)(p.ws + OFF_CNT) + 48;
  volatile int* const qslot = (volatile int*)(smem + SM_TAIL + 32);
  for (;;) {
    __syncthreads();
    if (tid == 0) *qslot = atomicAdd(queue, 1);
    __syncthreads();
    const int gq = *qslot;
    if (gq >= ngroups) break;
    const int gsel = ngroups - 1 - gq;
    const int t0 = 256 + gsel * 4;
    for (int i = tid; i < 4096 + 288; i += NTHREADS) hist[i] = 0u;
    __syncthreads();
    PROF_T0(1)
    const u16* iqp = iq + ((size_t)(t0 + (r & 3)) * 8 + (r >> 2)) * 32 + 8 * hh;
    const bf16x8 a0 = *(const bf16x8*)iqp, a1 = *(const bf16x8*)(iqp + 16);
    float wq[16];
#pragma unroll
    for (int i = 0; i < 16; ++i) wq[i] = iw[(size_t)(t0 + (i & 3)) * 8 + 2 * (i >> 2) + hh];
    const int ntiles = (t0 + 4 + 31) >> 5;
#define TK_LOAD(KT, B0, B1) do { if ((KT) < ntiles) { const u16* ikp_ = ik + (size_t)(KT) * 1024 + hh * 256 + r * 8; \
      B0 = *(const bf16x8*)ikp_; B1 = *(const bf16x8*)(ikp_ + 512); } } while (0)
#define TK_TAIL2(SA, SB, LASTT) do { \
      const s16x2 hp_ = __builtin_bit_cast(s16x2, __builtin_amdgcn_cvt_pkrtz(SA, SB)); \
      const s16x2 sh_ = {15, 15}; \
      u32 k2_ = __builtin_bit_cast(u32, hp_) ^ (__builtin_bit_cast(u32, hp_ >> sh_) | 0x80008000u);     \
      if (LASTT) { if (key > t0 + hh) k2_ &= 0xFFFF0000u; if (key > t0 + 2 + hh) k2_ &= 0x0000FFFFu; } \
      keysa[key] = (u16)k2_; keysb[key] = (u16)(k2_ >> 16); \
      if (!(LASTT) || (k2_ & 0xFFFFu)) atomicAdd((u32*)((char*)hista + ((k2_ >> 4) & 0xFFCu)), 1u); \
      if (!(LASTT) || (k2_ >> 16)) atomicAdd((u32*)((char*)histb + ((k2_ >> 20) & 0xFFCu)), 1u); \
    } while (0)
#define TK_PROC(KT, B0, B1) do { \
      const int key = (KT) * 32 + r; \
      f32x16 acc; \
      _Pragma("unroll") for (int i_ = 0; i_ < 16; ++i_) acc[i_] = 0.f; \
      acc = __builtin_amdgcn_mfma_f32_32x32x16_bf16(a0, B0, acc, 0, 0, 0); \
      acc = __builtin_amdgcn_mfma_f32_32x32x16_bf16(a1, B1, acc, 0, 0, 0); \
      float s0 = 0.f, s1 = 0.f, s2 = 0.f, s3 = 0.f; \
      _Pragma("unroll") for (int i_ = 0; i_ < 16; i_ += 4) { \
        s0 = __builtin_fmaf(wq[i_], irelu(acc[i_]), s0); s1 = __builtin_fmaf(wq[i_ + 1], irelu(acc[i_ + 1]), s1); \
        s2 = __builtin_fmaf(wq[i_ + 2], irelu(acc[i_ + 2]), s2); s3 = __builtin_fmaf(wq[i_ + 3], irelu(acc[i_ + 3]), s3); } \
      auto sw01 = __builtin_amdgcn_permlane32_swap(__float_as_uint(s0), __float_as_uint(s1), false, false); \
      auto sw23 = __builtin_amdgcn_permlane32_swap(__float_as_uint(s2), __float_as_uint(s3), false, false); \
      const float sa = __uint_as_float(sw01[0]) + __uint_as_float(sw01[1]);     \
      const float sb = __uint_as_float(sw23[0]) + __uint_as_float(sw23[1]);     \
      if ((KT) == ntiles - 1) TK_TAIL2(sa, sb, true); else TK_TAIL2(sa, sb, false); \
    } while (0)
    u32* const hista = hist + hh * 1024;
    u32* const histb = hist + (2 + hh) * 1024;
    u16* const keysa = keys + hh * 16384;
    u16* const keysb = keys + (2 + hh) * 16384;
    {
      bf16x8 bA0, bA1, bB0, bB1, bC0, bC1, bD0, bD1, bE0, bE1, bF0, bF1, bG0, bG1, bH0, bH1;
      bA0 = bA1 = bB0 = bB1 = bC0 = bC1 = bD0 = bD1 = bE0 = bE1 = bF0 = bF1 = bG0 = bG1 = bH0 = bH1 = a0;
      int kt = wid;
      TK_LOAD(kt, bA0, bA1); TK_LOAD(kt + 8, bB0, bB1); TK_LOAD(kt + 16, bC0, bC1); TK_LOAD(kt + 24, bD0, bD1);
      TK_LOAD(kt + 32, bE0, bE1); TK_LOAD(kt + 40, bF0, bF1); TK_LOAD(kt + 48, bG0, bG1); TK_LOAD(kt + 56, bH0, bH1);
      for (; kt < ntiles; kt += 64) {
        TK_PROC(kt, bA0, bA1); TK_LOAD(kt + 64, bA0, bA1);
        if (kt + 8 < ntiles) { TK_PROC(kt + 8, bB0, bB1); TK_LOAD(kt + 72, bB0, bB1); }
        if (kt + 16 < ntiles) { TK_PROC(kt + 16, bC0, bC1); TK_LOAD(kt + 80, bC0, bC1); }
        if (kt + 24 < ntiles) { TK_PROC(kt + 24, bD0, bD1); TK_LOAD(kt + 88, bD0, bD1); }
        if (kt + 32 < ntiles) { TK_PROC(kt + 32, bE0, bE1); TK_LOAD(kt + 96, bE0, bE1); }
        if (kt + 40 < ntiles) { TK_PROC(kt + 40, bF0, bF1); TK_LOAD(kt + 104, bF0, bF1); }
        if (kt + 48 < ntiles) { TK_PROC(kt + 48, bG0, bG1); TK_LOAD(kt + 112, bG0, bG1); }
        if (kt + 56 < ntiles) { TK_PROC(kt + 56, bH0, bH1); TK_LOAD(kt + 120, bH0, bH1); }
      }
    }
    __syncthreads();
    PROF_T1(1)
    PROF_T0(2)
    {
      const int q = wid & 3, half = wid >> 2;
      const int tq = t0 + q, n = tq + 1;
      const u16* kq = keys + q * 16384;
      u32* h2 = hist2 + q * 64;
      u32* misc = hist2 + 256 + q * 4;
      u16* lists = (u16*)(hist2 + 288);
      u16* mylist = lists + (q * 2 + half) * TK_CAP;
      const int niter = (n + 511) >> 9, nh = (niter + 1) >> 1;
      const int c0 = half ? nh : 0, c1 = half ? niter : nh;
      u32 Bs, cnt_above;
      topk_level1(hist + q * 1024, lane, Bs, cnt_above);
      const u32 nc = topk_candidates(kq, n, c0, c1, Bs, h2, mylist, lane);
      if (lane == 0) misc[half] = nc;
      __syncthreads();
      if (half == 0) {
        const u32 c2 = h2[lane];
        const u32 need = 256u - cnt_above;
        u32 suf3 = c2;
#pragma unroll
        for (int off = 1; off < 64; off <<= 1) { u32 o = __shfl_down(suf3, off); if (lane + off < 64) suf3 += o; }
        unsigned long long m3 = __ballot(suf3 >= need);
        const int vs = 63 - __clzll(m3);
        const u32 Kstar = (Bs << 6) | (u32)vs;
        const u32 cnt_gt = cnt_above + __shfl(suf3, vs) - __shfl(c2, vs);
        const u32 need_eq = 256u - cnt_gt;
        const u32 na = misc[0], nb = misc[1];
        u16* so = sel + (size_t)tq * 256;
        if (na <= (u32)TK_CAP && nb <= (u32)TK_CAP) {
          u32 bg = 0, be = 0;
          topk_emit(kq, lists + (q * 2) * TK_CAP, (int)na, Kstar, need_eq, bg, be, so, lane);
          topk_emit(kq, lists + (q * 2 + 1) * TK_CAP, (int)nb, Kstar, need_eq, bg, be, so, lane);
        } else {
          topk_pass2(kq, n, 0, niter, Kstar, need_eq, 0u, 0u, so, lane);
        }
      }
    }
    __syncthreads();
    PROF_T1(2)
  }
}

typedef _Float16 h2_t __attribute__((ext_vector_type(2)));
__device__ __forceinline__ float dot2h(u32 a, u32 b, float c) { return __builtin_amdgcn_fdot2(__builtin_bit_cast(h2_t, a), __builtin_bit_cast(h2_t, b), c, false); }
__device__ __forceinline__ float hlo(u32 a) { return (float)(__builtin_bit_cast(h2_t, a)[0]); }
__device__ __forceinline__ float hhi(u32 a) { return (float)(__builtin_bit_cast(h2_t, a)[1]); }

__device__ __forceinline__ float dpp_xor1(float v) {
  return __uint_as_float(__builtin_amdgcn_update_dpp(0u, __float_as_uint(v), 0xB1, 0xF, 0xF, true));
}

__device__ void phase_attn(const Params& p, char* smem) {
  const u16* qh = (const u16*)(p.ws + OFF_QR); const u16* kh = (const u16*)(p.ws + OFF_KR); const u16* vh = (const u16*)(p.ws + OFF_VV);
  const u16* sel = (const u16*)(p.ws + OFF_SEL); const float* qsh = (const float*)(p.ws + OFF_QSH);
  u16* mix = (u16*)(p.ws + OFF_MIX);
  uint4* sK = (uint4*)smem;
  uint4* sV = (uint4*)(smem + 65536);
  const int tid = threadIdx.x;
  const int ql = tid >> 1, hp = tid & 1, rot = (tid >> 1) & 3;
  for (int it2 = 0; it2 < 2; ++it2) {
    const int item0 = it2 ? (511 - (int)blockIdx.x) : (int)blockIdx.x;
    for (int item = item0; item >= 0 && item < 512; item += (it2 ? -(int)gridDim.x : (int)gridDim.x)) {
      if (it2 == 0 && item >= 256) break;
      if (it2 == 1 && item < 256) break;
      const int h = item & 7, qb = item >> 3;
      const int t = qb * 256 + ql;
      const uint4* qp = (const uint4*)(qh + ((size_t)h * T + t) * 64) + 4 * hp;
      const uint4 q0 = qp[(0 + rot) & 3], q1 = qp[(1 + rot) & 3], q2 = qp[(2 + rot) & 3], q3 = qp[(3 + rot) & 3];
      const float nshift = -0.5f * qsh[(size_t)h * T + t];
      float acc[32];
#pragma unroll
      for (int i = 0; i < 32; ++i) acc[i] = 0.f;
      float lsum = 0.f;
      const int nsel = (t + 1 < 256) ? (t + 1) : 256;
      const bool dense = t < 256;
      const uint4* sp = (const uint4*)(sel + (size_t)t * 256);
      uint4 cur = make_uint4(0, 0, 0, 0), nxt = make_uint4(0, 0, 0, 0);
      if (!dense) { cur = sp[0]; nxt = sp[1]; }
      int ptr = 0;
      int nextidx = dense ? 0 : (int)(cur.x & 0xFFFFu);
      const int nchunks = (qb >> 1) + 1;
      const int o0 = 4 * hp + ((0 + rot) & 3), o1 = 4 * hp + ((1 + rot) & 3), o2 = 4 * hp + ((2 + rot) & 3), o3 = 4 * hp + ((3 + rot) & 3);
      for (int c = 0; c < nchunks; ++c) {
        PROF_T0(3)
        __syncthreads();
        {
          const uint4* kg = (const uint4*)(kh + ((size_t)h * T + c * 512) * 64) + tid;
          const uint4* vg = (const uint4*)(vh + ((size_t)h * T + c * 512) * 64) + tid;
          uint4 t0 = kg[0], t1 = kg[512], t2 = kg[1024], t3 = kg[1536], t4 = kg[2048], t5 = kg[2560], t6 = kg[3072], t7 = kg[3584];
          uint4 u0 = vg[0], u1 = vg[512], u2 = vg[1024], u3 = vg[1536], u4 = vg[2048], u5 = vg[2560], u6 = vg[3072], u7 = vg[3584];
          __builtin_amdgcn_sched_barrier(0);
          uint4* dk = sK + tid; uint4* dv = sV + tid;
          dk[0] = t0; dk[512] = t1; dk[1024] = t2; dk[1536] = t3; dk[2048] = t4; dk[2560] = t5; dk[3072] = t6; dk[3584] = t7;
          dv[0] = u0; dv[512] = u1; dv[1024] = u2; dv[1536] = u3; dv[2048] = u4; dv[2560] = u5; dv[3072] = u6; dv[3584] = u7;
        }
        __syncthreads();
        PROF_T1(3)
        PROF_T0(4)
        const int cbase = c * 512, cend = cbase + 512;
        while (ptr < nsel && nextidx < cend) {
          const int lk = nextidx - cbase;
          const uint4* krow = sK + lk * 8;
          const uint4* vrow = sV + lk * 8;
          float d = nshift;
#define ATT_DOT(Q, O) { const uint4 kv = krow[O]; d = dot2h(Q.x, kv.x, d); d = dot2h(Q.y, kv.y, d); d = dot2h(Q.z, kv.z, d); d = dot2h(Q.w, kv.w, d); }
          ATT_DOT(q0, o0) ATT_DOT(q1, o1) ATT_DOT(q2, o2) ATT_DOT(q3, o3)
          d += dpp_xor1(d);
          const float pe = __builtin_amdgcn_exp2f(d);
          lsum += pe;
#define ATT_MIX(A, W) do { asm volatile("v_fma_mix_f32 %0, %2, %3, %0 op_sel_hi:[0,1,0]\n\tv_fma_mix_f32 %1, %2, %3, %1 op_sel:[0,1,0] op_sel_hi:[0,1,0]" \
            : "+v"(acc[A]), "+v"(acc[(A) + 1]) : "v"(pe), "v"(W)); } while (0)
#define ATT_PV(J, O) { const uint4 vv4 = vrow[O]; ATT_MIX(8 * J + 0, vv4.x); ATT_MIX(8 * J + 2, vv4.y); ATT_MIX(8 * J + 4, vv4.z); ATT_MIX(8 * J + 6, vv4.w); }
          ATT_PV(0, o0) ATT_PV(1, o1) ATT_PV(2, o2) ATT_PV(3, o3)
          ++ptr;
          if (dense) nextidx = ptr;
          else {
            cur.x = (cur.x >> 16) | (cur.y << 16); cur.y = (cur.y >> 16) | (cur.z << 16); cur.z = (cur.z >> 16) | (cur.w << 16); cur.w >>= 16;
            if ((ptr & 7) == 0) { cur = nxt; if (ptr + 8 < 256) nxt = sp[(ptr >> 3) + 1]; }
            nextidx = (int)(cur.x & 0xFFFFu);
          }
        }
        PROF_T1(4)
      }
      const float inv = 1.f / lsum;
      u16* orow = mix + (size_t)t * 1024 + h * 64;
#define ATT_OUT(J, O) { uint4 o; o.x = pack2bf(acc[8 * J] * inv, acc[8 * J + 1] * inv); o.y = pack2bf(acc[8 * J + 2] * inv, acc[8 * J + 3] * inv); \
        o.z = pack2bf(acc[8 * J + 4] * inv, acc[8 * J + 5] * inv); o.w = pack2bf(acc[8 * J + 6] * inv, acc[8 * J + 7] * inv); *(uint4*)(orow + (O) * 8) = o; }
      ATT_OUT(0, o0) ATT_OUT(1, o1) ATT_OUT(2, o2) ATT_OUT(3, o3)
    }
  }
}

__device__ void phase_gemm_out(const Params& p, char* smem) {
  g8::SchedDense S{(const char*)(p.ws + OFF_MIX), (const char*)(p.ws + OFF_WOUTT), 1024, T / 256, 4, (T / 256) * 4, (int)gridDim.x, (int)blockIdx.x};
  g8::EpiF32 E{(float*)(p.ws + OFF_H1), p.x, 1024};
  g8::gemm_phase<g8::SchedDense, g8::EpiF32, false>((LAS unsigned char*)smem, 1024, S, E, nullptr);
}

__device__ void phase_router(const Params& p, char* smem) {
  const float* h1 = (const float*)(p.ws + OFF_H1);
  u16* xn2 = (u16*)(p.ws + OFF_XN);
  int* toke = (int*)(p.ws + OFF_TOKE); float* tokg = (float*)(p.ws + OFF_TOKG); int* tokp = (int*)(p.ws + OFF_TOKP);
  int* cnt = (int*)(p.ws + OFF_CNT);
  const int tid = threadIdx.x, lane = tid & 63, wid = tid >> 6;
  const int e = lane & 31, kh = lane >> 5;
  float* xs = (float*)smem;
  float* part = (float*)(smem + 65536);
  float wreg[64];
  {
    const int k0 = wid * 128 + kh * 64;
#pragma unroll
    for (int j = 0; j < 64; ++j) wreg[j] = p.router_w[(size_t)(k0 + j) * 32 + e] * p.norm2_w[k0 + j];
  }
  const float rb = p.router_b[e];
  float4 nw4[4];
#pragma unroll
  for (int i = 0; i < 4; ++i) nw4[i] = ((const float4*)p.norm2_w)[lane + 64 * i];
  for (int b0 = blockIdx.x * 16; b0 < T; b0 += gridDim.x * 16) {
    float4 va[4], vb[4];
    {
      const float4* hra = (const float4*)(h1 + (size_t)(b0 + wid * 2) * D);
      const float4* hrb = hra + D / 4;
#pragma unroll
      for (int i = 0; i < 4; ++i) { va[i] = hra[lane + 64 * i]; vb[i] = hrb[lane + 64 * i]; }
    }
    __syncthreads();
    float ssa = 0.f, ssb = 0.f;
#pragma unroll
    for (int i = 0; i < 4; ++i) {
      ssa += va[i].x * va[i].x + va[i].y * va[i].y + va[i].z * va[i].z + va[i].w * va[i].w;
      ssb += vb[i].x * vb[i].x + vb[i].y * vb[i].y + vb[i].z * vb[i].z + vb[i].w * vb[i].w;
    }
#pragma unroll
    for (int o = 32; o >= 1; o >>= 1) { ssa += __shfl_xor(ssa, o); ssb += __shfl_xor(ssb, o); }
    const float rsa = rsqrtf(ssa * (1.f / D) + 1e-6f), rsb = rsqrtf(ssb * (1.f / D) + 1e-6f);
#pragma unroll
    for (int i = 0; i < 4; ++i) {
      const float4 w = nw4[i];
      const float4 ya = make_float4(va[i].x * rsa, va[i].y * rsa, va[i].z * rsa, va[i].w * rsa);
      const float4 yb = make_float4(vb[i].x * rsb, vb[i].y * rsb, vb[i].z * rsb, vb[i].w * rsb);
      *(float4*)(xs + (wid * 2) * 1024 + (lane + 64 * i) * 4) = ya;
      *(float4*)(xs + (wid * 2 + 1) * 1024 + (lane + 64 * i) * 4) = yb;
      uint2 oa, ob; oa.x = pack2bf(ya.x * w.x, ya.y * w.y); oa.y = pack2bf(ya.z * w.z, ya.w * w.w);
      ob.x = pack2bf(yb.x * w.x, yb.y * w.y); ob.y = pack2bf(yb.z * w.z, yb.w * w.w);
      *(uint2*)(xn2 + (size_t)(b0 + wid * 2) * D + (lane + 64 * i) * 4) = oa;
      *(uint2*)(xn2 + (size_t)(b0 + wid * 2 + 1) * D + (lane + 64 * i) * 4) = ob;
    }
    __syncthreads();
    for (int tl = 0; tl < 16; ++tl) {
      const f32x4* xr = (const f32x4*)(xs + tl * 1024 + wid * 128 + kh * 64);
      float a0 = 0.f, a1 = 0.f, a2 = 0.f, a3 = 0.f;
#pragma unroll
      for (int j = 0; j < 16; ++j) {
        const f32x4 x4 = xr[j];
        a0 += x4[0] * wreg[4 * j]; a1 += x4[1] * wreg[4 * j + 1]; a2 += x4[2] * wreg[4 * j + 2]; a3 += x4[3] * wreg[4 * j + 3];
      }
      float a = (a0 + a1) + (a2 + a3);
      a += __shfl_xor(a, 32);
      if (lane < 32) part[(tl * 8 + wid) * 32 + e] = a;
    }
    __syncthreads();
    {
      const int tl = wid * 2 + kh, t = b0 + tl;
      float val = rb;
#pragma unroll
      for (int w = 0; w < 8; ++w) val += part[(tl * 8 + w) * 32 + e];
      float tv[4]; int te[4];
#pragma unroll
      for (int k = 0; k < 4; ++k) {
        float bv = val; int bi = e;
#pragma unroll
        for (int off = 16; off >= 1; off >>= 1) {
          float ov = __shfl_xor(bv, off); int oi = __shfl_xor(bi, off);
          if (ov > bv || (ov == bv && oi < bi)) { bv = ov; bi = oi; }
        }
        tv[k] = bv; te[k] = bi;
        if (e == bi) val = -INFINITY;
      }
      const float m = tv[0];
      float ex[4], s = 0.f;
#pragma unroll
      for (int k = 0; k < 4; ++k) { ex[k] = __expf(tv[k] - m); s += ex[k]; }
      if (e < 4) {
        const int ee = (e == 0) ? te[0] : (e == 1) ? te[1] : (e == 2) ? te[2] : te[3];
        const float gg = ((e == 0) ? ex[0] : (e == 1) ? ex[1] : (e == 2) ? ex[2] : ex[3]) / s;
        const int pos = atomicAdd(&cnt[ee], 1);
        toke[(size_t)t * 4 + e] = ee; tokg[(size_t)t * 4 + e] = gg; tokp[(size_t)t * 4 + e] = pos;
      }
    }
  }
}

__device__ __forceinline__ int expert_tstart(const int* cnt, int e) {
  int s = 0;
  for (int i = 0; i < e; ++i) s += (cnt[i] + 255) >> 8;
  return s;
}

__device__ __forceinline__ int* moe_tile_starts(const Params& p, char* smem) {
  int* ts = (int*)(smem + SM_TAIL + 64);
  const int* cnt = (const int*)(p.ws + OFF_CNT);
  __syncthreads();
  if (threadIdx.x <= NE) ts[threadIdx.x] = expert_tstart(cnt, threadIdx.x);
  __syncthreads();
  return ts;
}

__device__ void phase_fill_rows(const Params& p, char* smem) {
  const int* toke = (const int*)(p.ws + OFF_TOKE); const int* tokp = (const int*)(p.ws + OFF_TOKP);
  int* rowtok = (int*)(p.ws + OFF_ROWTOK);
  const int* ts = moe_tile_starts(p, smem);
  int gtid = blockIdx.x * NTHREADS + threadIdx.x, gsz = gridDim.x * NTHREADS;
  for (int i = gtid; i < T * 4; i += gsz) rowtok[ts[toke[i]] * 256 + tokp[i]] = i >> 2;
}

__device__ void phase_gemm_gu(const Params& p, char* smem) {
  const int* ts = moe_tile_starts(p, smem);
  g8::SchedMoE<8, true> S{(const char*)(p.ws + OFF_XN), (const char*)(p.ws + OFF_WGUT), 1024, ts, (int)gridDim.x, (int)blockIdx.x};
  g8::EpiGU E{(u16*)(p.ws + OFF_Z), p.exp_b_gu};
  g8::gemm_phase<g8::SchedMoE<8, true>, g8::EpiGU, true>((LAS unsigned char*)smem, 1024, S, E, (const int*)(p.ws + OFF_ROWTOK));
}

__device__ void phase_gemm_dn(const Params& p, char* smem) {
  const int* ts = moe_tile_starts(p, smem);
  g8::SchedMoE<4, false> S{(const char*)(p.ws + OFF_Z), (const char*)(p.ws + OFF_WDNT), 1024, ts, (int)gridDim.x, (int)blockIdx.x};
  g8::EpiDN E{(u16*)(p.ws + OFF_SV), p.exp_b_down};
  g8::gemm_phase<g8::SchedMoE<4, false>, g8::EpiDN, false>((LAS unsigned char*)smem, 1024, S, E, nullptr);
}

__device__ void phase_combine(const Params& p, char* smem) {
  const int* toke = (const int*)(p.ws + OFF_TOKE); const float* tokg = (const float*)(p.ws + OFF_TOKG); const int* tokp = (const int*)(p.ws + OFF_TOKP);
  const float* h1 = (const float*)(p.ws + OFF_H1); const u16* yb = (const u16*)(p.ws + OFF_SV);
  const int* ts = moe_tile_starts(p, smem);
  const int tid = threadIdx.x;
  const int sub = tid & 127, tl = tid >> 7;
  for (int t0 = blockIdx.x * 4; t0 < T; t0 += gridDim.x * 4) {
    const int t = t0 + tl;
    float4 a = *(const float4*)(h1 + (size_t)t * D + sub * 8), b = *(const float4*)(h1 + (size_t)t * D + sub * 8 + 4);
    float o[8] = {a.x, a.y, a.z, a.w, b.x, b.y, b.z, b.w};
#pragma unroll
    for (int k = 0; k < 4; ++k) {
      const int e = toke[t * 4 + k]; const float gte = tokg[t * 4 + k];
      const size_t row = (size_t)ts[e] * 256 + tokp[t * 4 + k];
      uint4 w = *(const uint4*)(yb + row * 1024 + sub * 8);
      u32 ww[4] = {w.x, w.y, w.z, w.w};
#pragma unroll
      for (int i = 0; i < 4; ++i) { o[2 * i] += gte * __uint_as_float(ww[i] << 16); o[2 * i + 1] += gte * __uint_as_float(ww[i] & 0xFFFF0000u); }
    }
    *(float4*)(p.out + (size_t)t * D + sub * 8) = make_float4(o[0], o[1], o[2], o[3]);
    *(float4*)(p.out + (size_t)t * D + sub * 8 + 4) = make_float4(o[4], o[5], o[6], o[7]);
  }
}

enum { PH_INIT = 0, PH_PREP, PH_GEMM_IN, PH_POST, PH_SCAN_A, PH_TOPK, PH_SCAN_B, PH_SCAN_C, PH_ATTN, PH_RWKV_OUT, PH_GEMM_OUT, PH_ROUTER, PH_FILL, PH_GEMM_GU, PH_GEMM_DN, PH_COMBINE, PH_COUNT };

template <int PH>
__device__ __forceinline__ void run_phase(const Params& p, char* smem) {
  if (PH == PH_INIT) { phase_init(p); phase_norm1(p); }
  if (PH == PH_PREP) {
    transpose_convert(p.w_in, (u16*)(p.ws + OFF_WINT), 1024, DIN, DINP, 1, smem, blockIdx.x, gridDim.x);
    transpose_convert(p.w_out, (u16*)(p.ws + OFF_WOUTT), 1024, 1024, 1024, 1, smem, blockIdx.x, gridDim.x);
  }
  if (PH == PH_GEMM_IN) phase_gemm_in(p, smem);
  if (PH == PH_POST) { phase_post_attn(p); phase_post_rwkv(p, smem); }
  if (PH == PH_SCAN_A) phase_scan_a(p, smem);
  if (PH == PH_TOPK) phase_topk(p, smem);
  if (PH == PH_SCAN_B) { }
  if (PH == PH_SCAN_C) phase_scan_c(p, smem);
  if (PH == PH_ATTN) phase_attn(p, smem);
  if (PH == PH_RWKV_OUT) phase_rwkv_out(p);
  if (PH == PH_GEMM_OUT) phase_gemm_out(p, smem);
  if (PH == PH_ROUTER) phase_router(p, smem);
  if (PH == PH_FILL) phase_fill_rows(p, smem);
  if (PH == PH_GEMM_GU) phase_gemm_gu(p, smem);
  if (PH == PH_GEMM_DN) phase_gemm_dn(p, smem);
  if (PH == PH_COMBINE) phase_combine(p, smem);
}

#ifndef FUSED
#define FUSED 1
#endif

template <int PH>
__global__ void __launch_bounds__(NTHREADS) phase_kernel(Params p) {
  extern __shared__ __attribute__((aligned(16))) char smem[];
  run_phase<PH>(p, smem);
}

__host__ __device__ constexpr bool barrier_after(int ph) { return !(ph == PH_INIT || ph == PH_SCAN_B || ph == PH_SCAN_C); }

template <int PH>
__device__ __forceinline__ void run_from(const Params& p, char* smem, cg::grid_group& grid, const XcdBarrier& xb) {
#ifdef REPEAT_PH
  if constexpr (PH == REPEAT_PH) { run_phase<PH>(p, smem); xcd_barrier(xb); }
#endif
  run_phase<PH>(p, smem);
  if constexpr (PH + 1 < PH_COUNT) {
    if constexpr (barrier_after(PH)) xcd_barrier(xb);
    else __syncthreads();
    run_from<PH + 1>(p, smem, grid, xb);
  }
}

__global__ void __launch_bounds__(NTHREADS) fwd_megakernel(Params p) {
  extern __shared__ __attribute__((aligned(16))) char smem[];
  uint4& xb_words = *(uint4*)(smem + SM_TAIL);
  cg::grid_group grid = cg::this_grid();
  if (threadIdx.x == 0) { xb_words = make_uint4(0u, 0u, 0u, 0u); g_prof = 0ull; }
  __syncthreads();
  XcdBarrier xb = xcd_barrier_post((unsigned*)(p.ws + OFF_BAR), (volatile LAS unsigned*)&xb_words);
  if (p.ws == nullptr) grid.sync();
  run_from<0>(p, smem, grid, xb);
  if (PROBE_ID != 0 && blockIdx.x == PROF_BLOCK && threadIdx.x == 0) {
    const unsigned long long t0 = __builtin_amdgcn_s_memrealtime(), w = g_prof * PROF_AMP;
    while (__builtin_amdgcn_s_memrealtime() - t0 < w) __builtin_amdgcn_s_sleep(8);
  }
}

template <int PH>
static void launch_phase(const Params& p, int grid, hipStream_t stream) {
  static bool attr_set = false;
  if (!attr_set) { (void)hipFuncSetAttribute((const void*)phase_kernel<PH>, hipFuncAttributeMaxDynamicSharedMemorySize, LDS_BYTES); attr_set = true; }
  hipLaunchKernelGGL(phase_kernel<PH>, dim3(grid), dim3(NTHREADS), LDS_BYTES, stream, p);
}

template <int PH>
static void launch_all(const Params& p, int grid, hipStream_t stream) {
  launch_phase<PH>(p, grid, stream);
  if constexpr (PH + 1 < PH_COUNT) launch_all<PH + 1>(p, grid, stream);
}

extern "C" void kernel_launch(void* const* d_in, const int* in_sizes, int n_in, void* d_out, int out_size, void* d_ws, size_t ws_size,
                              hipStream_t stream) {
  if (ws_size < WS_NEEDED) { fprintf(stderr, "workspace too small: %zu < %zu\n", ws_size, (size_t)WS_NEEDED); return; }
  Params p{};
  p.x = (const float*)d_in[0]; p.positions = (const int*)d_in[1]; p.norm1_w = (const float*)d_in[2]; p.w_in = (const float*)d_in[3];
  p.q_norm_w = (const float*)d_in[4]; p.k_norm_w = (const float*)d_in[5]; p.rwkv_mu = (const float*)d_in[6]; p.rwkv_w0 = (const float*)d_in[7];
  p.rwkv_w2 = (const float*)d_in[8]; p.rwkv_a0 = (const float*)d_in[9]; p.rwkv_a2 = (const float*)d_in[10]; p.rwkv_g2 = (const float*)d_in[11];
  p.rwkv_k_k = (const float*)d_in[12]; p.rwkv_k_a = (const float*)d_in[13]; p.rwkv_r_k = (const float*)d_in[14]; p.rwkv_ln_w = (const float*)d_in[15];
  p.rwkv_ln_b = (const float*)d_in[16]; p.w_out = (const float*)d_in[17]; p.norm2_w = (const float*)d_in[18]; p.router_w = (const float*)d_in[19];
  p.router_b = (const float*)d_in[20]; p.exp_w_gu = (const float*)d_in[21]; p.exp_b_gu = (const float*)d_in[22]; p.exp_w_down = (const float*)d_in[23];
  p.exp_b_down = (const float*)d_in[24];
  p.out = (float*)d_out; p.ws = (char*)d_ws;
#if FUSED
  static int grid_blocks = 0;
  if (!grid_blocks) {
    (void)hipFuncSetAttribute((const void*)fwd_megakernel, hipFuncAttributeMaxDynamicSharedMemorySize, LDS_BYTES);
    int dev = 0, cus = 0, per_cu = 0;
    (void)hipGetDevice(&dev);
    (void)hipDeviceGetAttribute(&cus, hipDeviceAttributeMultiprocessorCount, dev);
    (void)hipOccupancyMaxActiveBlocksPerMultiprocessor(&per_cu, fwd_megakernel, NTHREADS, LDS_BYTES);
    if (per_cu < 1) { fprintf(stderr, "occupancy query returned %d\n", per_cu); per_cu = 1; }
    grid_blocks = cus;
  }
  (void)hipMemsetAsync((char*)d_ws + OFF_BAR, 0, 16384, stream);
  void* args[] = {(void*)&p};
  hipError_t e = hipLaunchCooperativeKernel((void*)fwd_megakernel, dim3(grid_blocks), dim3(NTHREADS), args, LDS_BYTES, stream);
  if (e != hipSuccess) fprintf(stderr, "cooperative launch failed: %s (grid %d)\n", hipGetErrorString(e), grid_blocks);
#else
  launch_all<0>(p, 256, stream);
#endif
}
```

```cpp
#include <hip/hip_runtime.h>
#include <hip/hip_bf16.h>
#include <hip/hip_fp16.h>
#include <hip/hip_cooperative_groups.h>
#include <stdint.h>
#include <stdio.h>
namespace cg = cooperative_groups;

typedef unsigned short u16;
typedef unsigned int u32;
using bf16x8 = __attribute__((ext_vector_type(8))) short;
using f32x4 = __attribute__((ext_vector_type(4))) float;
using f32x16 = __attribute__((ext_vector_type(16))) float;

constexpr int T = 16384, D = 1024, DIN = 3496, DINP = 3584;
constexpr int NCH = 128, CHL = T / NCH;
constexpr int NE = 32, DFF = 1024;
constexpr int ROWCAP = 73728;
constexpr int C_Q = 0, C_K = 512, C_V = 1024, C_IQ = 1536, C_IK = 1792, C_IW = 1824, C_RW = 1832;
constexpr int NTHREADS = 512;
constexpr int LDS_BYTES = 159 * 1024;

constexpr size_t SZ_WGUT = (size_t)NE * 2048 * 1024 * 2;
constexpr size_t SZ_WDNT = (size_t)NE * 1024 * 1024 * 2;
constexpr size_t SZ_WINT = (size_t)DINP * 1024 * 2;
constexpr size_t SZ_WOUTT = (size_t)1024 * 1024 * 2;
constexpr size_t SZ_XN = (size_t)T * 1024 * 2;
constexpr size_t SZ_Z = (size_t)T * DINP * 4;
constexpr size_t SZ_QKV = (size_t)T * 512 * 2;
constexpr size_t SZ_IQ = (size_t)T * 256 * 2;
constexpr size_t SZ_IK = (size_t)T * 32 * 2;
constexpr size_t SZ_IW = (size_t)T * 8 * 4;
constexpr size_t SZ_SV = (size_t)T * 8 * 384 * 4;
constexpr size_t SZ_G = (size_t)T * 512 * 4;
constexpr size_t SZ_BONUS = (size_t)T * 8 * 4;
constexpr size_t SZ_Y = (size_t)T * 512 * 4;
constexpr size_t SZ_SMAT = (size_t)8 * NCH * 4096 * 4;
constexpr size_t SZ_SEL = (size_t)T * 256 * 2;
constexpr size_t SZ_MIX = (size_t)T * 1024 * 2;
constexpr size_t SZ_H1 = (size_t)T * 1024 * 4;
constexpr size_t SZ_TOK = (size_t)T * 4 * 4;
constexpr size_t SZ_ROWTOK = (size_t)ROWCAP * 4;

constexpr size_t OFF_WGUT = 0;
constexpr size_t OFF_WDNT = OFF_WGUT + SZ_WGUT;
constexpr size_t OFF_WINT = OFF_WDNT + SZ_WDNT;
constexpr size_t OFF_WOUTT = OFF_WINT + SZ_WINT;
constexpr size_t OFF_XN = OFF_WOUTT + SZ_WOUTT;
constexpr size_t OFF_Z = OFF_XN + SZ_XN;
constexpr size_t OFF_QR = OFF_Z + SZ_Z;
constexpr size_t OFF_KR = OFF_QR + SZ_QKV;
constexpr size_t OFF_VV = OFF_KR + SZ_QKV;
constexpr size_t OFF_IQ = OFF_VV + SZ_QKV;
constexpr size_t OFF_IK = OFF_IQ + SZ_IQ;
constexpr size_t OFF_IW = OFF_IK + SZ_IK;
constexpr size_t OFF_SV = OFF_IW + SZ_IW;
constexpr size_t OFF_G = OFF_SV + SZ_SV;
constexpr size_t OFF_BONUS = OFF_G + SZ_G;
constexpr size_t OFF_Y = OFF_BONUS + SZ_BONUS;
constexpr size_t OFF_SP = OFF_Y + SZ_Y;
constexpr size_t OFF_SL = OFF_SP + SZ_SMAT;
constexpr size_t OFF_SI = OFF_SL + SZ_SMAT;
constexpr size_t OFF_SEL = OFF_SI + SZ_SMAT;
constexpr size_t OFF_MIX = OFF_SEL + SZ_SEL;
constexpr size_t OFF_H1 = OFF_MIX + SZ_MIX;
constexpr size_t OFF_TOKE = OFF_H1 + SZ_H1;
constexpr size_t OFF_TOKG = OFF_TOKE + SZ_TOK;
constexpr size_t OFF_TOKP = OFF_TOKG + SZ_TOK;
constexpr size_t OFF_ROWTOK = OFF_TOKP + SZ_TOK;
constexpr size_t OFF_CNT = OFF_ROWTOK + SZ_ROWTOK;
constexpr size_t OFF_QSH = OFF_CNT + 4096;
constexpr size_t OFF_BAR = OFF_QSH + (size_t)T * 8 * 4;
constexpr size_t WS_NEEDED = OFF_BAR + 16384;

struct Params {
  const float* x; const int* positions; const float* norm1_w; const float* w_in;
  const float* q_norm_w; const float* k_norm_w; const float* rwkv_mu; const float* rwkv_w0;
  const float* rwkv_w2; const float* rwkv_a0; const float* rwkv_a2; const float* rwkv_g2;
  const float* rwkv_k_k; const float* rwkv_k_a; const float* rwkv_r_k; const float* rwkv_ln_w;
  const float* rwkv_ln_b; const float* w_out; const float* norm2_w; const float* router_w;
  const float* router_b; const float* exp_w_gu; const float* exp_b_gu; const float* exp_w_down;
  const float* exp_b_down;
  float* out;
  char* ws;
};

__device__ __forceinline__ u16 f2bf(float f) {
  u32 u = __float_as_uint(f);
  u += 0x7FFFu + ((u >> 16) & 1u);
  return (u16)(u >> 16);
}
__device__ __forceinline__ float bf2f(u16 h) { return __uint_as_float(((u32)h) << 16); }
__device__ __forceinline__ u32 pack2bf(float a, float b) { return (u32)f2bf(a) | ((u32)f2bf(b) << 16); }
__device__ __forceinline__ float wave_sum(float v) {
#pragma unroll
  for (int o = 32; o >= 1; o >>= 1) v += __shfl_xor(v, o);
  return v;
}
__device__ __forceinline__ float sigmoidf_(float x) { return 1.f / (1.f + __expf(-x)); }

__device__ __forceinline__ void sincos_big(float ang, float& s, float& c) {
  double a = (double)ang * 0.15915494309189535;
  double r = a - rint(a);
  float rf = (float)r;
  s = __builtin_amdgcn_sinf(rf);
  c = __builtin_amdgcn_cosf(rf);
}


#define XB_TMO      128
#define XB_XCNT(j)  (256  + 64 * (j))
#define XB_XSUB(j)  (1280 + 64 * (j))
#define XB_XGEN(j)  (2304 + 64 * (j))
#define XB_TOP      3328
#define XB_TOPGEN   3392
#define XCD_BAR_WORDS 3456
#define XB_SPIN_CAP (1u << 22)
#define LAS __attribute__((address_space(3)))
__device__ __forceinline__ unsigned xb_ld(unsigned* p)              { return __hip_atomic_load(p, __ATOMIC_RELAXED, __HIP_MEMORY_SCOPE_AGENT); }
__device__ __forceinline__ unsigned xb_add(unsigned* p, unsigned v) { return __hip_atomic_fetch_add(p, v, __ATOMIC_RELAXED, __HIP_MEMORY_SCOPE_AGENT); }
__device__ __forceinline__ unsigned xb_xcc_id() { return (unsigned)__builtin_amdgcn_s_getreg((3 << 11) | 20) & 0xFu; }
#define XB_SPIN(cond, bar) do { unsigned _sp = 0; while (cond) { __builtin_amdgcn_s_sleep(1); \
    if ((++_sp & 255u) == 0u) { if (xb_ld(&(bar)[XB_TMO])) break; if (_sp > XB_SPIN_CAP) { atomicAdd(&(bar)[XB_TMO], 1u); break; } } } } while (0)
struct XcdBarrier { unsigned* bar; unsigned x; volatile LAS unsigned* st; };
__device__ __forceinline__ XcdBarrier xcd_barrier_post(unsigned* bar, volatile LAS unsigned* st) {
  XcdBarrier b; b.bar = bar; b.x = xb_xcc_id(); b.st = st;
  if (threadIdx.x == 0) (void)xb_add(&bar[XB_XCNT(b.x)], 1u);
  return b;
}
__device__ __forceinline__ void xcd_barrier_complete(unsigned* bar, unsigned x, unsigned& nloc, unsigned& nx) {
  const unsigned G = gridDim.x * gridDim.y * gridDim.z;
  unsigned sum, cnt, mine, sp = 0u;
  for (;;) {
    sum = 0u; cnt = 0u; mine = 0u;
#pragma unroll
    for (unsigned j = 0; j < 16; ++j) { const unsigned c = xb_ld(&bar[XB_XCNT(j)]); sum += c; cnt += (c > 0u) ? 1u : 0u; mine = (j == x) ? c : mine; }
    if (sum == G) break;
    __builtin_amdgcn_s_sleep(1);
    if ((++sp & 255u) == 0u) { if (xb_ld(&bar[XB_TMO])) break; if (sp > XB_SPIN_CAP) { atomicAdd(&bar[XB_TMO], 1u); break; } }
  }
  nloc = mine > 0u ? mine : 1u; nx = cnt > 0u ? cnt : 1u;
}
__device__ __forceinline__ void xcd_barrier(const XcdBarrier& b) {
  asm volatile("s_waitcnt vmcnt(0)" ::: "memory");
  __syncthreads();
  if (threadIdx.x == 0) {
    unsigned* bar = b.bar;
    __builtin_amdgcn_s_waitcnt(0);
    unsigned nloc = b.st[0], nx = b.st[1];
    if (nloc == 0u) { xcd_barrier_complete(bar, b.x, nloc, nx); b.st[0] = nloc; b.st[1] = nx; }
    const unsigned old = xb_add(&bar[XB_XSUB(b.x)], 1u);
    const unsigned gen = old / nloc;
    if (old + 1u == (gen + 1u) * nloc) {
      __builtin_amdgcn_fence(__ATOMIC_RELEASE, "agent");
      asm volatile("s_waitcnt vmcnt(0)" ::: "memory");
      const unsigned og = xb_add(&bar[XB_TOP], 1u);
      const unsigned tg = og / nx;
      if (og + 1u == (tg + 1u) * nx) xb_add(&bar[XB_TOPGEN], 1u);
      else XB_SPIN(xb_ld(&bar[XB_TOPGEN]) == tg, bar);
      __builtin_amdgcn_fence(__ATOMIC_ACQUIRE, "agent");
      xb_add(&bar[XB_XGEN(b.x)], 1u);
      asm volatile("s_waitcnt vmcnt(0)" ::: "memory");
    } else {
      XB_SPIN(xb_ld(&bar[XB_XGEN(b.x)]) == gen, bar);
      __builtin_amdgcn_fence(__ATOMIC_ACQUIRE, "agent");
      asm volatile("s_waitcnt vmcnt(0)" ::: "memory");
    }
  }
  __syncthreads();
}


#ifndef PROBE_ID
#define PROBE_ID 0
#endif
#define PROF_BLOCK 100
#define PROF_AMP 4
#define g_prof (*(unsigned long long*)(smem + 157 * 1024 + 16))
#define PROF_T0(id) unsigned long long _pt0_##id = 0; if (PROBE_ID == (id) && blockIdx.x == PROF_BLOCK && threadIdx.x == 0) _pt0_##id = __builtin_amdgcn_s_memrealtime();
#define PROF_T1(id) if (PROBE_ID == (id) && blockIdx.x == PROF_BLOCK && threadIdx.x == 0) g_prof += __builtin_amdgcn_s_memrealtime() - _pt0_##id;

__device__ void phase_init(const Params& p) {
  int* cnt = (int*)(p.ws + OFF_CNT);
  int* rowtok = (int*)(p.ws + OFF_ROWTOK);
  int gtid = blockIdx.x * NTHREADS + threadIdx.x;
  int gsz = gridDim.x * NTHREADS;
  if (gtid < 64) cnt[gtid] = 0;
  for (int i = gtid; i < ROWCAP; i += gsz) rowtok[i] = -1;
}

__device__ void transpose_convert(const float* src, u16* dst, int R, int C, int Cpad, int nbatch, char* smem, int bid, int nblk) {
  float* tile = (float*)smem;
  int tr = R / 64, tc = Cpad / 64;
  int ntile = tr * tc * nbatch;
  int tid = threadIdx.x;
  for (int id = bid; id < ntile; id += nblk) {
    int b = id / (tr * tc), rem = id % (tr * tc);
    int r0 = (rem / tc) * 64, c0 = (rem % tc) * 64;
    const float* s = src + (size_t)b * R * C;
    u16* d = dst + (size_t)b * Cpad * R;
#pragma unroll
    for (int i = 0; i < 8; ++i) {
      int r = (tid >> 6) + 8 * i, c = tid & 63;
      float v = (c0 + c < C) ? s[(size_t)(r0 + r) * C + c0 + c] : 0.f;
      tile[r * 65 + c] = v;
    }
    __syncthreads();
    {
      int cc = tid >> 3, rg = tid & 7;
      u32 w[4];
#pragma unroll
      for (int i = 0; i < 4; ++i) w[i] = pack2bf(tile[(rg * 8 + 2 * i) * 65 + cc], tile[(rg * 8 + 2 * i + 1) * 65 + cc]);
      uint4 o; o.x = w[0]; o.y = w[1]; o.z = w[2]; o.w = w[3];
      *(uint4*)(d + (size_t)(c0 + cc) * R + r0 + rg * 8) = o;
    }
    __syncthreads();
  }
}

__device__ void phase_norm1(const Params& p) {
  u16* xn = (u16*)(p.ws + OFF_XN);
  int lane = threadIdx.x & 63, wid = threadIdx.x >> 6;
  int gw = blockIdx.x * 8 + wid, nw = gridDim.x * 8;
  for (int t = gw; t < T; t += nw) {
    const float4* xr = (const float4*)(p.x + (size_t)t * D);
    float4 v[4]; float ss = 0.f;
#pragma unroll
    for (int i = 0; i < 4; ++i) { v[i] = xr[lane + 64 * i]; ss += v[i].x * v[i].x + v[i].y * v[i].y + v[i].z * v[i].z + v[i].w * v[i].w; }
    ss = wave_sum(ss);
    float rstd = rsqrtf(ss * (1.f / D) + 1e-6f);
#pragma unroll
    for (int i = 0; i < 4; ++i) {
      float4 w = ((const float4*)p.norm1_w)[lane + 64 * i];
      uint2 o; o.x = pack2bf(v[i].x * rstd * w.x, v[i].y * rstd * w.y); o.y = pack2bf(v[i].z * rstd * w.z, v[i].w * rstd * w.w);
      *(uint2*)(xn + (size_t)t * D + (lane + 64 * i) * 4) = o;
    }
  }
}

namespace g8 {
constexpr int BM = 256, BK = 64, HALF = 128, HTB = HALF * BK * 2, STAGE_BYTES = 8 * HTB;
__device__ __forceinline__ int lds_byte(int r, int c) { const int st = (r >> 4) * 2 + (c >> 5), rr = r & 15, cc = c & 31, ob = rr * 64 + cc * 2; return st * 1024 + (ob ^ (((ob >> 9) & 1) << 5)); }
__device__ __forceinline__ void stage_rc(int b, int& R, int& C) { const int st = b / 1024, sb = b % 1024, swz = sb ^ (((sb >> 9) & 1) << 5); R = (st >> 1) * 16 + swz / 64; C = (st & 1) * 32 + (swz % 64) / 2; }

struct Unit {
  const char* A;
  const char* B;
  unsigned hstepB;
  int row0;
  int col0;
  int aux;
};

template <class Sched, class Epi, bool GATHER>
__device__ __forceinline__ void gemm_phase(LAS unsigned char* lds, const int K, const Sched& S, const Epi& E, const int* __restrict__ rowtok) {
  const int tid = threadIdx.x, wid = __builtin_amdgcn_readfirstlane(tid >> 6), lane = tid & 63, wr = wid >> 2, wc = wid & 3, fr = lane & 15, fq = lane >> 4;
  const int nt = K / BK;
  int R0, C0, R1, C1;
  stage_rc(tid * 16, R0, C0); stage_rc(tid * 16 + 8192, R1, C1);
  const unsigned voffB0 = (unsigned)(R0 * K + C0) * 2u, voffB1 = (unsigned)(R1 * K + C1) * 2u;
  unsigned ac00, ac01, ac10, ac11, an00, an01, an10, an11;
#define G8_AOFF(u, o00, o01, o10, o11) do { \
    if (GATHER) { int t00 = rowtok[(u).row0 + R0], t01 = rowtok[(u).row0 + R1], t10 = rowtok[(u).row0 + HALF + R0], t11 = rowtok[(u).row0 + HALF + R1]; \
      t00 = t00 < 0 ? 0 : t00; t01 = t01 < 0 ? 0 : t01; t10 = t10 < 0 ? 0 : t10; t11 = t11 < 0 ? 0 : t11; \
      o00 = (unsigned)(t00 * K + C0) * 2u; o01 = (unsigned)(t01 * K + C1) * 2u; o10 = (unsigned)(t10 * K + C0) * 2u; o11 = (unsigned)(t11 * K + C1) * 2u; } \
    else { o00 = (unsigned)(R0 * K + C0) * 2u; o01 = (unsigned)(R1 * K + C1) * 2u; o10 = (unsigned)((HALF + R0) * K + C0) * 2u; o11 = (unsigned)((HALF + R1) * K + C1) * 2u; } } while (0)
  const size_t kstep = (size_t)(BK * 2);
  const unsigned ldsw = (unsigned)wid * 1024u;
  const int aoff = lds_byte(wr * 64 + fr, fq * 8), boff = lds_byte(wc * 32 + fr, fq * 8);
#define G8_SA(b, h) (((b) * 2 + (h)) * HTB)
#define G8_SB(b, h) ((4 + (b) * 2 + (h)) * HTB)
#define G8_STAGE(bufoff, gbase, v0, v1) do { \
    __builtin_amdgcn_global_load_lds((const unsigned*)((const char*)(gbase) + (v0)), (LAS unsigned*)(lds + (bufoff) + ldsw), 16, 0, 0); \
    __builtin_amdgcn_global_load_lds((const unsigned*)((const char*)(gbase) + (v1)), (LAS unsigned*)(lds + (bufoff) + ldsw + 8192), 16, 0, 0); } while (0)
#define G8_LDA(dst, b, h) do { _Pragma("unroll") for (int m = 0; m < 4; ++m) _Pragma("unroll") for (int k = 0; k < 2; ++k) dst[m][k] = *(const LAS bf16x8*)(lds + G8_SA(b, h) + aoff + m * 2048 + k * 1024); } while (0)
#define G8_LDB(dst, b, h) do { _Pragma("unroll") for (int n = 0; n < 2; ++n) _Pragma("unroll") for (int k = 0; k < 2; ++k) dst[n][k] = *(const LAS bf16x8*)(lds + G8_SB(b, h) + boff + n * 2048 + k * 1024); } while (0)
#define G8_MMA(ai, bj, At_, Bt_) do { __builtin_amdgcn_s_setprio(1); _Pragma("unroll") for (int m = 0; m < 4; ++m) _Pragma("unroll") for (int n = 0; n < 2; ++n) _Pragma("unroll") for (int k = 0; k < 2; ++k) \
    acc[ai][bj][m][n] = __builtin_amdgcn_mfma_f32_16x16x32_bf16(Bt_[n][k], At_[m][k], acc[ai][bj][m][n], 0, 0, 0); __builtin_amdgcn_s_setprio(0); } while (0)
#define G8_WAIT_V(n) asm volatile("s_waitcnt vmcnt(" #n ")" ::: "memory")
#define G8_WAIT_L(n) asm volatile("s_waitcnt lgkmcnt(" #n ")" ::: "memory")
#define G8_BAR __builtin_amdgcn_s_barrier()
#define G8_SCHED __builtin_amdgcn_sched_barrier(0)
  Unit cur, nxt; int ui = 0;
  if (!S.next(0, cur)) return;
  f32x4 acc[2][2][4][2];
#pragma unroll
  for (int a = 0; a < 2; ++a)
#pragma unroll
    for (int b = 0; b < 2; ++b)
#pragma unroll
      for (int m = 0; m < 4; ++m)
#pragma unroll
        for (int n = 0; n < 2; ++n) acc[a][b][m][n] = (f32x4){0.f, 0.f, 0.f, 0.f};
  bf16x8 At[4][2], B0[2][2], B1[2][2];
  const char* cA = cur.A; const char* cB = cur.B; unsigned chB = cur.hstepB;
  G8_AOFF(cur, ac00, ac01, ac10, ac11);
  an00 = ac00; an01 = ac01; an10 = ac10; an11 = ac11;
  G8_STAGE(G8_SB(0, 0), cB, voffB0, voffB1); G8_STAGE(G8_SA(0, 0), cA, ac00, ac01); G8_STAGE(G8_SB(0, 1), cB + chB, voffB0, voffB1); G8_STAGE(G8_SA(0, 1), cA, ac10, ac11);
  if (wr == 1) G8_BAR;
  G8_WAIT_V(4); G8_BAR;
  G8_STAGE(G8_SB(1, 0), cB + kstep, voffB0, voffB1); G8_STAGE(G8_SA(1, 0), cA + kstep, ac00, ac01); G8_STAGE(G8_SB(1, 1), cB + chB + kstep, voffB0, voffB1);
  G8_WAIT_V(6); G8_BAR;
  for (;;) {
    const bool has_next = S.next(ui + 1, nxt);
    const char* nA = has_next ? nxt.A : cA; const char* nB = has_next ? nxt.B : cB; const unsigned nhB = has_next ? nxt.hstepB : chB;
    if (GATHER) { if (has_next) G8_AOFF(nxt, an00, an01, an10, an11); else { an00 = ac00; an01 = ac01; an10 = ac10; an11 = ac11; } }
    for (int t = 0; t < nt; t += 2) {
      const bool last = (t == nt - 2);
      const char* a1 = cA + (size_t)(t + 1) * kstep;
      const char* a2 = last ? nA : cA + (size_t)(t + 2) * kstep; const char* b2 = last ? nB : cB + (size_t)(t + 2) * kstep;
      const char* a3 = a2 + kstep; const char* b3 = b2 + kstep;
      const unsigned hb2 = last ? nhB : chB;
      const unsigned x00 = last ? an00 : ac00, x01 = last ? an01 : ac01, x10 = last ? an10 : ac10, x11 = last ? an11 : ac11;
      G8_LDB(B0, 0, 0); G8_SCHED; G8_LDA(At, 0, 0); G8_STAGE(G8_SA(1, 1), a1, ac10, ac11);
      G8_WAIT_L(8); G8_BAR; G8_WAIT_L(0); G8_MMA(0, 0, At, B0); G8_BAR; G8_SCHED;
      G8_LDB(B1, 0, 1); G8_STAGE(G8_SB(0, 0), b2, voffB0, voffB1);
      G8_BAR; G8_WAIT_L(0); G8_MMA(0, 1, At, B1); G8_BAR;
      G8_LDA(At, 0, 1); G8_STAGE(G8_SA(0, 0), a2, x00, x01);
      G8_BAR; G8_WAIT_L(0); G8_MMA(1, 0, At, B0); G8_BAR; G8_SCHED;
      G8_STAGE(G8_SB(0, 1), b2 + hb2, voffB0, voffB1);
      G8_WAIT_V(6); G8_BAR; G8_MMA(1, 1, At, B1); G8_BAR;
      G8_LDB(B0, 1, 0); G8_SCHED; G8_LDA(At, 1, 0); G8_STAGE(G8_SA(0, 1), a2, x10, x11);
      G8_WAIT_L(8); G8_BAR; G8_WAIT_L(0); G8_MMA(0, 0, At, B0); G8_BAR; G8_SCHED;
      G8_LDB(B1, 1, 1); G8_STAGE(G8_SB(1, 0), b3, voffB0, voffB1);
      G8_BAR; G8_WAIT_L(0); G8_MMA(0, 1, At, B1); G8_BAR;
      G8_LDA(At, 1, 1); G8_STAGE(G8_SA(1, 0), a3, x00, x01);
      G8_BAR; G8_WAIT_L(0); G8_MMA(1, 0, At, B0); G8_BAR; G8_SCHED;
      G8_STAGE(G8_SB(1, 1), b3 + hb2, voffB0, voffB1);
      G8_WAIT_V(6); G8_BAR; G8_MMA(1, 1, At, B1); G8_BAR;
    }
    E(acc, cur, wr, wc, fr, fq);
    if (!has_next) break;
#pragma unroll
    for (int a = 0; a < 2; ++a)
#pragma unroll
      for (int b = 0; b < 2; ++b)
#pragma unroll
        for (int m = 0; m < 4; ++m)
#pragma unroll
          for (int n = 0; n < 2; ++n) acc[a][b][m][n] = (f32x4){0.f, 0.f, 0.f, 0.f};
    cur = nxt; cA = nA; cB = nB; chB = nhB; ++ui;
    ac00 = an00; ac01 = an01; ac10 = an10; ac11 = an11;
  }
  G8_WAIT_V(0);
  if (wr == 0) G8_BAR;
  G8_BAR;
#undef G8_AOFF
#undef G8_SA
#undef G8_SB
#undef G8_STAGE
#undef G8_LDA
#undef G8_LDB
#undef G8_MMA
#undef G8_WAIT_V
#undef G8_WAIT_L
#undef G8_BAR
#undef G8_SCHED
}

struct SchedDense {
  const char* A; const char* Bt; int K, nM, nN, nwg, G, c;
  __device__ __forceinline__ bool next(int i, Unit& u) const {
    const int L = i * G + c; if (L >= nwg) return false;
    int wgid = L; { const int q = nwg / 8, r = nwg % 8, xcd = wgid % 8, off = wgid / 8; wgid = (xcd < r ? xcd * (q + 1) : r * (q + 1) + (xcd - r) * q) + off; }
    const int nig = 8 * nN, gid = wgid / nig, fm = gid * 8, gsz = (nM - fm) < 8 ? (nM - fm) : 8;
    const int pm = fm + ((wgid % nig) % gsz), pn = (wgid % nig) / gsz;
    u.A = A + (size_t)pm * BM * K * 2; u.B = Bt + (size_t)pn * BM * K * 2; u.hstepB = (unsigned)(HALF * K * 2);
    u.row0 = pm * BM; u.col0 = pn * BM; u.aux = 0; return true;
  }
};
template <int NCOLT, bool GU>
struct SchedMoE {
  const char* A; const char* W; int K; const int* ts; int G, c;
  __device__ __forceinline__ bool next(int i, Unit& u) const {
    const int id = i * G + c; const int ntiles = ts[NE];
    if (id >= ntiles * NCOLT) return false;
    const int tile = id / NCOLT, pn = id % NCOLT;
    int e = 0;
    while (e < NE - 1 && ts[e + 1] <= tile) ++e;
    u.row0 = tile * BM; u.aux = e;
    if (GU) { u.A = A; u.B = W + ((size_t)e * 2048 + pn * 128) * K * 2; u.hstepB = (unsigned)(1024 * K * 2); u.col0 = pn * 128; }
    else { u.A = A + (size_t)tile * BM * K * 2; u.B = W + ((size_t)e * 1024 + pn * 256) * K * 2; u.hstepB = (unsigned)(HALF * K * 2); u.col0 = pn * 256; }
    return true;
  }
};

struct EpiF32 {
  float* C; const float* resid; int ldc;
  __device__ __forceinline__ void operator()(const f32x4 (&acc)[2][2][4][2], const Unit& u, int wr, int wc, int fr, int fq) const {
    const int row0 = u.row0 + wr * 64 + fr, col0 = u.col0 + wc * 32 + 4 * fq;
#pragma unroll
    for (int ai = 0; ai < 2; ++ai)
#pragma unroll
      for (int m = 0; m < 4; ++m) {
        const size_t ro = (size_t)(row0 + ai * HALF + m * 16) * ldc + col0;
#pragma unroll
        for (int bj = 0; bj < 2; ++bj)
#pragma unroll
          for (int n = 0; n < 2; ++n) {
            f32x4 v = acc[ai][bj][m][n];
            if (resid) v += *(const f32x4*)(resid + ro + bj * HALF + n * 16);
            *(f32x4*)(C + ro + bj * HALF + n * 16) = v;
          }
      }
  }
};
struct EpiGU {
  u16* O; const float* bias_all;
  __device__ __forceinline__ void operator()(const f32x4 (&acc)[2][2][4][2], const Unit& u, int wr, int wc, int fr, int fq) const {
    const float* bias = bias_all + (size_t)u.aux * 2048;
    const int row0 = u.row0 + wr * 64 + fr, col0 = u.col0 + wc * 32 + 4 * fq;
    f32x4 bg[2], bl[2];
#pragma unroll
    for (int n = 0; n < 2; ++n) { bg[n] = *(const f32x4*)(bias + col0 + n * 16); bl[n] = *(const f32x4*)(bias + 1024 + col0 + n * 16); }
#pragma unroll
    for (int ai = 0; ai < 2; ++ai)
#pragma unroll
      for (int m = 0; m < 4; ++m) {
        u16* rowp = O + (size_t)(row0 + ai * HALF + m * 16) * 1024 + col0;
#pragma unroll
        for (int n = 0; n < 2; ++n) {
          const f32x4 g4 = acc[ai][0][m][n] + bg[n], l4 = acc[ai][1][m][n] + bl[n];
          float a[4];
#pragma unroll
          for (int j = 0; j < 4; ++j) {
            const float glu = fminf(g4[j], 7.f), lin = fminf(fmaxf(l4[j], -7.f), 7.f);
            a[j] = (lin + 1.f) * glu * (1.f / (1.f + __expf(-1.702f * glu)));
          }
          uint2 w; w.x = pack2bf(a[0], a[1]); w.y = pack2bf(a[2], a[3]);
          *(uint2*)(rowp + n * 16) = w;
        }
      }
  }
};
struct EpiDN {
  u16* O; const float* bias_all;
  __device__ __forceinline__ void operator()(const f32x4 (&acc)[2][2][4][2], const Unit& u, int wr, int wc, int fr, int fq) const {
    const float* bias = bias_all + (size_t)u.aux * 1024;
    const int row0 = u.row0 + wr * 64 + fr, col0 = u.col0 + wc * 32 + 4 * fq;
    f32x4 bv[2][2];
#pragma unroll
    for (int bj = 0; bj < 2; ++bj)
#pragma unroll
      for (int n = 0; n < 2; ++n) bv[bj][n] = *(const f32x4*)(bias + col0 + bj * HALF + n * 16);
#pragma unroll
    for (int ai = 0; ai < 2; ++ai)
#pragma unroll
      for (int m = 0; m < 4; ++m) {
        u16* rowp = O + (size_t)(row0 + ai * HALF + m * 16) * 1024 + col0;
#pragma unroll
        for (int bj = 0; bj < 2; ++bj)
#pragma unroll
          for (int n = 0; n < 2; ++n) {
            const f32x4 v = acc[ai][bj][m][n] + bv[bj][n];
            uint2 w; w.x = pack2bf(v[0], v[1]); w.y = pack2bf(v[2], v[3]);
            *(uint2*)(rowp + bj * HALF + n * 16) = w;
          }
      }
  }
};
}

constexpr int SM_TAIL = 157 * 1024;
__device__ void phase_gemm_in(const Params& p, char* smem) {
  g8::SchedDense S{(const char*)(p.ws + OFF_XN), (const char*)(p.ws + OFF_WINT), D, T / 256, DINP / 256, (T / 256) * (DINP / 256), (int)gridDim.x, (int)blockIdx.x};
  g8::EpiF32 E{(float*)(p.ws + OFF_Z), nullptr, DINP};
  g8::gemm_phase<g8::SchedDense, g8::EpiF32, false>((LAS unsigned char*)smem, D, S, E, nullptr);
}

__device__ void phase_post_attn(const Params& p) {
  const float* z = (const float*)(p.ws + OFF_Z);
  u16* qr = (u16*)(p.ws + OFF_QR); u16* kr = (u16*)(p.ws + OFF_KR); u16* vv = (u16*)(p.ws + OFF_VV);
  u16* iq = (u16*)(p.ws + OFF_IQ); u16* ik = (u16*)(p.ws + OFF_IK); float* iw = (float*)(p.ws + OFF_IW);
  const float INVF8[8] = {1.0f, 0.1939227432012558f, 0.03760603070259094f, 0.007292664609849453f,
                          0.0014142135623842478f, 0.00027424818836152554f, 5.318296098266728e-05f, 1.0313386155758053e-05f};
  const float INVF4[4] = {1.0f, 0.03760603070259094f, 0.0014142135623842478f, 5.318296098266728e-05f};
  int lane = threadIdx.x & 63, wid = threadIdx.x >> 6;
  int gw = blockIdx.x * 8 + wid, nw = gridDim.x * 8;
  const int sub = lane & 7;
  float* qsh = (float*)(p.ws + OFF_QSH);
  float kwmax = fabsf(p.k_norm_w[lane]);
#pragma unroll
  for (int o = 32; o >= 1; o >>= 1) kwmax = fmaxf(kwmax, __shfl_xor(kwmax, o));
  for (int t = gw; t < T; t += nw) {
    const float* zr = z + (size_t)t * DINP;
    const float pos = (float)p.positions[t];
    float cs8[8], sn8[8];
#pragma unroll
    for (int i = 0; i < 8; ++i) sincos_big(pos * INVF8[i], sn8[i], cs8[i]);
#pragma unroll
    for (int which = 0; which < 2; ++which) {
      const float* src = zr + (which ? C_K : C_Q) + lane * 8;
      const float* nw_ = (which ? p.k_norm_w : p.q_norm_w) + sub * 8;
      float4 a = *(const float4*)src, b = *(const float4*)(src + 4);
      float v[8] = {a.x, a.y, a.z, a.w, b.x, b.y, b.z, b.w};
      float ss = 0.f;
#pragma unroll
      for (int i = 0; i < 8; ++i) ss += v[i] * v[i];
      ss += __shfl_xor(ss, 1); ss += __shfl_xor(ss, 2); ss += __shfl_xor(ss, 4);
      float rstd = rsqrtf(ss * (1.f / 64.f) + 1e-6f);
      float y[8], o[8];
#pragma unroll
      for (int i = 0; i < 8; ++i) y[i] = v[i] * rstd * nw_[i];
#pragma unroll
      for (int i = 0; i < 8; ++i) {
        float oth = __shfl_xor(y[i], 1);
        float r0 = y[i] * cs8[i] - oth * sn8[i];
        float r1 = y[i] * cs8[i] + oth * sn8[i];
        o[i] = (sub == 0) ? r0 : ((sub == 1) ? r1 : y[i]);
      }
      const float sc = which ? 1.f : (0.125f * 1.4426950408889634f);
      u32 hw[4]; float n2 = 0.f;
#pragma unroll
      for (int i = 0; i < 4; ++i) {
        __half h0 = __float2half_rn(o[2 * i] * sc), h1 = __float2half_rn(o[2 * i + 1] * sc);
        float f0 = __half2float(h0), f1 = __half2float(h1);
        n2 += f0 * f0 + f1 * f1;
        hw[i] = (u32)__half_as_ushort(h0) | ((u32)__half_as_ushort(h1) << 16);
      }
      uint4 w; w.x = hw[0]; w.y = hw[1]; w.z = hw[2]; w.w = hw[3];
      const int hd = lane >> 3;
      *(uint4*)((which ? kr : qr) + ((size_t)hd * T + t) * 64 + sub * 8) = w;
      if (which == 0) {
        n2 += __shfl_xor(n2, 1); n2 += __shfl_xor(n2, 2); n2 += __shfl_xor(n2, 4);
        if (sub == 0) qsh[(size_t)hd * T + t] = sqrtf(n2) * 8.f * kwmax * 1.01f;
      }
    }
    {
      const float* src = zr + C_V + lane * 8;
      float4 a = *(const float4*)src, b = *(const float4*)(src + 4);
      float v[8] = {a.x, a.y, a.z, a.w, b.x, b.y, b.z, b.w};
      u32 hw[4];
#pragma unroll
      for (int i = 0; i < 4; ++i) hw[i] = (u32)__half_as_ushort(__float2half_rn(v[2 * i])) | ((u32)__half_as_ushort(__float2half_rn(v[2 * i + 1])) << 16);
      uint4 w; w.x = hw[0]; w.y = hw[1]; w.z = hw[2]; w.w = hw[3];
      *(uint4*)(vv + ((size_t)(lane >> 3) * T + t) * 64 + sub * 8) = w;
    }
    float cs4[4], sn4[4];
#pragma unroll
    for (int i = 0; i < 4; ++i) sincos_big(pos * INVF4[i], sn4[i], cs4[i]);
    {
      float4 a = *(const float4*)(zr + C_IQ + lane * 4);
      float y[4] = {a.x, a.y, a.z, a.w}, o[4];
#pragma unroll
      for (int i = 0; i < 4; ++i) {
        float oth = __shfl_xor(y[i], 1);
        float r0 = y[i] * cs4[i] - oth * sn4[i];
        float r1 = y[i] * cs4[i] + oth * sn4[i];
        o[i] = (sub == 0) ? r0 : ((sub == 1) ? r1 : y[i]);
      }
      uint2 w; w.x = pack2bf(o[0], o[1]); w.y = pack2bf(o[2], o[3]);
      *(uint2*)(iq + (size_t)t * 256 + lane * 4) = w;
    }
    {
      float4 a = (lane < 8) ? *(const float4*)(zr + C_IK + lane * 4) : make_float4(0, 0, 0, 0);
      float y[4] = {a.x, a.y, a.z, a.w}, o[4];
#pragma unroll
      for (int i = 0; i < 4; ++i) {
        float oth = __shfl_xor(y[i], 1);
        float r0 = y[i] * cs4[i] - oth * sn4[i];
        float r1 = y[i] * cs4[i] + oth * sn4[i];
        o[i] = (sub == 0) ? r0 : ((sub == 1) ? r1 : y[i]);
      }
      if (lane < 8) {
        uint2 w; w.x = pack2bf(o[0], o[1]); w.y = pack2bf(o[2], o[3]);
        *(uint2*)(ik + (size_t)(t >> 5) * 1024 + (size_t)(((lane >> 2) * 2 + ((lane >> 1) & 1)) * 256 + (t & 31) * 8 + (lane & 1) * 4)) = w;
        iw[(size_t)t * 8 + lane] = zr[C_IW + lane];
      }
    }
  }
}

__device__ void phase_post_rwkv(const Params& p, char* smem) {
  const float* z = (const float*)(p.ws + OFF_Z);
  float* sv = (float*)(p.ws + OFF_SV); float* G = (float*)(p.ws + OFF_G); float* BON = (float*)(p.ws + OFF_BONUS);
  float* lora = (float*)smem;
  const int tid = threadIdx.x, lane = tid & 63, h = tid >> 6, c = tid;
  const float mu_r = p.rwkv_mu[c], mu_k = p.rwkv_mu[512 + c], mu_v = p.rwkv_mu[1024 + c];
  const float w0 = p.rwkv_w0[c], a0 = p.rwkv_a0[c], kkw = p.rwkv_k_k[c], kaw = p.rwkv_k_a[c], rkw = p.rwkv_r_k[c];
  float wr2[32], ar2[32], gr2[64];
#pragma unroll
  for (int j = 0; j < 32; ++j) { wr2[j] = p.rwkv_w2[j * 512 + c]; ar2[j] = p.rwkv_a2[j * 512 + c]; }
#pragma unroll
  for (int j = 0; j < 64; ++j) gr2[j] = p.rwkv_g2[j * 512 + c];
  for (int tg = blockIdx.x; tg < T / 8; tg += gridDim.x) {
    const int t0 = tg * 8;
#pragma unroll
    for (int i = 0; i < 2; ++i) {
      int item = tid + 512 * i, tok = item >> 7, j = item & 127, t = t0 + tok;
      int col = C_RW + 1536 + j;
      float zc = z[(size_t)t * DINP + col];
      float zp = (t > 0) ? z[(size_t)(t - 1) * DINP + col] : 0.f;
      float xs = zc + (zp - zc) * p.rwkv_mu[1536 + j];
      float o = (j < 32) ? tanhf(xs) : ((j < 64) ? xs : sigmoidf_(xs));
      lora[tok * 128 + j] = o;
    }
    __syncthreads();
    float zr9[9], zk9[9], zv9[9];
#pragma unroll
    for (int k = 0; k < 9; ++k) {
      const int t = t0 - 1 + k;
      if (t >= 0) { const float* zp_ = z + (size_t)t * DINP + C_RW; zr9[k] = zp_[c]; zk9[k] = zp_[512 + c]; zv9[k] = zp_[1024 + c]; }
      else { zr9[k] = 0.f; zk9[k] = 0.f; zv9[k] = 0.f; }
    }
#pragma unroll
    for (int k = 0; k < 8; ++k) {
      const f32x4* lr = (const f32x4*)(lora + k * 128);
      float w0_ = 0.f, w1_ = 0.f, a0_ = 0.f, a1_ = 0.f, g0_ = 0.f, g1_ = 0.f;
#pragma unroll
      for (int j = 0; j < 8; ++j) {
        const f32x4 lw = lr[j];
        w0_ += lw[0] * wr2[4 * j] + lw[2] * wr2[4 * j + 2]; w1_ += lw[1] * wr2[4 * j + 1] + lw[3] * wr2[4 * j + 3];
      }
      asm volatile("" : "+v"(w0_), "+v"(w1_) :: "memory");
#pragma unroll
      for (int j = 0; j < 8; ++j) {
        const f32x4 la = lr[8 + j];
        a0_ += la[0] * ar2[4 * j] + la[2] * ar2[4 * j + 2]; a1_ += la[1] * ar2[4 * j + 1] + la[3] * ar2[4 * j + 3];
      }
      asm volatile("" : "+v"(a0_), "+v"(a1_) :: "memory");
#pragma unroll
      for (int j = 0; j < 8; ++j) {
        const f32x4 lg = lr[16 + j];
        g0_ += lg[0] * gr2[4 * j] + lg[2] * gr2[4 * j + 2]; g1_ += lg[1] * gr2[4 * j + 1] + lg[3] * gr2[4 * j + 3];
      }
      asm volatile("" : "+v"(g0_), "+v"(g1_) :: "memory");
#pragma unroll
      for (int j = 8; j < 16; ++j) {
        const f32x4 lg = lr[16 + j];
        g0_ += lg[0] * gr2[4 * j] + lg[2] * gr2[4 * j + 2]; g1_ += lg[1] * gr2[4 * j + 1] + lg[3] * gr2[4 * j + 3];
      }
      asm volatile("" : "+v"(g0_), "+v"(g1_) :: "memory");
      const float aw_k = w0_ + w1_, aa_k = a0_ + a1_, ag_k = g0_ + g1_;
      const int t = t0 + k;
      const float rc = zr9[k + 1], kc = zk9[k + 1], vc = zv9[k + 1];
      const float rp = zr9[k], kp = zk9[k], vp = zv9[k];
      float r = rc + (rp - rc) * mu_r, kx = kc + (kp - kc) * mu_k, v = vc + (vp - vc) * mu_v;
      float xw = -(w0 + aw_k);
      float sp = fmaxf(xw, 0.f) + log1pf(__expf(-fabsf(xw)));
      float logw = -sp - 0.5f;
      float decay = __expf(-__expf(logw));
      float a = sigmoidf_(a0 + aa_k);
      float kk = kx * kkw;
      float ss = wave_sum(kk * kk);
      kk *= rsqrtf(fmaxf(ss, 1e-24f));
      float kmod = kx * (1.f + (a - 1.f) * kaw);
      float bon = wave_sum(r * kmod * rkw);
      float* o = sv + ((size_t)t * 8 + h) * 384 + lane;
      o[0] = decay; o[64] = kk; o[128] = kk * a; o[192] = kmod; o[256] = r; o[320] = v;
      G[(size_t)t * 512 + c] = ag_k;
      if (lane == 0) BON[(size_t)t * 8 + h] = bon;
    }
    __syncthreads();
  }
}

typedef float f2 __attribute__((ext_vector_type(2)));
#define SB_ __builtin_amdgcn_sched_barrier(0)
#define PIN16(o) asm volatile("" : "+v"(S2[o+0]), "+v"(S2[o+1]), "+v"(S2[o+2]), "+v"(S2[o+3]), "+v"(S2[o+4]), "+v"(S2[o+5]), "+v"(S2[o+6]), "+v"(S2[o+7]), \
    "+v"(S2[o+8]), "+v"(S2[o+9]), "+v"(S2[o+10]), "+v"(S2[o+11]), "+v"(S2[o+12]), "+v"(S2[o+13]), "+v"(S2[o+14]), "+v"(S2[o+15]) :: "memory")
#define SC_LO(v) ((f2){(v)[0], (v)[1]})
#define SC_HI(v) ((f2){(v)[2], (v)[3]})

__device__ __forceinline__ float dpp_qp1(float v) { return __uint_as_float(__builtin_amdgcn_update_dpp(0u, __float_as_uint(v), 0xB1, 0xF, 0xF, true)); }
__device__ __forceinline__ float dpp_qp2(float v) { return __uint_as_float(__builtin_amdgcn_update_dpp(0u, __float_as_uint(v), 0x4E, 0xF, 0xF, true)); }
__device__ __forceinline__ float red4(float v) { v += dpp_qp1(v); v += dpp_qp2(v); return v; }

#define SCAN_DMA(base, ldsbuf) do { \
    __builtin_amdgcn_global_load_lds((const unsigned*)((base) + go0), (LAS unsigned*)(ldsbuf), 16, 0, 0); \
    __builtin_amdgcn_global_load_lds((const unsigned*)((base) + go1), (LAS unsigned*)((ldsbuf) + 256), 16, 0, 0); \
    __builtin_amdgcn_global_load_lds((const unsigned*)((base) + go2), (LAS unsigned*)((ldsbuf) + 512), 16, 0, 0); \
    __builtin_amdgcn_global_load_lds((const unsigned*)((base) + go3), (LAS unsigned*)((ldsbuf) + 768), 16, 0, 0); \
    __builtin_amdgcn_global_load_lds((const unsigned*)((base) + go4), (LAS unsigned*)((ldsbuf) + 1024), 16, 0, 0); \
    __builtin_amdgcn_global_load_lds((const unsigned*)((base) + go5), (LAS unsigned*)((ldsbuf) + 1280), 16, 0, 0); } while (0)

#define SCV_LD4(V, rec, q) do { const f32x4* rc_ = (const f32x4*)(rec) + (q) + 4 * cb; V[0] = rc_[0]; V[1] = rc_[1]; V[2] = rc_[2]; V[3] = rc_[3]; } while (0)
#define SCV_PAIR(V, jp) (((jp) & 1) ? SC_HI(V[(jp) >> 1]) : SC_LO(V[(jp) >> 1]))

template <int MODE>
__device__ void scan_task(const Params& p, int h, int c, float* wl  ) {
  const int lane = threadIdx.x & 63;
  const int ra = lane >> 2, cb = lane & 3;
  const float* sv = (const float*)(p.ws + OFF_SV);
  f2 S2[32];
  if (MODE == 0) {
#pragma unroll
    for (int i = 0; i < 4; ++i)
#pragma unroll
      for (int jp = 0; jp < 8; ++jp) S2[i * 8 + jp] = (f2){(4 * ra + i == 16 * cb + 2 * jp) ? 1.f : 0.f, (4 * ra + i == 16 * cb + 2 * jp + 1) ? 1.f : 0.f};
  } else if (MODE == 1) {
#pragma unroll
    for (int j = 0; j < 32; ++j) S2[j] = (f2){0.f, 0.f};
  } else {
    const float* si = (const float*)(p.ws + OFF_SI) + (size_t)(h * NCH + c) * 4096 + (4 * ra) * 64 + 16 * cb;
#pragma unroll
    for (int i = 0; i < 4; ++i)
#pragma unroll
      for (int q = 0; q < 4; ++q) { const float4 u = *(const float4*)(si + i * 64 + 4 * q); S2[i * 8 + 2 * q] = (f2){u.x, u.y}; S2[i * 8 + 2 * q + 1] = (f2){u.z, u.w}; }
  }
  float* Y = (float*)(p.ws + OFF_Y);
  const float* src = sv + ((size_t)(c * CHL) * 8 + h) * 384;
  const int f0 = lane, f1 = lane + 64, f2_ = lane + 128, f3 = lane + 192, f4 = lane + 256, f5 = lane + 320;
  const int go0 = (f0 / 96) * 3072 + (f0 % 96) * 4, go1 = (f1 / 96) * 3072 + (f1 % 96) * 4, go2 = (f2_ / 96) * 3072 + (f2_ % 96) * 4;
  const int go3 = (f3 / 96) * 3072 + (f3 % 96) * 4, go4 = (f4 / 96) * 3072 + (f4 % 96) * 4, go5 = (f5 / 96) * 3072 + (f5 % 96) * 4;
  SCAN_DMA(src, wl);
  constexpr int NG = CHL / 4;
  f32x4 KK[4], KN[4];
#define SCAN_STEP(KC, KNX, rec, nrec, tstep) do { \
    f32x4 W_[4], B_[4]; \
    SCV_LD4(W_, rec, 0); SCV_LD4(B_, rec, 32); SB_; \
    float d_[4]; \
    _Pragma("unroll") for (int i = 0; i < 4; ++i) { \
      f2 a_ = S2[i * 8] * SCV_PAIR(KC, 0); \
      _Pragma("unroll") for (int jp = 1; jp < 8; ++jp) a_ += S2[i * 8 + jp] * SCV_PAIR(KC, jp); \
      d_[i] = red4(a_[0] + a_[1]); } \
    asm volatile("" : "+v"(d_[0]), "+v"(d_[1]), "+v"(d_[2]), "+v"(d_[3]) :: "memory"); SB_; \
    f32x4 K_[4]; f32x4 R_[4]; f32x4 v4_ = {0.f, 0.f, 0.f, 0.f}; \
    if (MODE != 0) { SCV_LD4(K_, rec, 48); v4_ = ((const f32x4*)(rec))[80 + ra]; } \
    if (MODE == 2) SCV_LD4(R_, rec, 64); \
    if ((nrec) != nullptr) SCV_LD4(KNX, nrec, 16); \
    SB_; \
    _Pragma("unroll") for (int i = 0; i < 4; ++i) { \
      const f2 ns_ = (f2){-d_[i], -d_[i]}; \
      _Pragma("unroll") for (int jp = 0; jp < 8; ++jp) S2[i * 8 + jp] = S2[i * 8 + jp] * SCV_PAIR(W_, jp) + ns_ * SCV_PAIR(B_, jp); } \
    PIN16(0); PIN16(16); SB_; \
    if (MODE != 0) { \
      _Pragma("unroll") for (int i = 0; i < 4; ++i) { \
        const f2 vi_ = (f2){v4_[i], v4_[i]}; \
        _Pragma("unroll") for (int jp = 0; jp < 8; ++jp) S2[i * 8 + jp] += vi_ * SCV_PAIR(K_, jp); } \
      PIN16(0); PIN16(16); SB_; } \
    if (MODE == 2) { \
      float y_ = 0.f; \
      _Pragma("unroll") for (int i = 0; i < 4; ++i) { \
        f2 a_ = S2[i * 8] * SCV_PAIR(R_, 0); \
        _Pragma("unroll") for (int jp = 1; jp < 8; ++jp) a_ += S2[i * 8 + jp] * SCV_PAIR(R_, jp); \
        const float e_ = red4(a_[0] + a_[1]); \
        y_ = (cb == i) ? e_ : y_; } \
      Y[(size_t)(tstep) * 512 + h * 64 + lane] = y_;         \
      SB_; } \
  } while (0)
  for (int g = 0; g < NG; ++g) {
    asm volatile("s_waitcnt vmcnt(0)" ::: "memory");
    if (g + 1 < NG) SCAN_DMA(src + (size_t)(g + 1) * 4 * 3072, wl + ((g + 1) & 1) * 1536);
    const float* Lb = wl + (g & 1) * 1536;
    const int tb = c * CHL + g * 4;
    SCV_LD4(KK, Lb, 16); SB_;
    SCAN_STEP(KK, KN, Lb, Lb + 384, tb);
    SCAN_STEP(KN, KK, Lb + 384, Lb + 768, tb + 1);
    SCAN_STEP(KK, KN, Lb + 768, Lb + 1152, tb + 2);
    SCAN_STEP(KN, KK, Lb + 1152, (const float*)nullptr, tb + 3);
  }
  if (MODE != 2) {
    float* o = (float*)(p.ws + (MODE == 0 ? OFF_SP : OFF_SL)) + (size_t)(h * NCH + c) * 4096 + (4 * ra) * 64 + 16 * cb;
#pragma unroll
    for (int i = 0; i < 4; ++i)
#pragma unroll
      for (int q = 0; q < 4; ++q) *(float4*)(o + i * 64 + 4 * q) = make_float4(S2[i * 8 + 2 * q][0], S2[i * 8 + 2 * q][1], S2[i * 8 + 2 * q + 1][0], S2[i * 8 + 2 * q + 1][1]);
  }
#undef SCAN_STEP
}

__device__ void phase_scan_a(const Params& p, char* smem) {
  const int wid = __builtin_amdgcn_readfirstlane(threadIdx.x >> 6);
  float* wl = (float*)smem + wid * 3072;
  const int nw = gridDim.x * 8;
  for (int id = wid * (int)gridDim.x + (int)blockIdx.x; id < 8 * NCH; id += nw) scan_task<0>(p, id & 7, id >> 3, wl);
  for (int id = wid * (int)gridDim.x + (int)blockIdx.x; id < 16 * NCH; id += nw) { if (id >= 8 * NCH) scan_task<1>(p, id & 7, (id - 8 * NCH) >> 3, wl); }
}

__device__ __forceinline__ float rdlane(float v, int l) { return __uint_as_float(__builtin_amdgcn_readlane(__float_as_uint(v), l)); }

__device__ void scan_b_row(const Params& p, int h, int row, float* pbuf  ) {
  const int lane = threadIdx.x & 63;
  const float* SP = (const float*)(p.ws + OFF_SP) + (size_t)h * NCH * 4096;
  const float* SL = (const float*)(p.ws + OFF_SL) + (size_t)h * NCH * 4096 + row * 64 + lane;
  float* SI = (float*)(p.ws + OFF_SI) + (size_t)h * NCH * 4096 + row * 64 + lane;
  float sreg = 0.f;
  SI[0] = 0.f;
#define SB_DMA(c_, buf_) do { _Pragma("unroll") for (int i_ = 0; i_ < 16; ++i_) \
    __builtin_amdgcn_global_load_lds((const unsigned*)(SP + (size_t)(c_) * 4096 + (i_ * 64 + lane) * 4), (LAS unsigned*)((buf_) + i_ * 256), 16, 0, 0); } while (0)
  float lcur = SL[0];
  SB_DMA(0, pbuf);
  for (int c = 0; c < NCH - 1; ++c) {
    float* cb = pbuf + (c & 1) * 4096;
    float lnext = 0.f;
    if (c + 1 < NCH - 1) {
      lnext = SL[(size_t)(c + 1) * 4096];
      SB_DMA(c + 1, pbuf + ((c + 1) & 1) * 4096);
      asm volatile("s_waitcnt vmcnt(17)" ::: "memory");
    } else {
      asm volatile("s_waitcnt vmcnt(0)" ::: "memory");
    }
    float a0 = lcur, a1 = 0.f, a2 = 0.f, a3 = 0.f;
#pragma unroll
    for (int k = 0; k < 64; k += 4) {
      a0 = __builtin_fmaf(rdlane(sreg, k), cb[k * 64 + lane], a0); a1 = __builtin_fmaf(rdlane(sreg, k + 1), cb[(k + 1) * 64 + lane], a1);
      a2 = __builtin_fmaf(rdlane(sreg, k + 2), cb[(k + 2) * 64 + lane], a2); a3 = __builtin_fmaf(rdlane(sreg, k + 3), cb[(k + 3) * 64 + lane], a3);
    }
    sreg = (a0 + a1) + (a2 + a3);
    SI[(size_t)(c + 1) * 4096] = sreg;
    lcur = lnext;
  }
#undef SB_DMA
}

__device__ void transpose_convert_wave(const float* src, u16* dst, int R, int C, int nbatch, int id0, int id1, int wv, int nwaves) {
  const int lane = threadIdx.x & 63, ng = lane & 15, g = lane >> 4;
  const int tr = R / 64, tc = C / 64;
#pragma unroll 1
  for (int id = id0 + wv; id < id1; id += nwaves) {
    const int b = id / (tr * tc), rem = id % (tr * tc);
    const int r0 = (rem / tc) * 64, c0 = (rem % tc) * 64;
    const float* s = src + (size_t)b * R * C + (size_t)(r0 + 8 * g) * C + c0 + 4 * ng;
    u16* d = dst + (size_t)b * C * R + (size_t)(c0 + 4 * ng) * R + r0 + 8 * g;
#pragma unroll
    for (int hf = 0; hf < 2; ++hf) {
      float4 v[8];
#pragma unroll
      for (int i = 0; i < 8; ++i) v[i] = *(const float4*)(s + (size_t)(hf * 32 + i) * C);
      uint4 o0, o1, o2, o3;
      o0.x = pack2bf(v[0].x, v[1].x); o0.y = pack2bf(v[2].x, v[3].x); o0.z = pack2bf(v[4].x, v[5].x); o0.w = pack2bf(v[6].x, v[7].x);
      o1.x = pack2bf(v[0].y, v[1].y); o1.y = pack2bf(v[2].y, v[3].y); o1.z = pack2bf(v[4].y, v[5].y); o1.w = pack2bf(v[6].y, v[7].y);
      o2.x = pack2bf(v[0].z, v[1].z); o2.y = pack2bf(v[2].z, v[3].z); o2.z = pack2bf(v[4].z, v[5].z); o2.w = pack2bf(v[6].z, v[7].z);
      o3.x = pack2bf(v[0].w, v[1].w); o3.y = pack2bf(v[2].w, v[3].w); o3.z = pack2bf(v[4].w, v[5].w); o3.w = pack2bf(v[6].w, v[7].w);
      *(uint4*)(d + hf * 32) = o0; *(uint4*)(d + (size_t)R + hf * 32) = o1; *(uint4*)(d + (size_t)2 * R + hf * 32) = o2; *(uint4*)(d + (size_t)3 * R + hf * 32) = o3;
    }
  }
}
constexpr int PREP_GU_TILES = NE * 16 * 32, PREP_DN_TILES = NE * 16 * 16, PREP_TILES = PREP_GU_TILES + PREP_DN_TILES;
constexpr int PREP_SPLIT = 0;
__device__ void prep_expert_range(const Params& p, int lo, int hi, int wv, int nwaves) {
  if (lo < PREP_GU_TILES) transpose_convert_wave(p.exp_w_gu, (u16*)(p.ws + OFF_WGUT), 1024, 2048, NE, lo, hi < PREP_GU_TILES ? hi : PREP_GU_TILES, wv, nwaves);
  if (hi > PREP_GU_TILES) {
    const int l2 = (lo > PREP_GU_TILES ? lo : PREP_GU_TILES) - PREP_GU_TILES;
    transpose_convert_wave(p.exp_w_down, (u16*)(p.ws + OFF_WDNT), 1024, 1024, NE, l2, hi - PREP_GU_TILES, wv, nwaves);
  }
}

__device__ void scan_b_block(const Params& p, int h, int rg, float* ring  ) {
  const int lane = threadIdx.x & 63, w = __builtin_amdgcn_readfirstlane(threadIdx.x >> 6);
  const int row = rg * 8 + w;
  const float* SP = (const float*)(p.ws + OFF_SP) + (size_t)h * NCH * 4096;
  const float* SL = (const float*)(p.ws + OFF_SL) + (size_t)h * NCH * 4096 + row * 64 + lane;
  float* SI = (float*)(p.ws + OFF_SI) + (size_t)h * NCH * 4096 + row * 64 + lane;
  float sreg = 0.f;
  SI[0] = 0.f;
#define SBB_DMA(c_, buf_) do { \
    __builtin_amdgcn_global_load_lds((const unsigned*)(SP + (size_t)(c_) * 4096 + ((2 * w) * 64 + lane) * 4), (LAS unsigned*)((buf_) + (2 * w) * 256), 16, 0, 0); \
    __builtin_amdgcn_global_load_lds((const unsigned*)(SP + (size_t)(c_) * 4096 + ((2 * w + 1) * 64 + lane) * 4), (LAS unsigned*)((buf_) + (2 * w + 1) * 256), 16, 0, 0); } while (0)
  constexpr int LASTC = NCH - 2;
  float l0 = SL[0]; SBB_DMA(0, ring);
  float l1 = SL[(size_t)1 * 4096]; SBB_DMA(1, ring + 4096);
  for (int c = 0; c < NCH - 1; ++c) {
    asm volatile("s_waitcnt vmcnt(3)" ::: "memory");
    __builtin_amdgcn_s_barrier();
    const int cn = (c + 2 <= LASTC) ? (c + 2) : LASTC;
    const float l2 = SL[(size_t)cn * 4096];
    SBB_DMA(cn, ring + ((c + 2) % 3) * 4096);
    const float* cb = ring + (c % 3) * 4096;
    float a0 = l0, a1 = 0.f, a2 = 0.f, a3 = 0.f;
#pragma unroll
    for (int k = 0; k < 64; k += 4) {
      a0 = __builtin_fmaf(rdlane(sreg, k), cb[k * 64 + lane], a0); a1 = __builtin_fmaf(rdlane(sreg, k + 1), cb[(k + 1) * 64 + lane], a1);
      a2 = __builtin_fmaf(rdlane(sreg, k + 2), cb[(k + 2) * 64 + lane], a2); a3 = __builtin_fmaf(rdlane(sreg, k + 3), cb[(k + 3) * 64 + lane], a3);
    }
    sreg = (a0 + a1) + (a2 + a3);
    SI[(size_t)(c + 1) * 4096] = sreg;
    l0 = l1; l1 = l2;
  }
  asm volatile("s_waitcnt vmcnt(0)" ::: "memory");
  __syncthreads();
#undef SBB_DMA
}

__device__ void phase_scan_c(const Params& p, char* smem) {
  const int wid = __builtin_amdgcn_readfirstlane(threadIdx.x >> 6);
  const int nw = gridDim.x * 4;
  if (wid < 4) {
    float* wl = (float*)smem + wid * 3072;
    for (int id = wid * (int)gridDim.x + (int)blockIdx.x; id < 8 * NCH; id += nw) scan_task<2>(p, id & 7, id >> 3, wl);
  } else {
    prep_expert_range(p, PREP_SPLIT, PREP_TILES, (wid - 4) * (int)gridDim.x + (int)blockIdx.x, nw);
  }
}

__device__ void phase_rwkv_out(const Params& p) {
  const float* Y = (const float*)(p.ws + OFF_Y); const float* sv = (const float*)(p.ws + OFF_SV);
  const float* G = (const float*)(p.ws + OFF_G); const float* BON = (const float*)(p.ws + OFF_BONUS);
  u16* mix = (u16*)(p.ws + OFF_MIX);
  const int tid = threadIdx.x, lane = tid & 63, h = tid >> 6;
  const float lw = p.rwkv_ln_w[tid], lb = p.rwkv_ln_b[tid];
  for (int t = blockIdx.x; t < T; t += gridDim.x) {
    float y = Y[(size_t)t * 512 + tid];
    float mean = wave_sum(y) * (1.f / 64.f);
    float d = y - mean;
    float var = wave_sum(d * d) * (1.f / 64.f);
    float o = d * rsqrtf(var + 64e-5f) * lw + lb;
    float v = sv[((size_t)t * 8 + h) * 384 + 320 + lane];
    o = (o + BON[(size_t)t * 8 + h] * v) * G[(size_t)t * 512 + tid];
    mix[(size_t)t * 1024 + 512 + tid] = f2bf(o);
  }
}

typedef short s16x2 __attribute__((ext_vector_type(2)));
__device__ __forceinline__ float irelu(float x) { return __int_as_float(max(__float_as_int(x), 0)); }
__device__ __forceinline__ u16 score_key(float s) {
  s = fminf(fmaxf(s, -60000.f), 60000.f);
  u16 b = __half_as_ushort(__float2half_rn(s));
  return (b & 0x8000u) ? (u16)(~b) : (u16)(b | 0x8000u);
}

__device__ __forceinline__ void topk_level1(const u32* hq, int lane, u32& Bs, u32& cnt_above) {
  u32 ssum = 0;
#pragma unroll
  for (int d = 0; d < 16; ++d) ssum += hq[16 * lane + d];
  u32 suf = ssum;
#pragma unroll
  for (int off = 1; off < 64; off <<= 1) { u32 o = __shfl_down(suf, off); if (lane + off < 64) suf += o; }
  unsigned long long m = __ballot(suf >= 256u);
  const int Ls = 63 - __clzll(m);
  const u32 above = __shfl(suf, Ls) - __shfl(ssum, Ls);
  const u32 c1 = (lane < 16) ? hq[16 * Ls + lane] : 0u;
  u32 suf2 = c1;
#pragma unroll
  for (int off = 1; off < 16; off <<= 1) { u32 o = __shfl_down(suf2, off); if (lane + off < 64) suf2 += o; }
  unsigned long long m2 = __ballot((lane < 16) && (above + suf2 >= 256u));
  const int js = 63 - __clzll(m2);
  Bs = (u32)(16 * Ls + js);
  cnt_above = above + __shfl(suf2, js) - __shfl(c1, js);
}

constexpr int TK_CAP = 512;
__device__ __forceinline__ u32 topk_candidates(const u16* keys, int n, int c0, int c1, u32 Bs, u32* h2, u16* list, int lane) {
  u32 running = 0;
  for (int it = c0; it < c1; ++it) {
    const int base = it * 512 + lane;
#pragma unroll
    for (int e = 0; e < 8; ++e) {
      const int idx = base + e * 64;
      const u32 k = keys[idx];
      const u32 bin = k >> 6;
      const bool f = (idx < n) && (bin >= Bs);
      const unsigned long long m = __ballot(f);
      if (m) {
        const u32 r = running + __builtin_amdgcn_mbcnt_hi((u32)(m >> 32), __builtin_amdgcn_mbcnt_lo((u32)m, 0u));
        if (f) {
          if (r < (u32)TK_CAP) list[r] = (u16)idx;
          if (bin == Bs) atomicAdd(&h2[k & 63u], 1u);
        }
        running += (u32)__popcll(m);
      }
    }
  }
  return running;
}

__device__ __forceinline__ void topk_emit(const u16* keys, const u16* list, int cnt, u32 Kstar, u32 need_eq, u32& base_gt, u32& base_eq, u16* selout, int lane) {
  for (int i0 = 0; i0 < cnt; i0 += 64) {
    const int i = i0 + lane;
    const bool v = i < cnt;
    const u32 idx = v ? (u32)list[i] : 0u;
    const u32 k = keys[idx];
    const bool g = v && k > Kstar, q = v && k == Kstar;
    const unsigned long long mg = __ballot(g), me = __ballot(q);
    const u32 gb = base_gt + __builtin_amdgcn_mbcnt_hi((u32)(mg >> 32), __builtin_amdgcn_mbcnt_lo((u32)mg, 0u));
    const u32 eb = base_eq + __builtin_amdgcn_mbcnt_hi((u32)(me >> 32), __builtin_amdgcn_mbcnt_lo((u32)me, 0u));
    if (g) selout[gb + min(eb, need_eq)] = (u16)idx;
    else if (q && eb < need_eq) selout[gb + eb] = (u16)idx;
    base_gt += (u32)__popcll(mg); base_eq += (u32)__popcll(me);
  }
}

__device__ __forceinline__ u32 topk_pass1(const u16* keys, int n, int c0, int c1, u32 Bs, u32* h2, int lane) {
  u32 cg = 0;
  for (int it = c0; it < c1; ++it) {
    const int base = it * 512 + lane * 8;
    uint4 kv = *(const uint4*)(keys + base);
    u32 w[4] = {kv.x, kv.y, kv.z, kv.w};
#pragma unroll
    for (int e = 0; e < 8; ++e) {
      u32 k = (e & 1) ? (w[e >> 1] >> 16) : (w[e >> 1] & 0xFFFFu);
      const bool valid = (base + e < n);
      const u32 bin = k >> 6;
      if (valid && bin == Bs) atomicAdd(&h2[k & 63u], 1u);
      cg += (valid && bin > Bs) ? 1u : 0u;
    }
  }
#pragma unroll
  for (int o = 32; o >= 1; o >>= 1) cg += __shfl_xor(cg, o);
  return cg;
}

__device__ __forceinline__ void topk_pass2(const u16* keys, int n, int c0, int c1, u32 Kstar, u32 need_eq, u32 base_gt, u32 base_eq, u16* selout, int lane) {
  for (int it = c0; it < c1; ++it) {
    const int base = it * 512 + lane * 8;
    uint4 kv = *(const uint4*)(keys + base);
    u32 w[4] = {kv.x, kv.y, kv.z, kv.w};
    bool g[8], q[8];
    u32 lcg = 0, lce = 0, tg = 0, te = 0;
#pragma unroll
    for (int e = 0; e < 8; ++e) {
      u32 k = (e & 1) ? (w[e >> 1] >> 16) : (w[e >> 1] & 0xFFFFu);
      const bool valid = (base + e < n);
      g[e] = valid && k > Kstar; q[e] = valid && k == Kstar;
      const unsigned long long mg = __ballot(g[e]), me = __ballot(q[e]);
      lcg += __builtin_amdgcn_mbcnt_hi((u32)(mg >> 32), __builtin_amdgcn_mbcnt_lo((u32)mg, 0u));
      lce += __builtin_amdgcn_mbcnt_hi((u32)(me >> 32), __builtin_amdgcn_mbcnt_lo((u32)me, 0u));
      tg += __popcll(mg); te += __popcll(me);
    }
    u32 gb = base_gt + lcg, eb = base_eq + lce;
#pragma unroll
    for (int e = 0; e < 8; ++e) {
      if (g[e]) selout[gb + min(eb, need_eq)] = (u16)(base + e);
      else if (q[e] && eb < need_eq) selout[gb + eb] = (u16)(base + e);
      gb += g[e] ? 1u : 0u; eb += q[e] ? 1u : 0u;
    }
    base_gt += tg; base_eq += te;
  }
}

__device__ void phase_topk(const Params& p, char* smem) {
  u16* keys = (u16*)smem;
  u32* hist = (u32*)(smem + 131072);
  u32* hist2 = hist + 4096;
  const u16* iq = (const u16*)(p.ws + OFF_IQ); const u16* ik = (const u16*)(p.ws + OFF_IK);
  const float* iw = (const float*)(p.ws + OFF_IW);
  u16* sel = (u16*)(p.ws + OFF_SEL);
  const int tid = threadIdx.x, lane = tid & 63, wid = tid >> 6;
  const int r = lane & 31, hh = lane >> 5;
  const int ngroups = (T - 256) / 4;
  if (blockIdx.x < 64) scan_b_block(p, blockIdx.x >> 3, blockIdx.x & 7, (float*)smem);
  int* const queue = (int*)(p.ws + OFF_CNT) + 48;
  volatile int* const qslot = (volatile int*)(smem + SM_TAIL + 32);
  for (;;) {
    __syncthreads();
    if (tid == 0) *qslot = atomicAdd(queue, 1);
    __syncthreads();
    const int gq = *qslot;
    if (gq >= ngroups) break;
    const int gsel = ngroups - 1 - gq;
    const int t0 = 256 + gsel * 4;
    for (int i = tid; i < 4096 + 288; i += NTHREADS) hist[i] = 0u;
    __syncthreads();
    PROF_T0(1)
    const u16* iqp = iq + ((size_t)(t0 + (r & 3)) * 8 + (r >> 2)) * 32 + 8 * hh;
    const bf16x8 a0 = *(const bf16x8*)iqp, a1 = *(const bf16x8*)(iqp + 16);
    float wq[16];
#pragma unroll
    for (int i = 0; i < 16; ++i) wq[i] = iw[(size_t)(t0 + (i & 3)) * 8 + 2 * (i >> 2) + hh];
    const int ntiles = (t0 + 4 + 31) >> 5;
#define TK_LOAD(KT, B0, B1) do { if ((KT) < ntiles) { const u16* ikp_ = ik + (size_t)(KT) * 1024 + hh * 256 + r * 8; \
      B0 = *(const bf16x8*)ikp_; B1 = *(const bf16x8*)(ikp_ + 512); } } while (0)
#define TK_TAIL2(SA, SB, LASTT) do { \
      const s16x2 hp_ = __builtin_bit_cast(s16x2, __builtin_amdgcn_cvt_pkrtz(SA, SB)); \
      const s16x2 sh_ = {15, 15}; \
      u32 k2_ = __builtin_bit_cast(u32, hp_) ^ (__builtin_bit_cast(u32, hp_ >> sh_) | 0x80008000u);     \
      if (LASTT) { if (key > t0 + hh) k2_ &= 0xFFFF0000u; if (key > t0 + 2 + hh) k2_ &= 0x0000FFFFu; } \
      keysa[key] = (u16)k2_; keysb[key] = (u16)(k2_ >> 16); \
      if (!(LASTT) || (k2_ & 0xFFFFu)) atomicAdd((u32*)((char*)hista + ((k2_ >> 4) & 0xFFCu)), 1u); \
      if (!(LASTT) || (k2_ >> 16)) atomicAdd((u32*)((char*)histb + ((k2_ >> 20) & 0xFFCu)), 1u); \
    } while (0)
#define TK_PROC(KT, B0, B1) do { \
      const int key = (KT) * 32 + r; \
      f32x16 acc; \
      _Pragma("unroll") for (int i_ = 0; i_ < 16; ++i_) acc[i_] = 0.f; \
      acc = __builtin_amdgcn_mfma_f32_32x32x16_bf16(a0, B0, acc, 0, 0, 0); \
      acc = __builtin_amdgcn_mfma_f32_32x32x16_bf16(a1, B1, acc, 0, 0, 0); \
      float s0 = 0.f, s1 = 0.f, s2 = 0.f, s3 = 0.f; \
      _Pragma("unroll") for (int i_ = 0; i_ < 16; i_ += 4) { \
        s0 = __builtin_fmaf(wq[i_], irelu(acc[i_]), s0); s1 = __builtin_fmaf(wq[i_ + 1], irelu(acc[i_ + 1]), s1); \
        s2 = __builtin_fmaf(wq[i_ + 2], irelu(acc[i_ + 2]), s2); s3 = __builtin_fmaf(wq[i_ + 3], irelu(acc[i_ + 3]), s3); } \
      auto sw01 = __builtin_amdgcn_permlane32_swap(__float_as_uint(s0), __float_as_uint(s1), false, false); \
      auto sw23 = __builtin_amdgcn_permlane32_swap(__float_as_uint(s2), __float_as_uint(s3), false, false); \
      const float sa = __uint_as_float(sw01[0]) + __uint_as_float(sw01[1]);     \
      const float sb = __uint_as_float(sw23[0]) + __uint_as_float(sw23[1]);     \
      if ((KT) == ntiles - 1) TK_TAIL2(sa, sb, true); else TK_TAIL2(sa, sb, false); \
    } while (0)
    u32* const hista = hist + hh * 1024;
    u32* const histb = hist + (2 + hh) * 1024;
    u16* const keysa = keys + hh * 16384;
    u16* const keysb = keys + (2 + hh) * 16384;
    {
      bf16x8 bA0, bA1, bB0, bB1, bC0, bC1, bD0, bD1, bE0, bE1, bF0, bF1, bG0, bG1, bH0, bH1;
      bA0 = bA1 = bB0 = bB1 = bC0 = bC1 = bD0 = bD1 = bE0 = bE1 = bF0 = bF1 = bG0 = bG1 = bH0 = bH1 = a0;
      int kt = wid;
      TK_LOAD(kt, bA0, bA1); TK_LOAD(kt + 8, bB0, bB1); TK_LOAD(kt + 16, bC0, bC1); TK_LOAD(kt + 24, bD0, bD1);
      TK_LOAD(kt + 32, bE0, bE1); TK_LOAD(kt + 40, bF0, bF1); TK_LOAD(kt + 48, bG0, bG1); TK_LOAD(kt + 56, bH0, bH1);
      for (; kt < ntiles; kt += 64) {
        TK_PROC(kt, bA0, bA1); TK_LOAD(kt + 64, bA0, bA1);
        if (kt + 8 < ntiles) { TK_PROC(kt + 8, bB0, bB1); TK_LOAD(kt + 72, bB0, bB1); }
        if (kt + 16 < ntiles) { TK_PROC(kt + 16, bC0, bC1); TK_LOAD(kt + 80, bC0, bC1); }
        if (kt + 24 < ntiles) { TK_PROC(kt + 24, bD0, bD1); TK_LOAD(kt + 88, bD0, bD1); }
        if (kt + 32 < ntiles) { TK_PROC(kt + 32, bE0, bE1); TK_LOAD(kt + 96, bE0, bE1); }
        if (kt + 40 < ntiles) { TK_PROC(kt + 40, bF0, bF1); TK_LOAD(kt + 104, bF0, bF1); }
        if (kt + 48 < ntiles) { TK_PROC(kt + 48, bG0, bG1); TK_LOAD(kt + 112, bG0, bG1); }
        if (kt + 56 < ntiles) { TK_PROC(kt + 56, bH0, bH1); TK_LOAD(kt + 120, bH0, bH1); }
      }
    }
    __syncthreads();
    PROF_T1(1)
    PROF_T0(2)
    {
      const int q = wid & 3, half = wid >> 2;
      const int tq = t0 + q, n = tq + 1;
      const u16* kq = keys + q * 16384;
      u32* h2 = hist2 + q * 64;
      u32* misc = hist2 + 256 + q * 4;
      u16* lists = (u16*)(hist2 + 288);
      u16* mylist = lists + (q * 2 + half) * TK_CAP;
      const int niter = (n + 511) >> 9, nh = (niter + 1) >> 1;
      const int c0 = half ? nh : 0, c1 = half ? niter : nh;
      u32 Bs, cnt_above;
      topk_level1(hist + q * 1024, lane, Bs, cnt_above);
      const u32 nc = topk_candidates(kq, n, c0, c1, Bs, h2, mylist, lane);
      if (lane == 0) misc[half] = nc;
      __syncthreads();
      if (half == 0) {
        const u32 c2 = h2[lane];
        const u32 need = 256u - cnt_above;
        u32 suf3 = c2;
#pragma unroll
        for (int off = 1; off < 64; off <<= 1) { u32 o = __shfl_down(suf3, off); if (lane + off < 64) suf3 += o; }
        unsigned long long m3 = __ballot(suf3 >= need);
        const int vs = 63 - __clzll(m3);
        const u32 Kstar = (Bs << 6) | (u32)vs;
        const u32 cnt_gt = cnt_above + __shfl(suf3, vs) - __shfl(c2, vs);
        const u32 need_eq = 256u - cnt_gt;
        const u32 na = misc[0], nb = misc[1];
        u16* so = sel + (size_t)tq * 256;
        if (na <= (u32)TK_CAP && nb <= (u32)TK_CAP) {
          u32 bg = 0, be = 0;
          topk_emit(kq, lists + (q * 2) * TK_CAP, (int)na, Kstar, need_eq, bg, be, so, lane);
          topk_emit(kq, lists + (q * 2 + 1) * TK_CAP, (int)nb, Kstar, need_eq, bg, be, so, lane);
        } else {
          topk_pass2(kq, n, 0, niter, Kstar, need_eq, 0u, 0u, so, lane);
        }
      }
    }
    __syncthreads();
    PROF_T1(2)
  }
}

typedef _Float16 h2_t __attribute__((ext_vector_type(2)));
__device__ __forceinline__ float dot2h(u32 a, u32 b, float c) { return __builtin_amdgcn_fdot2(__builtin_bit_cast(h2_t, a), __builtin_bit_cast(h2_t, b), c, false); }
__device__ __forceinline__ float hlo(u32 a) { return (float)(__builtin_bit_cast(h2_t, a)[0]); }
__device__ __forceinline__ float hhi(u32 a) { return (float)(__builtin_bit_cast(h2_t, a)[1]); }

__device__ __forceinline__ float dpp_xor1(float v) {
  return __uint_as_float(__builtin_amdgcn_update_dpp(0u, __float_as_uint(v), 0xB1, 0xF, 0xF, true));
}

__device__ void phase_attn(const Params& p, char* smem) {
  const u16* qh = (const u16*)(p.ws + OFF_QR); const u16* kh = (const u16*)(p.ws + OFF_KR); const u16* vh = (const u16*)(p.ws + OFF_VV);
  const u16* sel = (const u16*)(p.ws + OFF_SEL); const float* qsh = (const float*)(p.ws + OFF_QSH);
  u16* mix = (u16*)(p.ws + OFF_MIX);
  uint4* sK = (uint4*)smem;
  uint4* sV = (uint4*)(smem + 65536);
  const int tid = threadIdx.x;
  const int ql = tid >> 1, hp = tid & 1, rot = (tid >> 1) & 3;
  for (int it2 = 0; it2 < 2; ++it2) {
    const int item0 = it2 ? (511 - (int)blockIdx.x) : (int)blockIdx.x;
    for (int item = item0; item >= 0 && item < 512; item += (it2 ? -(int)gridDim.x : (int)gridDim.x)) {
      if (it2 == 0 && item >= 256) break;
      if (it2 == 1 && item < 256) break;
      const int h = item & 7, qb = item >> 3;
      const int t = qb * 256 + ql;
      const uint4* qp = (const uint4*)(qh + ((size_t)h * T + t) * 64) + 4 * hp;
      const uint4 q0 = qp[(0 + rot) & 3], q1 = qp[(1 + rot) & 3], q2 = qp[(2 + rot) & 3], q3 = qp[(3 + rot) & 3];
      const float nshift = -0.5f * qsh[(size_t)h * T + t];
      float acc[32];
#pragma unroll
      for (int i = 0; i < 32; ++i) acc[i] = 0.f;
      float lsum = 0.f;
      const int nsel = (t + 1 < 256) ? (t + 1) : 256;
      const bool dense = t < 256;
      const uint4* sp = (const uint4*)(sel + (size_t)t * 256);
      u16* const win = (u16*)(smem + 131072) + ql * 32;
      int ptr = 0, wbase = 0;
      const int nchunks = (qb >> 1) + 1;
      const int o0 = 4 * hp + ((0 + rot) & 3), o1 = 4 * hp + ((1 + rot) & 3), o2 = 4 * hp + ((2 + rot) & 3), o3 = 4 * hp + ((3 + rot) & 3);
      uint4 t0, t1, t2, t3, t4, t5, t6, t7, u0, u1, u2, u3, u4, u5, u6, u7, wv0, wv1;
#define ATT_CLOAD(cc) do { \
        const uint4* kg = (const uint4*)(kh + ((size_t)h * T + (cc) * 512) * 64) + tid; \
        const uint4* vg = (const uint4*)(vh + ((size_t)h * T + (cc) * 512) * 64) + tid; \
        t0 = kg[0]; t1 = kg[512]; t2 = kg[1024]; t3 = kg[1536]; t4 = kg[2048]; t5 = kg[2560]; t6 = kg[3072]; t7 = kg[3584]; \
        u0 = vg[0]; u1 = vg[512]; u2 = vg[1024]; u3 = vg[1536]; u4 = vg[2048]; u5 = vg[2560]; u6 = vg[3072]; u7 = vg[3584]; } while (0)
#define ATT_WLOAD() do { const int wi_ = (wbase >> 3) + 2 * hp; wv0 = sp[wi_ < 31 ? wi_ : 31]; wv1 = sp[wi_ + 1 < 31 ? wi_ + 1 : 31]; } while (0)
#define ATT_WSTORE() do { *(uint4*)(win + 16 * hp) = wv0; *(uint4*)(win + 16 * hp + 8) = wv1; } while (0)
      ATT_CLOAD(0);
      ATT_WLOAD();
      for (int c = 0; c < nchunks; ++c) {
        PROF_T0(3)
        __syncthreads();
        {
          uint4* dk = sK + tid; uint4* dv = sV + tid;
          dk[0] = t0; dk[512] = t1; dk[1024] = t2; dk[1536] = t3; dk[2048] = t4; dk[2560] = t5; dk[3072] = t6; dk[3584] = t7;
          dv[0] = u0; dv[512] = u1; dv[1024] = u2; dv[1536] = u3; dv[2048] = u4; dv[2560] = u5; dv[3072] = u6; dv[3584] = u7;
          ATT_WSTORE();
        }
        __syncthreads();
        PROF_T1(3)
        PROF_T0(4)
        if (c + 1 < nchunks) ATT_CLOAD(c + 1);
        const int cbase = c * 512, cend = cbase + 512;
        int nextidx = dense ? ptr : (int)win[ptr - wbase];
        while (ptr < nsel && nextidx < cend) {
          const int lk = nextidx - cbase;
          const uint4* krow = sK + lk * 8;
          const uint4* vrow = sV + lk * 8;
          ++ptr;
          int nidx2 = ptr;
          if (!dense) {
            if (ptr - wbase >= 32) { wbase = ptr & ~7; ATT_WLOAD(); ATT_WSTORE(); }
            nidx2 = (int)win[ptr - wbase];
          }
          float d = nshift;
#define ATT_DOT(Q, O) { const uint4 kv = krow[O]; d = dot2h(Q.x, kv.x, d); d = dot2h(Q.y, kv.y, d); d = dot2h(Q.z, kv.z, d); d = dot2h(Q.w, kv.w, d); }
          ATT_DOT(q0, o0) ATT_DOT(q1, o1) ATT_DOT(q2, o2) ATT_DOT(q3, o3)
          d += dpp_xor1(d);
          const float pe = __builtin_amdgcn_exp2f(d);
          lsum += pe;
#define ATT_MIX(A, W) do { asm volatile("v_fma_mix_f32 %0, %2, %3, %0 op_sel_hi:[0,1,0]\n\tv_fma_mix_f32 %1, %2, %3, %1 op_sel:[0,1,0] op_sel_hi:[0,1,0]" \
            : "+v"(acc[A]), "+v"(acc[(A) + 1]) : "v"(pe), "v"(W)); } while (0)
#define ATT_PV(J, O) { const uint4 vv4 = vrow[O]; ATT_MIX(8 * J + 0, vv4.x); ATT_MIX(8 * J + 2, vv4.y); ATT_MIX(8 * J + 4, vv4.z); ATT_MIX(8 * J + 6, vv4.w); }
          ATT_PV(0, o0) ATT_PV(1, o1) ATT_PV(2, o2) ATT_PV(3, o3)
          nextidx = nidx2;
        }
        PROF_T1(4)
        if (!dense) { wbase = ptr & ~7; ATT_WLOAD(); }
      }
#undef ATT_CLOAD
#undef ATT_WLOAD
#undef ATT_WSTORE
      const float inv = 1.f / lsum;
      u16* orow = mix + (size_t)t * 1024 + h * 64;
#define ATT_OUT(J, O) { uint4 o; o.x = pack2bf(acc[8 * J] * inv, acc[8 * J + 1] * inv); o.y = pack2bf(acc[8 * J + 2] * inv, acc[8 * J + 3] * inv); \
        o.z = pack2bf(acc[8 * J + 4] * inv, acc[8 * J + 5] * inv); o.w = pack2bf(acc[8 * J + 6] * inv, acc[8 * J + 7] * inv); *(uint4*)(orow + (O) * 8) = o; }
      ATT_OUT(0, o0) ATT_OUT(1, o1) ATT_OUT(2, o2) ATT_OUT(3, o3)
    }
  }
}

__device__ void phase_gemm_out(const Params& p, char* smem) {
  g8::SchedDense S{(const char*)(p.ws + OFF_MIX), (const char*)(p.ws + OFF_WOUTT), 1024, T / 256, 4, (T / 256) * 4, (int)gridDim.x, (int)blockIdx.x};
  g8::EpiF32 E{(float*)(p.ws + OFF_H1), p.x, 1024};
  g8::gemm_phase<g8::SchedDense, g8::EpiF32, false>((LAS unsigned char*)smem, 1024, S, E, nullptr);
}

__device__ void phase_router(const Params& p, char* smem) {
  const float* h1 = (const float*)(p.ws + OFF_H1);
  u16* xn2 = (u16*)(p.ws + OFF_XN);
  int* toke = (int*)(p.ws + OFF_TOKE); float* tokg = (float*)(p.ws + OFF_TOKG); int* tokp = (int*)(p.ws + OFF_TOKP);
  int* cnt = (int*)(p.ws + OFF_CNT);
  const int tid = threadIdx.x, lane = tid & 63, wid = tid >> 6;
  const int e = lane & 31, kh = lane >> 5;
  float* xs = (float*)smem;
  float* part = (float*)(smem + 65536);
  float wreg[64];
  {
    const int k0 = wid * 128 + kh * 64;
#pragma unroll
    for (int j = 0; j < 64; ++j) wreg[j] = p.router_w[(size_t)(k0 + j) * 32 + e] * p.norm2_w[k0 + j];
  }
  const float rb = p.router_b[e];
  float4 nw4[4];
#pragma unroll
  for (int i = 0; i < 4; ++i) nw4[i] = ((const float4*)p.norm2_w)[lane + 64 * i];
  for (int b0 = blockIdx.x * 16; b0 < T; b0 += gridDim.x * 16) {
    float4 va[4], vb[4];
    {
      const float4* hra = (const float4*)(h1 + (size_t)(b0 + wid * 2) * D);
      const float4* hrb = hra + D / 4;
#pragma unroll
      for (int i = 0; i < 4; ++i) { va[i] = hra[lane + 64 * i]; vb[i] = hrb[lane + 64 * i]; }
    }
    __syncthreads();
    float ssa = 0.f, ssb = 0.f;
#pragma unroll
    for (int i = 0; i < 4; ++i) {
      ssa += va[i].x * va[i].x + va[i].y * va[i].y + va[i].z * va[i].z + va[i].w * va[i].w;
      ssb += vb[i].x * vb[i].x + vb[i].y * vb[i].y + vb[i].z * vb[i].z + vb[i].w * vb[i].w;
    }
#pragma unroll
    for (int o = 32; o >= 1; o >>= 1) { ssa += __shfl_xor(ssa, o); ssb += __shfl_xor(ssb, o); }
    const float rsa = rsqrtf(ssa * (1.f / D) + 1e-6f), rsb = rsqrtf(ssb * (1.f / D) + 1e-6f);
#pragma unroll
    for (int i = 0; i < 4; ++i) {
      const float4 w = nw4[i];
      const float4 ya = make_float4(va[i].x * rsa, va[i].y * rsa, va[i].z * rsa, va[i].w * rsa);
      const float4 yb = make_float4(vb[i].x * rsb, vb[i].y * rsb, vb[i].z * rsb, vb[i].w * rsb);
      *(float4*)(xs + (wid * 2) * 1024 + (lane + 64 * i) * 4) = ya;
      *(float4*)(xs + (wid * 2 + 1) * 1024 + (lane + 64 * i) * 4) = yb;
      uint2 oa, ob; oa.x = pack2bf(ya.x * w.x, ya.y * w.y); oa.y = pack2bf(ya.z * w.z, ya.w * w.w);
      ob.x = pack2bf(yb.x * w.x, yb.y * w.y); ob.y = pack2bf(yb.z * w.z, yb.w * w.w);
      *(uint2*)(xn2 + (size_t)(b0 + wid * 2) * D + (lane + 64 * i) * 4) = oa;
      *(uint2*)(xn2 + (size_t)(b0 + wid * 2 + 1) * D + (lane + 64 * i) * 4) = ob;
    }
    __syncthreads();
    for (int tl = 0; tl < 16; ++tl) {
      const f32x4* xr = (const f32x4*)(xs + tl * 1024 + wid * 128 + kh * 64);
      float a0 = 0.f, a1 = 0.f, a2 = 0.f, a3 = 0.f;
#pragma unroll
      for (int j = 0; j < 16; ++j) {
        const f32x4 x4 = xr[j];
        a0 += x4[0] * wreg[4 * j]; a1 += x4[1] * wreg[4 * j + 1]; a2 += x4[2] * wreg[4 * j + 2]; a3 += x4[3] * wreg[4 * j + 3];
      }
      float a = (a0 + a1) + (a2 + a3);
      a += __shfl_xor(a, 32);
      if (lane < 32) part[(tl * 8 + wid) * 32 + e] = a;
    }
    __syncthreads();
    {
      const int tl = wid * 2 + kh, t = b0 + tl;
      float val = rb;
#pragma unroll
      for (int w = 0; w < 8; ++w) val += part[(tl * 8 + w) * 32 + e];
      float tv[4]; int te[4];
#pragma unroll
      for (int k = 0; k < 4; ++k) {
        float bv = val; int bi = e;
#pragma unroll
        for (int off = 16; off >= 1; off >>= 1) {
          float ov = __shfl_xor(bv, off); int oi = __shfl_xor(bi, off);
          if (ov > bv || (ov == bv && oi < bi)) { bv = ov; bi = oi; }
        }
        tv[k] = bv; te[k] = bi;
        if (e == bi) val = -INFINITY;
      }
      const float m = tv[0];
      float ex[4], s = 0.f;
#pragma unroll
      for (int k = 0; k < 4; ++k) { ex[k] = __expf(tv[k] - m); s += ex[k]; }
      if (e < 4) {
        const int ee = (e == 0) ? te[0] : (e == 1) ? te[1] : (e == 2) ? te[2] : te[3];
        const float gg = ((e == 0) ? ex[0] : (e == 1) ? ex[1] : (e == 2) ? ex[2] : ex[3]) / s;
        const int pos = atomicAdd(&cnt[ee], 1);
        toke[(size_t)t * 4 + e] = ee; tokg[(size_t)t * 4 + e] = gg; tokp[(size_t)t * 4 + e] = pos;
      }
    }
  }
}

__device__ __forceinline__ int expert_tstart(const int* cnt, int e) {
  int s = 0;
  for (int i = 0; i < e; ++i) s += (cnt[i] + 255) >> 8;
  return s;
}

__device__ __forceinline__ int* moe_tile_starts(const Params& p, char* smem) {
  int* ts = (int*)(smem + SM_TAIL + 64);
  const int* cnt = (const int*)(p.ws + OFF_CNT);
  __syncthreads();
  if (threadIdx.x <= NE) ts[threadIdx.x] = expert_tstart(cnt, threadIdx.x);
  __syncthreads();
  return ts;
}

__device__ void phase_fill_rows(const Params& p, char* smem) {
  const int* toke = (const int*)(p.ws + OFF_TOKE); const int* tokp = (const int*)(p.ws + OFF_TOKP);
  int* rowtok = (int*)(p.ws + OFF_ROWTOK);
  const int* ts = moe_tile_starts(p, smem);
  int gtid = blockIdx.x * NTHREADS + threadIdx.x, gsz = gridDim.x * NTHREADS;
  for (int i = gtid; i < T * 4; i += gsz) rowtok[ts[toke[i]] * 256 + tokp[i]] = i >> 2;
}

__device__ void phase_gemm_gu(const Params& p, char* smem) {
  const int* ts = moe_tile_starts(p, smem);
  g8::SchedMoE<8, true> S{(const char*)(p.ws + OFF_XN), (const char*)(p.ws + OFF_WGUT), 1024, ts, (int)gridDim.x, (int)blockIdx.x};
  g8::EpiGU E{(u16*)(p.ws + OFF_Z), p.exp_b_gu};
  g8::gemm_phase<g8::SchedMoE<8, true>, g8::EpiGU, true>((LAS unsigned char*)smem, 1024, S, E, (const int*)(p.ws + OFF_ROWTOK));
}

__device__ void phase_gemm_dn(const Params& p, char* smem) {
  const int* ts = moe_tile_starts(p, smem);
  g8::SchedMoE<4, false> S{(const char*)(p.ws + OFF_Z), (const char*)(p.ws + OFF_WDNT), 1024, ts, (int)gridDim.x, (int)blockIdx.x};
  g8::EpiDN E{(u16*)(p.ws + OFF_SV), p.exp_b_down};
  g8::gemm_phase<g8::SchedMoE<4, false>, g8::EpiDN, false>((LAS unsigned char*)smem, 1024, S, E, nullptr);
}

__device__ void phase_combine(const Params& p, char* smem) {
  const int* toke = (const int*)(p.ws + OFF_TOKE); const float* tokg = (const float*)(p.ws + OFF_TOKG); const int* tokp = (const int*)(p.ws + OFF_TOKP);
  const float* h1 = (const float*)(p.ws + OFF_H1); const u16* yb = (const u16*)(p.ws + OFF_SV);
  const int* ts = moe_tile_starts(p, smem);
  const int tid = threadIdx.x;
  const int sub = tid & 127, tl = tid >> 7;
  for (int t0 = blockIdx.x * 4; t0 < T; t0 += gridDim.x * 4) {
    const int t = t0 + tl;
    float4 a = *(const float4*)(h1 + (size_t)t * D + sub * 8), b = *(const float4*)(h1 + (size_t)t * D + sub * 8 + 4);
    float o[8] = {a.x, a.y, a.z, a.w, b.x, b.y, b.z, b.w};
#pragma unroll
    for (int k = 0; k < 4; ++k) {
      const int e = toke[t * 4 + k]; const float gte = tokg[t * 4 + k];
      const size_t row = (size_t)ts[e] * 256 + tokp[t * 4 + k];
      uint4 w = *(const uint4*)(yb + row * 1024 + sub * 8);
      u32 ww[4] = {w.x, w.y, w.z, w.w};
#pragma unroll
      for (int i = 0; i < 4; ++i) { o[2 * i] += gte * __uint_as_float(ww[i] << 16); o[2 * i + 1] += gte * __uint_as_float(ww[i] & 0xFFFF0000u); }
    }
    *(float4*)(p.out + (size_t)t * D + sub * 8) = make_float4(o[0], o[1], o[2], o[3]);
    *(float4*)(p.out + (size_t)t * D + sub * 8 + 4) = make_float4(o[4], o[5], o[6], o[7]);
  }
}

enum { PH_INIT = 0, PH_PREP, PH_GEMM_IN, PH_POST, PH_SCAN_A, PH_TOPK, PH_SCAN_B, PH_SCAN_C, PH_ATTN, PH_RWKV_OUT, PH_GEMM_OUT, PH_ROUTER, PH_FILL, PH_GEMM_GU, PH_GEMM_DN, PH_COMBINE, PH_COUNT };

template <int PH>
__device__ __forceinline__ void run_phase(const Params& p, char* smem) {
  if (PH == PH_INIT) { phase_init(p); phase_norm1(p); }
  if (PH == PH_PREP) {
    transpose_convert(p.w_in, (u16*)(p.ws + OFF_WINT), 1024, DIN, DINP, 1, smem, blockIdx.x, gridDim.x);
    transpose_convert(p.w_out, (u16*)(p.ws + OFF_WOUTT), 1024, 1024, 1024, 1, smem, blockIdx.x, gridDim.x);
  }
  if (PH == PH_GEMM_IN) phase_gemm_in(p, smem);
  if (PH == PH_POST) { phase_post_attn(p); phase_post_rwkv(p, smem); }
  if (PH == PH_SCAN_A) phase_scan_a(p, smem);
  if (PH == PH_TOPK) phase_topk(p, smem);
  if (PH == PH_SCAN_B) { }
  if (PH == PH_SCAN_C) phase_scan_c(p, smem);
  if (PH == PH_ATTN) phase_attn(p, smem);
  if (PH == PH_RWKV_OUT) phase_rwkv_out(p);
  if (PH == PH_GEMM_OUT) phase_gemm_out(p, smem);
  if (PH == PH_ROUTER) phase_router(p, smem);
  if (PH == PH_FILL) phase_fill_rows(p, smem);
  if (PH == PH_GEMM_GU) phase_gemm_gu(p, smem);
  if (PH == PH_GEMM_DN) phase_gemm_dn(p, smem);
  if (PH == PH_COMBINE) phase_combine(p, smem);
}

#ifndef FUSED
#define FUSED 1
#endif

template <int PH>
__global__ void __launch_bounds__(NTHREADS) phase_kernel(Params p) {
  extern __shared__ __attribute__((aligned(16))) char smem[];
  run_phase<PH>(p, smem);
}

__host__ __device__ constexpr bool barrier_after(int ph) { return !(ph == PH_INIT || ph == PH_SCAN_B || ph == PH_SCAN_C); }

template <int PH>
__device__ __forceinline__ void run_from(const Params& p, char* smem, cg::grid_group& grid, const XcdBarrier& xb) {
#ifdef REPEAT_PH
  if constexpr (PH == REPEAT_PH) { run_phase<PH>(p, smem); xcd_barrier(xb); }
#endif
  run_phase<PH>(p, smem);
  if constexpr (PH + 1 < PH_COUNT) {
    if constexpr (barrier_after(PH)) xcd_barrier(xb);
    else __syncthreads();
    run_from<PH + 1>(p, smem, grid, xb);
  }
}

__global__ void __launch_bounds__(NTHREADS) fwd_megakernel(Params p) {
  extern __shared__ __attribute__((aligned(16))) char smem[];
  uint4& xb_words = *(uint4*)(smem + SM_TAIL);
  cg::grid_group grid = cg::this_grid();
  if (threadIdx.x == 0) { xb_words = make_uint4(0u, 0u, 0u, 0u); g_prof = 0ull; }
  __syncthreads();
  XcdBarrier xb = xcd_barrier_post((unsigned*)(p.ws + OFF_BAR), (volatile LAS unsigned*)&xb_words);
  if (p.ws == nullptr) grid.sync();
  run_from<0>(p, smem, grid, xb);
  if (PROBE_ID != 0 && blockIdx.x == PROF_BLOCK && threadIdx.x == 0) {
    const unsigned long long t0 = __builtin_amdgcn_s_memrealtime(), w = g_prof * PROF_AMP;
    while (__builtin_amdgcn_s_memrealtime() - t0 < w) __builtin_amdgcn_s_sleep(8);
  }
}

template <int PH>
static void launch_phase(const Params& p, int grid, hipStream_t stream) {
  static bool attr_set = false;
  if (!attr_set) { (void)hipFuncSetAttribute((const void*)phase_kernel<PH>, hipFuncAttributeMaxDynamicSharedMemorySize, LDS_BYTES); attr_set = true; }
  hipLaunchKernelGGL(phase_kernel<PH>, dim3(grid), dim3(NTHREADS), LDS_BYTES, stream, p);
}

template <int PH>
static void launch_all(const Params& p, int grid, hipStream_t stream) {
  launch_phase<PH>(p, grid, stream);
  if constexpr (PH + 1 < PH_COUNT) launch_all<PH + 1>(p, grid, stream);
}

extern "C" void kernel_launch(void* const* d_in, const int* in_sizes, int n_in, void* d_out, int out_size, void* d_ws, size_t ws_size,
                              hipStream_t stream) {
  if (ws_size < WS_NEEDED) { fprintf(stderr, "workspace too small: %zu < %zu\n", ws_size, (size_t)WS_NEEDED); return; }
  Params p{};
  p.x = (const float*)d_in[0]; p.positions = (const int*)d_in[1]; p.norm1_w = (const float*)d_in[2]; p.w_in = (const float*)d_in[3];
  p.q_norm_w = (const float*)d_in[4]; p.k_norm_w = (const float*)d_in[5]; p.rwkv_mu = (const float*)d_in[6]; p.rwkv_w0 = (const float*)d_in[7];
  p.rwkv_w2 = (const float*)d_in[8]; p.rwkv_a0 = (const float*)d_in[9]; p.rwkv_a2 = (const float*)d_in[10]; p.rwkv_g2 = (const float*)d_in[11];
  p.rwkv_k_k = (const float*)d_in[12]; p.rwkv_k_a = (const float*)d_in[13]; p.rwkv_r_k = (const float*)d_in[14]; p.rwkv_ln_w = (const float*)d_in[15];
  p.rwkv_ln_b = (const float*)d_in[16]; p.w_out = (const float*)d_in[17]; p.norm2_w = (const float*)d_in[18]; p.router_w = (const float*)d_in[19];
  p.router_b = (const float*)d_in[20]; p.exp_w_gu = (const float*)d_in[21]; p.exp_b_gu = (const float*)d_in[22]; p.exp_w_down = (const float*)d_in[23];
  p.exp_b_down = (const float*)d_in[24];
  p.out = (float*)d_out; p.ws = (char*)d_ws;
#if FUSED
  static int grid_blocks = 0;
  if (!grid_blocks) {
    (void)hipFuncSetAttribute((const void*)fwd_megakernel, hipFuncAttributeMaxDynamicSharedMemorySize, LDS_BYTES);
    int dev = 0, cus = 0, per_cu = 0;
    (void)hipGetDevice(&dev);
    (void)hipDeviceGetAttribute(&cus, hipDeviceAttributeMultiprocessorCount, dev);
    (void)hipOccupancyMaxActiveBlocksPerMultiprocessor(&per_cu, fwd_megakernel, NTHREADS, LDS_BYTES);
    if (per_cu < 1) { fprintf(stderr, "occupancy query returned %d\n", per_cu); per_cu = 1; }
    grid_blocks = cus;
  }
  (void)hipMemsetAsync((char*)d_ws + OFF_BAR, 0, 16384, stream);
  void* args[] = {(void*)&p};
  hipError_t e = hipLaunchCooperativeKernel((void*)fwd_megakernel, dim3(grid_blocks), dim3(NTHREADS), args, LDS_BYTES, stream);
  if (e != hipSuccess) fprintf(stderr, "cooperative launch failed: %s (grid %d)\n", hipGetErrorString(e), grid_blocks);
#else
  launch_all<0>(p, 256, stream);
#endif
}
```

```cpp
#include <hip/hip_runtime.h>
#include <hip/hip_bf16.h>
#include <hip/hip_fp16.h>
#include <hip/hip_cooperative_groups.h>
#include <stdint.h>
#include <stdio.h>
namespace cg = cooperative_groups;

typedef unsigned short u16;
typedef unsigned int u32;
using bf16x8 = __attribute__((ext_vector_type(8))) short;
using f32x4 = __attribute__((ext_vector_type(4))) float;
using f32x16 = __attribute__((ext_vector_type(16))) float;

constexpr int T = 16384, D = 1024, DIN = 3496, DINP = 3584;
constexpr int NCH = 128, CHL = T / NCH;
constexpr int NE = 32, DFF = 1024;
constexpr int ROWCAP = 73728;
constexpr int C_Q = 0, C_K = 512, C_V = 1024, C_IQ = 1536, C_IK = 1792, C_IW = 1824, C_RW = 1832;
constexpr int NTHREADS = 512;
constexpr int LDS_BYTES = 159 * 1024;

constexpr size_t SZ_WGUT = (size_t)NE * 2048 * 1024 * 2;
constexpr size_t SZ_WDNT = (size_t)NE * 1024 * 1024 * 2;
constexpr size_t SZ_WINT = (size_t)DINP * 1024 * 2;
constexpr size_t SZ_WOUTT = (size_t)1024 * 1024 * 2;
constexpr size_t SZ_XN = (size_t)T * 1024 * 2;
constexpr size_t SZ_Z = (size_t)T * DINP * 4;
constexpr size_t SZ_QKV = (size_t)T * 512 * 2;
constexpr size_t SZ_IQ = (size_t)T * 256 * 2;
constexpr size_t SZ_IK = (size_t)T * 32 * 2;
constexpr size_t SZ_IW = (size_t)T * 8 * 4;
constexpr size_t SZ_SV = (size_t)T * 8 * 384 * 4;
constexpr size_t SZ_G = (size_t)T * 512 * 4;
constexpr size_t SZ_BONUS = (size_t)T * 8 * 4;
constexpr size_t SZ_Y = (size_t)T * 512 * 4;
constexpr size_t SZ_SMAT = (size_t)8 * NCH * 4096 * 4;
constexpr size_t SZ_SEL = (size_t)T * 256 * 2;
constexpr size_t SZ_MIX = (size_t)T * 1024 * 2;
constexpr size_t SZ_H1 = (size_t)T * 1024 * 4;
constexpr size_t SZ_TOK = (size_t)T * 4 * 4;
constexpr size_t SZ_ROWTOK = (size_t)ROWCAP * 4;

constexpr size_t OFF_WGUT = 0;
constexpr size_t OFF_WDNT = OFF_WGUT + SZ_WGUT;
constexpr size_t OFF_WINT = OFF_WDNT + SZ_WDNT;
constexpr size_t OFF_WOUTT = OFF_WINT + SZ_WINT;
constexpr size_t OFF_XN = OFF_WOUTT + SZ_WOUTT;
constexpr size_t OFF_Z = OFF_XN + SZ_XN;
constexpr size_t OFF_QR = OFF_Z + SZ_Z;
constexpr size_t OFF_KR = OFF_QR + SZ_QKV;
constexpr size_t OFF_VV = OFF_KR + SZ_QKV;
constexpr size_t OFF_IQ = OFF_VV + SZ_QKV;
constexpr size_t OFF_IK = OFF_IQ + SZ_IQ;
constexpr size_t OFF_IW = OFF_IK + SZ_IK;
constexpr size_t OFF_SV = OFF_IW + SZ_IW;
constexpr size_t OFF_G = OFF_SV + SZ_SV;
constexpr size_t OFF_BONUS = OFF_G + SZ_G;
constexpr size_t OFF_Y = OFF_BONUS + SZ_BONUS;
constexpr size_t OFF_SP = OFF_Y + SZ_Y;
constexpr size_t OFF_SL = OFF_SP + SZ_SMAT;
constexpr size_t OFF_SI = OFF_SL + SZ_SMAT;
constexpr size_t OFF_SEL = OFF_SI + SZ_SMAT;
constexpr size_t OFF_MIX = OFF_SEL + SZ_SEL;
constexpr size_t OFF_H1 = OFF_MIX + SZ_MIX;
constexpr size_t OFF_TOKE = OFF_H1 + SZ_H1;
constexpr size_t OFF_TOKG = OFF_TOKE + SZ_TOK;
constexpr size_t OFF_TOKP = OFF_TOKG + SZ_TOK;
constexpr size_t OFF_ROWTOK = OFF_TOKP + SZ_TOK;
constexpr size_t OFF_CNT = OFF_ROWTOK + SZ_ROWTOK;
constexpr size_t OFF_QSH = OFF_CNT + 4096;
constexpr size_t OFF_BAR = OFF_QSH + (size_t)T * 8 * 4;
constexpr size_t WS_NEEDED = OFF_BAR + 16384;

struct Params {
  const float* x; const int* positions; const float* norm1_w; const float* w_in;
  const float* q_norm_w; const float* k_norm_w; const float* rwkv_mu; const float* rwkv_w0;
  const float* rwkv_w2; const float* rwkv_a0; const float* rwkv_a2; const float* rwkv_g2;
  const float* rwkv_k_k; const float* rwkv_k_a; const float* rwkv_r_k; const float* rwkv_ln_w;
  const float* rwkv_ln_b; const float* w_out; const float* norm2_w; const float* router_w;
  const float* router_b; const float* exp_w_gu; const float* exp_b_gu; const float* exp_w_down;
  const float* exp_b_down;
  float* out;
  char* ws;
};

__device__ __forceinline__ u16 f2bf(float f) {
  u32 u = __float_as_uint(f);
  u += 0x7FFFu + ((u >> 16) & 1u);
  return (u16)(u >> 16);
}
__device__ __forceinline__ float bf2f(u16 h) { return __uint_as_float(((u32)h) << 16); }
__device__ __forceinline__ u32 pack2bf(float a, float b) { return (u32)f2bf(a) | ((u32)f2bf(b) << 16); }
__device__ __forceinline__ float wave_sum(float v) {
#pragma unroll
  for (int o = 32; o >= 1; o >>= 1) v += __shfl_xor(v, o);
  return v;
}
__device__ __forceinline__ float sigmoidf_(float x) { return 1.f / (1.f + __expf(-x)); }

__device__ __forceinline__ void sincos_big(float ang, float& s, float& c) {
  double a = (double)ang * 0.15915494309189535;
  double r = a - rint(a);
  float rf = (float)r;
  s = __builtin_amdgcn_sinf(rf);
  c = __builtin_amdgcn_cosf(rf);
}


#define XB_TMO      128
#define XB_XCNT(j)  (256  + 64 * (j))
#define XB_XSUB(j)  (1280 + 64 * (j))
#define XB_XGEN(j)  (2304 + 64 * (j))
#define XB_TOP      3328
#define XB_TOPGEN   3392
#define XCD_BAR_WORDS 3456
#define XB_SPIN_CAP (1u << 22)
#define LAS __attribute__((address_space(3)))
__device__ __forceinline__ unsigned xb_ld(unsigned* p)              { return __hip_atomic_load(p, __ATOMIC_RELAXED, __HIP_MEMORY_SCOPE_AGENT); }
__device__ __forceinline__ unsigned xb_add(unsigned* p, unsigned v) { return __hip_atomic_fetch_add(p, v, __ATOMIC_RELAXED, __HIP_MEMORY_SCOPE_AGENT); }
__device__ __forceinline__ unsigned xb_xcc_id() { return (unsigned)__builtin_amdgcn_s_getreg((3 << 11) | 20) & 0xFu; }
#define XB_SPIN(cond, bar) do { unsigned _sp = 0; while (cond) { __builtin_amdgcn_s_sleep(1); \
    if ((++_sp & 255u) == 0u) { if (xb_ld(&(bar)[XB_TMO])) break; if (_sp > XB_SPIN_CAP) { atomicAdd(&(bar)[XB_TMO], 1u); break; } } } } while (0)
struct XcdBarrier { unsigned* bar; unsigned x; volatile LAS unsigned* st; };
__device__ __forceinline__ XcdBarrier xcd_barrier_post(unsigned* bar, volatile LAS unsigned* st) {
  XcdBarrier b; b.bar = bar; b.x = xb_xcc_id(); b.st = st;
  if (threadIdx.x == 0) (void)xb_add(&bar[XB_XCNT(b.x)], 1u);
  return b;
}
__device__ __forceinline__ void xcd_barrier_complete(unsigned* bar, unsigned x, unsigned& nloc, unsigned& nx) {
  const unsigned G = gridDim.x * gridDim.y * gridDim.z;
  unsigned sum, cnt, mine, sp = 0u;
  for (;;) {
    sum = 0u; cnt = 0u; mine = 0u;
#pragma unroll
    for (unsigned j = 0; j < 16; ++j) { const unsigned c = xb_ld(&bar[XB_XCNT(j)]); sum += c; cnt += (c > 0u) ? 1u : 0u; mine = (j == x) ? c : mine; }
    if (sum == G) break;
    __builtin_amdgcn_s_sleep(1);
    if ((++sp & 255u) == 0u) { if (xb_ld(&bar[XB_TMO])) break; if (sp > XB_SPIN_CAP) { atomicAdd(&bar[XB_TMO], 1u); break; } }
  }
  nloc = mine > 0u ? mine : 1u; nx = cnt > 0u ? cnt : 1u;
}
__device__ __forceinline__ void xcd_barrier(const XcdBarrier& b) {
  asm volatile("s_waitcnt vmcnt(0)" ::: "memory");
  __syncthreads();
  if (threadIdx.x == 0) {
    unsigned* bar = b.bar;
    __builtin_amdgcn_s_waitcnt(0);
    unsigned nloc = b.st[0], nx = b.st[1];
    if (nloc == 0u) { xcd_barrier_complete(bar, b.x, nloc, nx); b.st[0] = nloc; b.st[1] = nx; }
    const unsigned old = xb_add(&bar[XB_XSUB(b.x)], 1u);
    const unsigned gen = old / nloc;
    if (old + 1u == (gen + 1u) * nloc) {
      __builtin_amdgcn_fence(__ATOMIC_RELEASE, "agent");
      asm volatile("s_waitcnt vmcnt(0)" ::: "memory");
      const unsigned og = xb_add(&bar[XB_TOP], 1u);
      const unsigned tg = og / nx;
      if (og + 1u == (tg + 1u) * nx) xb_add(&bar[XB_TOPGEN], 1u);
      else XB_SPIN(xb_ld(&bar[XB_TOPGEN]) == tg, bar);
      __builtin_amdgcn_fence(__ATOMIC_ACQUIRE, "agent");
      xb_add(&bar[XB_XGEN(b.x)], 1u);
      asm volatile("s_waitcnt vmcnt(0)" ::: "memory");
    } else {
      XB_SPIN(xb_ld(&bar[XB_XGEN(b.x)]) == gen, bar);
      __builtin_amdgcn_fence(__ATOMIC_ACQUIRE, "agent");
      asm volatile("s_waitcnt vmcnt(0)" ::: "memory");
    }
  }
  __syncthreads();
}


#ifndef PROBE_ID
#define PROBE_ID 0
#endif
#define PROF_BLOCK 100
#define PROF_AMP 4
#define g_prof (*(unsigned long long*)(smem + 157 * 1024 + 16))
#define PROF_T0(id) unsigned long long _pt0_##id = 0; if (PROBE_ID == (id) && blockIdx.x == PROF_BLOCK && threadIdx.x == 0) _pt0_##id = __builtin_amdgcn_s_memrealtime();
#define PROF_T1(id) if (PROBE_ID == (id) && blockIdx.x == PROF_BLOCK && threadIdx.x == 0) g_prof += __builtin_amdgcn_s_memrealtime() - _pt0_##id;

__device__ void phase_init(const Params& p) {
  int* cnt = (int*)(p.ws + OFF_CNT);
  int* rowtok = (int*)(p.ws + OFF_ROWTOK);
  int gtid = blockIdx.x * NTHREADS + threadIdx.x;
  int gsz = gridDim.x * NTHREADS;
  if (gtid < 64) cnt[gtid] = 0;
  for (int i = gtid; i < ROWCAP; i += gsz) rowtok[i] = -1;
}

__device__ void transpose_convert(const float* src, u16* dst, int R, int C, int Cpad, int nbatch, char* smem, int bid, int nblk) {
  float* tile = (float*)smem;
  int tr = R / 64, tc = Cpad / 64;
  int ntile = tr * tc * nbatch;
  int tid = threadIdx.x;
  for (int id = bid; id < ntile; id += nblk) {
    int b = id / (tr * tc), rem = id % (tr * tc);
    int r0 = (rem / tc) * 64, c0 = (rem % tc) * 64;
    const float* s = src + (size_t)b * R * C;
    u16* d = dst + (size_t)b * Cpad * R;
#pragma unroll
    for (int i = 0; i < 8; ++i) {
      int r = (tid >> 6) + 8 * i, c = tid & 63;
      float v = (c0 + c < C) ? s[(size_t)(r0 + r) * C + c0 + c] : 0.f;
      tile[r * 65 + c] = v;
    }
    __syncthreads();
    {
      int cc = tid >> 3, rg = tid & 7;
      u32 w[4];
#pragma unroll
      for (int i = 0; i < 4; ++i) w[i] = pack2bf(tile[(rg * 8 + 2 * i) * 65 + cc], tile[(rg * 8 + 2 * i + 1) * 65 + cc]);
      uint4 o; o.x = w[0]; o.y = w[1]; o.z = w[2]; o.w = w[3];
      *(uint4*)(d + (size_t)(c0 + cc) * R + r0 + rg * 8) = o;
    }
    __syncthreads();
  }
}

__device__ void phase_norm1(const Params& p) {
  u16* xn = (u16*)(p.ws + OFF_XN);
  int lane = threadIdx.x & 63, wid = threadIdx.x >> 6;
  int gw = blockIdx.x * 8 + wid, nw = gridDim.x * 8;
  for (int t = gw; t < T; t += nw) {
    const float4* xr = (const float4*)(p.x + (size_t)t * D);
    float4 v[4]; float ss = 0.f;
#pragma unroll
    for (int i = 0; i < 4; ++i) { v[i] = xr[lane + 64 * i]; ss += v[i].x * v[i].x + v[i].y * v[i].y + v[i].z * v[i].z + v[i].w * v[i].w; }
    ss = wave_sum(ss);
    float rstd = rsqrtf(ss * (1.f / D) + 1e-6f);
#pragma unroll
    for (int i = 0; i < 4; ++i) {
      float4 w = ((const float4*)p.norm1_w)[lane + 64 * i];
      uint2 o; o.x = pack2bf(v[i].x * rstd * w.x, v[i].y * rstd * w.y); o.y = pack2bf(v[i].z * rstd * w.z, v[i].w * rstd * w.w);
      *(uint2*)(xn + (size_t)t * D + (lane + 64 * i) * 4) = o;
    }
  }
}

namespace g8 {
constexpr int BM = 256, BK = 64, HALF = 128, HTB = HALF * BK * 2, STAGE_BYTES = 8 * HTB;
__device__ __forceinline__ int lds_byte(int r, int c) { const int st = (r >> 4) * 2 + (c >> 5), rr = r & 15, cc = c & 31, ob = rr * 64 + cc * 2; return st * 1024 + (ob ^ (((ob >> 9) & 1) << 5)); }
__device__ __forceinline__ void stage_rc(int b, int& R, int& C) { const int st = b / 1024, sb = b % 1024, swz = sb ^ (((sb >> 9) & 1) << 5); R = (st >> 1) * 16 + swz / 64; C = (st & 1) * 32 + (swz % 64) / 2; }

struct Unit {
  const char* A;
  const char* B;
  unsigned hstepB;
  int row0;
  int col0;
  int aux;
};

template <class Sched, class Epi, bool GATHER>
__device__ __forceinline__ void gemm_phase(LAS unsigned char* lds, const int K, const Sched& S, const Epi& E, const int* __restrict__ rowtok) {
  const int tid = threadIdx.x, wid = __builtin_amdgcn_readfirstlane(tid >> 6), lane = tid & 63, wr = wid >> 2, wc = wid & 3, fr = lane & 15, fq = lane >> 4;
  const int nt = K / BK;
  int R0, C0, R1, C1;
  stage_rc(tid * 16, R0, C0); stage_rc(tid * 16 + 8192, R1, C1);
  const unsigned voffB0 = (unsigned)(R0 * K + C0) * 2u, voffB1 = (unsigned)(R1 * K + C1) * 2u;
  unsigned ac00, ac01, ac10, ac11, an00, an01, an10, an11;
#define G8_AOFF(u, o00, o01, o10, o11) do { \
    if (GATHER) { int t00 = rowtok[(u).row0 + R0], t01 = rowtok[(u).row0 + R1], t10 = rowtok[(u).row0 + HALF + R0], t11 = rowtok[(u).row0 + HALF + R1]; \
      t00 = t00 < 0 ? 0 : t00; t01 = t01 < 0 ? 0 : t01; t10 = t10 < 0 ? 0 : t10; t11 = t11 < 0 ? 0 : t11; \
      o00 = (unsigned)(t00 * K + C0) * 2u; o01 = (unsigned)(t01 * K + C1) * 2u; o10 = (unsigned)(t10 * K + C0) * 2u; o11 = (unsigned)(t11 * K + C1) * 2u; } \
    else { o00 = (unsigned)(R0 * K + C0) * 2u; o01 = (unsigned)(R1 * K + C1) * 2u; o10 = (unsigned)((HALF + R0) * K + C0) * 2u; o11 = (unsigned)((HALF + R1) * K + C1) * 2u; } } while (0)
  const size_t kstep = (size_t)(BK * 2);
  const unsigned ldsw = (unsigned)wid * 1024u;
  const int aoff = lds_byte(wr * 64 + fr, fq * 8), boff = lds_byte(wc * 32 + fr, fq * 8);
#define G8_SA(b, h) (((b) * 2 + (h)) * HTB)
#define G8_SB(b, h) ((4 + (b) * 2 + (h)) * HTB)
#define G8_STAGE(bufoff, gbase, v0, v1) do { \
    __builtin_amdgcn_global_load_lds((const unsigned*)((const char*)(gbase) + (v0)), (LAS unsigned*)(lds + (bufoff) + ldsw), 16, 0, 0); \
    __builtin_amdgcn_global_load_lds((const unsigned*)((const char*)(gbase) + (v1)), (LAS unsigned*)(lds + (bufoff) + ldsw + 8192), 16, 0, 0); } while (0)
#define G8_LDA(dst, b, h) do { _Pragma("unroll") for (int m = 0; m < 4; ++m) _Pragma("unroll") for (int k = 0; k < 2; ++k) dst[m][k] = *(const LAS bf16x8*)(lds + G8_SA(b, h) + aoff + m * 2048 + k * 1024); } while (0)
#define G8_LDB(dst, b, h) do { _Pragma("unroll") for (int n = 0; n < 2; ++n) _Pragma("unroll") for (int k = 0; k < 2; ++k) dst[n][k] = *(const LAS bf16x8*)(lds + G8_SB(b, h) + boff + n * 2048 + k * 1024); } while (0)
#define G8_MMA(ai, bj, At_, Bt_) do { __builtin_amdgcn_s_setprio(1); _Pragma("unroll") for (int m = 0; m < 4; ++m) _Pragma("unroll") for (int n = 0; n < 2; ++n) _Pragma("unroll") for (int k = 0; k < 2; ++k) \
    acc[ai][bj][m][n] = __builtin_amdgcn_mfma_f32_16x16x32_bf16(Bt_[n][k], At_[m][k], acc[ai][bj][m][n], 0, 0, 0); __builtin_amdgcn_s_setprio(0); } while (0)
#define G8_WAIT_V(n) asm volatile("s_waitcnt vmcnt(" #n ")" ::: "memory")
#define G8_WAIT_L(n) asm volatile("s_waitcnt lgkmcnt(" #n ")" ::: "memory")
#define G8_BAR __builtin_amdgcn_s_barrier()
#define G8_SCHED __builtin_amdgcn_sched_barrier(0)
  Unit cur, nxt; int ui = 0;
  if (!S.next(0, cur)) return;
  f32x4 acc[2][2][4][2];
#pragma unroll
  for (int a = 0; a < 2; ++a)
#pragma unroll
    for (int b = 0; b < 2; ++b)
#pragma unroll
      for (int m = 0; m < 4; ++m)
#pragma unroll
        for (int n = 0; n < 2; ++n) acc[a][b][m][n] = (f32x4){0.f, 0.f, 0.f, 0.f};
  bf16x8 At[4][2], B0[2][2], B1[2][2];
  const char* cA = cur.A; const char* cB = cur.B; unsigned chB = cur.hstepB;
  G8_AOFF(cur, ac00, ac01, ac10, ac11);
  an00 = ac00; an01 = ac01; an10 = ac10; an11 = ac11;
  G8_STAGE(G8_SB(0, 0), cB, voffB0, voffB1); G8_STAGE(G8_SA(0, 0), cA, ac00, ac01); G8_STAGE(G8_SB(0, 1), cB + chB, voffB0, voffB1); G8_STAGE(G8_SA(0, 1), cA, ac10, ac11);
  if (wr == 1) G8_BAR;
  G8_WAIT_V(4); G8_BAR;
  G8_STAGE(G8_SB(1, 0), cB + kstep, voffB0, voffB1); G8_STAGE(G8_SA(1, 0), cA + kstep, ac00, ac01); G8_STAGE(G8_SB(1, 1), cB + chB + kstep, voffB0, voffB1);
  G8_WAIT_V(6); G8_BAR;
  for (;;) {
    const bool has_next = S.next(ui + 1, nxt);
    const char* nA = has_next ? nxt.A : cA; const char* nB = has_next ? nxt.B : cB; const unsigned nhB = has_next ? nxt.hstepB : chB;
    if (GATHER) { if (has_next) G8_AOFF(nxt, an00, an01, an10, an11); else { an00 = ac00; an01 = ac01; an10 = ac10; an11 = ac11; } }
    for (int t = 0; t < nt; t += 2) {
      const bool last = (t == nt - 2);
      const char* a1 = cA + (size_t)(t + 1) * kstep;
      const char* a2 = last ? nA : cA + (size_t)(t + 2) * kstep; const char* b2 = last ? nB : cB + (size_t)(t + 2) * kstep;
      const char* a3 = a2 + kstep; const char* b3 = b2 + kstep;
      const unsigned hb2 = last ? nhB : chB;
      const unsigned x00 = last ? an00 : ac00, x01 = last ? an01 : ac01, x10 = last ? an10 : ac10, x11 = last ? an11 : ac11;
      G8_LDB(B0, 0, 0); G8_SCHED; G8_LDA(At, 0, 0); G8_STAGE(G8_SA(1, 1), a1, ac10, ac11);
      G8_WAIT_L(8); G8_BAR; G8_WAIT_L(0); G8_MMA(0, 0, At, B0); G8_BAR; G8_SCHED;
      G8_LDB(B1, 0, 1); G8_STAGE(G8_SB(0, 0), b2, voffB0, voffB1);
      G8_BAR; G8_WAIT_L(0); G8_MMA(0, 1, At, B1); G8_BAR;
      G8_LDA(At, 0, 1); G8_STAGE(G8_SA(0, 0), a2, x00, x01);
      G8_BAR; G8_WAIT_L(0); G8_MMA(1, 0, At, B0); G8_BAR; G8_SCHED;
      G8_STAGE(G8_SB(0, 1), b2 + hb2, voffB0, voffB1);
      G8_WAIT_V(6); G8_BAR; G8_MMA(1, 1, At, B1); G8_BAR;
      G8_LDB(B0, 1, 0); G8_SCHED; G8_LDA(At, 1, 0); G8_STAGE(G8_SA(0, 1), a2, x10, x11);
      G8_WAIT_L(8); G8_BAR; G8_WAIT_L(0); G8_MMA(0, 0, At, B0); G8_BAR; G8_SCHED;
      G8_LDB(B1, 1, 1); G8_STAGE(G8_SB(1, 0), b3, voffB0, voffB1);
      G8_BAR; G8_WAIT_L(0); G8_MMA(0, 1, At, B1); G8_BAR;
      G8_LDA(At, 1, 1); G8_STAGE(G8_SA(1, 0), a3, x00, x01);
      G8_BAR; G8_WAIT_L(0); G8_MMA(1, 0, At, B0); G8_BAR; G8_SCHED;
      G8_STAGE(G8_SB(1, 1), b3 + hb2, voffB0, voffB1);
      G8_WAIT_V(6); G8_BAR; G8_MMA(1, 1, At, B1); G8_BAR;
    }
    E(acc, cur, wr, wc, fr, fq);
    if (!has_next) break;
#pragma unroll
    for (int a = 0; a < 2; ++a)
#pragma unroll
      for (int b = 0; b < 2; ++b)
#pragma unroll
        for (int m = 0; m < 4; ++m)
#pragma unroll
          for (int n = 0; n < 2; ++n) acc[a][b][m][n] = (f32x4){0.f, 0.f, 0.f, 0.f};
    cur = nxt; cA = nA; cB = nB; chB = nhB; ++ui;
    ac00 = an00; ac01 = an01; ac10 = an10; ac11 = an11;
  }
  G8_WAIT_V(0);
  if (wr == 0) G8_BAR;
  G8_BAR;
#undef G8_AOFF
#undef G8_SA
#undef G8_SB
#undef G8_STAGE
#undef G8_LDA
#undef G8_LDB
#undef G8_MMA
#undef G8_WAIT_V
#undef G8_WAIT_L
#undef G8_BAR
#undef G8_SCHED
}

struct SchedDense {
  const char* A; const char* Bt; int K, nM, nN, nwg, G, c;
  __device__ __forceinline__ bool next(int i, Unit& u) const {
    const int L = i * G + c; if (L >= nwg) return false;
    int wgid = L; { const int q = nwg / 8, r = nwg % 8, xcd = wgid % 8, off = wgid / 8; wgid = (xcd < r ? xcd * (q + 1) : r * (q + 1) + (xcd - r) * q) + off; }
    const int nig = 8 * nN, gid = wgid / nig, fm = gid * 8, gsz = (nM - fm) < 8 ? (nM - fm) : 8;
    const int pm = fm + ((wgid % nig) % gsz), pn = (wgid % nig) / gsz;
    u.A = A + (size_t)pm * BM * K * 2; u.B = Bt + (size_t)pn * BM * K * 2; u.hstepB = (unsigned)(HALF * K * 2);
    u.row0 = pm * BM; u.col0 = pn * BM; u.aux = 0; return true;
  }
};
template <int NCOLT, bool GU>
struct SchedMoE {
  const char* A; const char* W; int K; const int* ts; int G, c;
  __device__ __forceinline__ bool next(int i, Unit& u) const {
    const int id = i * G + c; const int ntiles = ts[NE];
    if (id >= ntiles * NCOLT) return false;
    const int tile = id / NCOLT, pn = id % NCOLT;
    int e = 0;
    while (e < NE - 1 && ts[e + 1] <= tile) ++e;
    u.row0 = tile * BM; u.aux = e;
    if (GU) { u.A = A; u.B = W + ((size_t)e * 2048 + pn * 128) * K * 2; u.hstepB = (unsigned)(1024 * K * 2); u.col0 = pn * 128; }
    else { u.A = A + (size_t)tile * BM * K * 2; u.B = W + ((size_t)e * 1024 + pn * 256) * K * 2; u.hstepB = (unsigned)(HALF * K * 2); u.col0 = pn * 256; }
    return true;
  }
};

struct EpiF32 {
  float* C; const float* resid; int ldc;
  __device__ __forceinline__ void operator()(const f32x4 (&acc)[2][2][4][2], const Unit& u, int wr, int wc, int fr, int fq) const {
    const int row0 = u.row0 + wr * 64 + fr, col0 = u.col0 + wc * 32 + 4 * fq;
#pragma unroll
    for (int ai = 0; ai < 2; ++ai)
#pragma unroll
      for (int m = 0; m < 4; ++m) {
        const size_t ro = (size_t)(row0 + ai * HALF + m * 16) * ldc + col0;
#pragma unroll
        for (int bj = 0; bj < 2; ++bj)
#pragma unroll
          for (int n = 0; n < 2; ++n) {
            f32x4 v = acc[ai][bj][m][n];
            if (resid) v += *(const f32x4*)(resid + ro + bj * HALF + n * 16);
            *(f32x4*)(C + ro + bj * HALF + n * 16) = v;
          }
      }
  }
};
struct EpiGU {
  u16* O; const float* bias_all;
  __device__ __forceinline__ void operator()(const f32x4 (&acc)[2][2][4][2], const Unit& u, int wr, int wc, int fr, int fq) const {
    const float* bias = bias_all + (size_t)u.aux * 2048;
    const int row0 = u.row0 + wr * 64 + fr, col0 = u.col0 + wc * 32 + 4 * fq;
    f32x4 bg[2], bl[2];
#pragma unroll
    for (int n = 0; n < 2; ++n) { bg[n] = *(const f32x4*)(bias + col0 + n * 16); bl[n] = *(const f32x4*)(bias + 1024 + col0 + n * 16); }
#pragma unroll
    for (int ai = 0; ai < 2; ++ai)
#pragma unroll
      for (int m = 0; m < 4; ++m) {
        u16* rowp = O + (size_t)(row0 + ai * HALF + m * 16) * 1024 + col0;
#pragma unroll
        for (int n = 0; n < 2; ++n) {
          const f32x4 g4 = acc[ai][0][m][n] + bg[n], l4 = acc[ai][1][m][n] + bl[n];
          float a[4];
#pragma unroll
          for (int j = 0; j < 4; ++j) {
            const float glu = fminf(g4[j], 7.f), lin = fminf(fmaxf(l4[j], -7.f), 7.f);
            a[j] = (lin + 1.f) * glu * (1.f / (1.f + __expf(-1.702f * glu)));
          }
          uint2 w; w.x = pack2bf(a[0], a[1]); w.y = pack2bf(a[2], a[3]);
          *(uint2*)(rowp + n * 16) = w;
        }
      }
  }
};
struct EpiDN {
  u16* O; const float* bias_all;
  __device__ __forceinline__ void operator()(const f32x4 (&acc)[2][2][4][2], const Unit& u, int wr, int wc, int fr, int fq) const {
    const float* bias = bias_all + (size_t)u.aux * 1024;
    const int row0 = u.row0 + wr * 64 + fr, col0 = u.col0 + wc * 32 + 4 * fq;
    f32x4 bv[2][2];
#pragma unroll
    for (int bj = 0; bj < 2; ++bj)
#pragma unroll
      for (int n = 0; n < 2; ++n) bv[bj][n] = *(const f32x4*)(bias + col0 + bj * HALF + n * 16);
#pragma unroll
    for (int ai = 0; ai < 2; ++ai)
#pragma unroll
      for (int m = 0; m < 4; ++m) {
        u16* rowp = O + (size_t)(row0 + ai * HALF + m * 16) * 1024 + col0;
#pragma unroll
        for (int bj = 0; bj < 2; ++bj)
#pragma unroll
          for (int n = 0; n < 2; ++n) {
            const f32x4 v = acc[ai][bj][m][n] + bv[bj][n];
            uint2 w; w.x = pack2bf(v[0], v[1]); w.y = pack2bf(v[2], v[3]);
            *(uint2*)(rowp + bj * HALF + n * 16) = w;
          }
      }
  }
};
}

constexpr int SM_TAIL = 157 * 1024;
__device__ void phase_gemm_in(const Params& p, char* smem) {
  g8::SchedDense S{(const char*)(p.ws + OFF_XN), (const char*)(p.ws + OFF_WINT), D, T / 256, DINP / 256, (T / 256) * (DINP / 256), (int)gridDim.x, (int)blockIdx.x};
  g8::EpiF32 E{(float*)(p.ws + OFF_Z), nullptr, DINP};
  g8::gemm_phase<g8::SchedDense, g8::EpiF32, false>((LAS unsigned char*)smem, D, S, E, nullptr);
}

__device__ void phase_post_attn(const Params& p) {
  const float* z = (const float*)(p.ws + OFF_Z);
  u16* qr = (u16*)(p.ws + OFF_QR); u16* kr = (u16*)(p.ws + OFF_KR); u16* vv = (u16*)(p.ws + OFF_VV);
  u16* iq = (u16*)(p.ws + OFF_IQ); u16* ik = (u16*)(p.ws + OFF_IK); float* iw = (float*)(p.ws + OFF_IW);
  const float INVF8[8] = {1.0f, 0.1939227432012558f, 0.03760603070259094f, 0.007292664609849453f,
                          0.0014142135623842478f, 0.00027424818836152554f, 5.318296098266728e-05f, 1.0313386155758053e-05f};
  const float INVF4[4] = {1.0f, 0.03760603070259094f, 0.0014142135623842478f, 5.318296098266728e-05f};
  int lane = threadIdx.x & 63, wid = threadIdx.x >> 6;
  int gw = blockIdx.x * 8 + wid, nw = gridDim.x * 8;
  const int sub = lane & 7;
  float* qsh = (float*)(p.ws + OFF_QSH);
  float kwmax = fabsf(p.k_norm_w[lane]);
#pragma unroll
  for (int o = 32; o >= 1; o >>= 1) kwmax = fmaxf(kwmax, __shfl_xor(kwmax, o));
  for (int t = gw; t < T; t += nw) {
    const float* zr = z + (size_t)t * DINP;
    const float pos = (float)p.positions[t];
    float cs8[8], sn8[8];
#pragma unroll
    for (int i = 0; i < 8; ++i) sincos_big(pos * INVF8[i], sn8[i], cs8[i]);
#pragma unroll
    for (int which = 0; which < 2; ++which) {
      const float* src = zr + (which ? C_K : C_Q) + lane * 8;
      const float* nw_ = (which ? p.k_norm_w : p.q_norm_w) + sub * 8;
      float4 a = *(const float4*)src, b = *(const float4*)(src + 4);
      float v[8] = {a.x, a.y, a.z, a.w, b.x, b.y, b.z, b.w};
      float ss = 0.f;
#pragma unroll
      for (int i = 0; i < 8; ++i) ss += v[i] * v[i];
      ss += __shfl_xor(ss, 1); ss += __shfl_xor(ss, 2); ss += __shfl_xor(ss, 4);
      float rstd = rsqrtf(ss * (1.f / 64.f) + 1e-6f);
      float y[8], o[8];
#pragma unroll
      for (int i = 0; i < 8; ++i) y[i] = v[i] * rstd * nw_[i];
#pragma unroll
      for (int i = 0; i < 8; ++i) {
        float oth = __shfl_xor(y[i], 1);
        float r0 = y[i] * cs8[i] - oth * sn8[i];
        float r1 = y[i] * cs8[i] + oth * sn8[i];
        o[i] = (sub == 0) ? r0 : ((sub == 1) ? r1 : y[i]);
      }
      const float sc = which ? 1.f : (0.125f * 1.4426950408889634f);
      u32 hw[4]; float n2 = 0.f;
#pragma unroll
      for (int i = 0; i < 4; ++i) {
        __half h0 = __float2half_rn(o[2 * i] * sc), h1 = __float2half_rn(o[2 * i + 1] * sc);
        float f0 = __half2float(h0), f1 = __half2float(h1);
        n2 += f0 * f0 + f1 * f1;
        hw[i] = (u32)__half_as_ushort(h0) | ((u32)__half_as_ushort(h1) << 16);
      }
      uint4 w; w.x = hw[0]; w.y = hw[1]; w.z = hw[2]; w.w = hw[3];
      const int hd = lane >> 3;
      *(uint4*)((which ? kr : qr) + ((size_t)hd * T + t) * 64 + sub * 8) = w;
      if (which == 0) {
        n2 += __shfl_xor(n2, 1); n2 += __shfl_xor(n2, 2); n2 += __shfl_xor(n2, 4);
        if (sub == 0) qsh[(size_t)hd * T + t] = sqrtf(n2) * 8.f * kwmax * 1.01f;
      }
    }
    {
      const float* src = zr + C_V + lane * 8;
      float4 a = *(const float4*)src, b = *(const float4*)(src + 4);
      float v[8] = {a.x, a.y, a.z, a.w, b.x, b.y, b.z, b.w};
      u32 hw[4];
#pragma unroll
      for (int i = 0; i < 4; ++i) hw[i] = (u32)__half_as_ushort(__float2half_rn(v[2 * i])) | ((u32)__half_as_ushort(__float2half_rn(v[2 * i + 1])) << 16);
      uint4 w; w.x = hw[0]; w.y = hw[1]; w.z = hw[2]; w.w = hw[3];
      *(uint4*)(vv + ((size_t)(lane >> 3) * T + t) * 64 + sub * 8) = w;
    }
    float cs4[4], sn4[4];
#pragma unroll
    for (int i = 0; i < 4; ++i) sincos_big(pos * INVF4[i], sn4[i], cs4[i]);
    {
      float4 a = *(const float4*)(zr + C_IQ + lane * 4);
      float y[4] = {a.x, a.y, a.z, a.w}, o[4];
#pragma unroll
      for (int i = 0; i < 4; ++i) {
        float oth = __shfl_xor(y[i], 1);
        float r0 = y[i] * cs4[i] - oth * sn4[i];
        float r1 = y[i] * cs4[i] + oth * sn4[i];
        o[i] = (sub == 0) ? r0 : ((sub == 1) ? r1 : y[i]);
      }
      uint2 w; w.x = pack2bf(o[0], o[1]); w.y = pack2bf(o[2], o[3]);
      *(uint2*)(iq + (size_t)t * 256 + lane * 4) = w;
    }
    {
      float4 a = (lane < 8) ? *(const float4*)(zr + C_IK + lane * 4) : make_float4(0, 0, 0, 0);
      float y[4] = {a.x, a.y, a.z, a.w}, o[4];
#pragma unroll
      for (int i = 0; i < 4; ++i) {
        float oth = __shfl_xor(y[i], 1);
        float r0 = y[i] * cs4[i] - oth * sn4[i];
        float r1 = y[i] * cs4[i] + oth * sn4[i];
        o[i] = (sub == 0) ? r0 : ((sub == 1) ? r1 : y[i]);
      }
      if (lane < 8) {
        uint2 w; w.x = pack2bf(o[0], o[1]); w.y = pack2bf(o[2], o[3]);
        *(uint2*)(ik + (size_t)(t >> 5) * 1024 + (size_t)(((lane >> 2) * 2 + ((lane >> 1) & 1)) * 256 + (t & 31) * 8 + (lane & 1) * 4)) = w;
        iw[(size_t)t * 8 + lane] = zr[C_IW + lane];
      }
    }
  }
}

__device__ void phase_post_rwkv(const Params& p, char* smem) {
  const float* z = (const float*)(p.ws + OFF_Z);
  float* sv = (float*)(p.ws + OFF_SV); float* G = (float*)(p.ws + OFF_G); float* BON = (float*)(p.ws + OFF_BONUS);
  float* lora = (float*)smem;
  const int tid = threadIdx.x, lane = tid & 63, h = tid >> 6, c = tid;
  const float mu_r = p.rwkv_mu[c], mu_k = p.rwkv_mu[512 + c], mu_v = p.rwkv_mu[1024 + c];
  const float w0 = p.rwkv_w0[c], a0 = p.rwkv_a0[c], kkw = p.rwkv_k_k[c], kaw = p.rwkv_k_a[c], rkw = p.rwkv_r_k[c];
  float wr2[32], ar2[32], gr2[64];
#pragma unroll
  for (int j = 0; j < 32; ++j) { wr2[j] = p.rwkv_w2[j * 512 + c]; ar2[j] = p.rwkv_a2[j * 512 + c]; }
#pragma unroll
  for (int j = 0; j < 64; ++j) gr2[j] = p.rwkv_g2[j * 512 + c];
  for (int tg = blockIdx.x; tg < T / 8; tg += gridDim.x) {
    const int t0 = tg * 8;
#pragma unroll
    for (int i = 0; i < 2; ++i) {
      int item = tid + 512 * i, tok = item >> 7, j = item & 127, t = t0 + tok;
      int col = C_RW + 1536 + j;
      float zc = z[(size_t)t * DINP + col];
      float zp = (t > 0) ? z[(size_t)(t - 1) * DINP + col] : 0.f;
      float xs = zc + (zp - zc) * p.rwkv_mu[1536 + j];
      float o = (j < 32) ? tanhf(xs) : ((j < 64) ? xs : sigmoidf_(xs));
      lora[tok * 128 + j] = o;
    }
    __syncthreads();
    float zr9[9], zk9[9], zv9[9];
#pragma unroll
    for (int k = 0; k < 9; ++k) {
      const int t = t0 - 1 + k;
      if (t >= 0) { const float* zp_ = z + (size_t)t * DINP + C_RW; zr9[k] = zp_[c]; zk9[k] = zp_[512 + c]; zv9[k] = zp_[1024 + c]; }
      else { zr9[k] = 0.f; zk9[k] = 0.f; zv9[k] = 0.f; }
    }
#pragma unroll
    for (int k = 0; k < 8; ++k) {
      const f32x4* lr = (const f32x4*)(lora + k * 128);
      float w0_ = 0.f, w1_ = 0.f, a0_ = 0.f, a1_ = 0.f, g0_ = 0.f, g1_ = 0.f;
#pragma unroll
      for (int j = 0; j < 8; ++j) {
        const f32x4 lw = lr[j];
        w0_ += lw[0] * wr2[4 * j] + lw[2] * wr2[4 * j + 2]; w1_ += lw[1] * wr2[4 * j + 1] + lw[3] * wr2[4 * j + 3];
      }
      asm volatile("" : "+v"(w0_), "+v"(w1_) :: "memory");
#pragma unroll
      for (int j = 0; j < 8; ++j) {
        const f32x4 la = lr[8 + j];
        a0_ += la[0] * ar2[4 * j] + la[2] * ar2[4 * j + 2]; a1_ += la[1] * ar2[4 * j + 1] + la[3] * ar2[4 * j + 3];
      }
      asm volatile("" : "+v"(a0_), "+v"(a1_) :: "memory");
#pragma unroll
      for (int j = 0; j < 8; ++j) {
        const f32x4 lg = lr[16 + j];
        g0_ += lg[0] * gr2[4 * j] + lg[2] * gr2[4 * j + 2]; g1_ += lg[1] * gr2[4 * j + 1] + lg[3] * gr2[4 * j + 3];
      }
      asm volatile("" : "+v"(g0_), "+v"(g1_) :: "memory");
#pragma unroll
      for (int j = 8; j < 16; ++j) {
        const f32x4 lg = lr[16 + j];
        g0_ += lg[0] * gr2[4 * j] + lg[2] * gr2[4 * j + 2]; g1_ += lg[1] * gr2[4 * j + 1] + lg[3] * gr2[4 * j + 3];
      }
      asm volatile("" : "+v"(g0_), "+v"(g1_) :: "memory");
      const float aw_k = w0_ + w1_, aa_k = a0_ + a1_, ag_k = g0_ + g1_;
      const int t = t0 + k;
      const float rc = zr9[k + 1], kc = zk9[k + 1], vc = zv9[k + 1];
      const float rp = zr9[k], kp = zk9[k], vp = zv9[k];
      float r = rc + (rp - rc) * mu_r, kx = kc + (kp - kc) * mu_k, v = vc + (vp - vc) * mu_v;
      float xw = -(w0 + aw_k);
      float sp = fmaxf(xw, 0.f) + log1pf(__expf(-fabsf(xw)));
      float logw = -sp - 0.5f;
      float decay = __expf(-__expf(logw));
      float a = sigmoidf_(a0 + aa_k);
      float kk = kx * kkw;
      float ss = wave_sum(kk * kk);
      kk *= rsqrtf(fmaxf(ss, 1e-24f));
      float kmod = kx * (1.f + (a - 1.f) * kaw);
      float bon = wave_sum(r * kmod * rkw);
      float* o = sv + ((size_t)t * 8 + h) * 384 + lane;
      o[0] = decay; o[64] = kk; o[128] = kk * a; o[192] = kmod; o[256] = r; o[320] = v;
      G[(size_t)t * 512 + c] = ag_k;
      if (lane == 0) BON[(size_t)t * 8 + h] = bon;
    }
    __syncthreads();
  }
}

typedef float f2 __attribute__((ext_vector_type(2)));
#define SB_ __builtin_amdgcn_sched_barrier(0)
#define PIN16(o) asm volatile("" : "+v"(S2[o+0]), "+v"(S2[o+1]), "+v"(S2[o+2]), "+v"(S2[o+3]), "+v"(S2[o+4]), "+v"(S2[o+5]), "+v"(S2[o+6]), "+v"(S2[o+7]), \
    "+v"(S2[o+8]), "+v"(S2[o+9]), "+v"(S2[o+10]), "+v"(S2[o+11]), "+v"(S2[o+12]), "+v"(S2[o+13]), "+v"(S2[o+14]), "+v"(S2[o+15]) :: "memory")
#define SC_LO(v) ((f2){(v)[0], (v)[1]})
#define SC_HI(v) ((f2){(v)[2], (v)[3]})

__device__ __forceinline__ float dpp_qp1(float v) { return __uint_as_float(__builtin_amdgcn_update_dpp(0u, __float_as_uint(v), 0xB1, 0xF, 0xF, true)); }
__device__ __forceinline__ float dpp_qp2(float v) { return __uint_as_float(__builtin_amdgcn_update_dpp(0u, __float_as_uint(v), 0x4E, 0xF, 0xF, true)); }
__device__ __forceinline__ float red4(float v) { v += dpp_qp1(v); v += dpp_qp2(v); return v; }

#define SCAN_DMA(base, ldsbuf) do { \
    __builtin_amdgcn_global_load_lds((const unsigned*)((base) + go0), (LAS unsigned*)(ldsbuf), 16, 0, 0); \
    __builtin_amdgcn_global_load_lds((const unsigned*)((base) + go1), (LAS unsigned*)((ldsbuf) + 256), 16, 0, 0); \
    __builtin_amdgcn_global_load_lds((const unsigned*)((base) + go2), (LAS unsigned*)((ldsbuf) + 512), 16, 0, 0); \
    __builtin_amdgcn_global_load_lds((const unsigned*)((base) + go3), (LAS unsigned*)((ldsbuf) + 768), 16, 0, 0); \
    __builtin_amdgcn_global_load_lds((const unsigned*)((base) + go4), (LAS unsigned*)((ldsbuf) + 1024), 16, 0, 0); \
    __builtin_amdgcn_global_load_lds((const unsigned*)((base) + go5), (LAS unsigned*)((ldsbuf) + 1280), 16, 0, 0); } while (0)

#define SCV_LD4(V, rec, q) do { const f32x4* rc_ = (const f32x4*)(rec) + (q) + 4 * cb; V[0] = rc_[0]; V[1] = rc_[1]; V[2] = rc_[2]; V[3] = rc_[3]; } while (0)
#define SCV_PAIR(V, jp) (((jp) & 1) ? SC_HI(V[(jp) >> 1]) : SC_LO(V[(jp) >> 1]))

template <int MODE>
__device__ void scan_task(const Params& p, int h, int c, float* wl  ) {
  const int lane = threadIdx.x & 63;
  const int ra = lane >> 2, cb = lane & 3;
  const float* sv = (const float*)(p.ws + OFF_SV);
  f2 S2[32];
  if (MODE == 0) {
#pragma unroll
    for (int i = 0; i < 4; ++i)
#pragma unroll
      for (int jp = 0; jp < 8; ++jp) S2[i * 8 + jp] = (f2){(4 * ra + i == 16 * cb + 2 * jp) ? 1.f : 0.f, (4 * ra + i == 16 * cb + 2 * jp + 1) ? 1.f : 0.f};
  } else if (MODE == 1) {
#pragma unroll
    for (int j = 0; j < 32; ++j) S2[j] = (f2){0.f, 0.f};
  } else {
    const float* si = (const float*)(p.ws + OFF_SI) + (size_t)(h * NCH + c) * 4096 + (4 * ra) * 64 + 16 * cb;
#pragma unroll
    for (int i = 0; i < 4; ++i)
#pragma unroll
      for (int q = 0; q < 4; ++q) { const float4 u = *(const float4*)(si + i * 64 + 4 * q); S2[i * 8 + 2 * q] = (f2){u.x, u.y}; S2[i * 8 + 2 * q + 1] = (f2){u.z, u.w}; }
  }
  float* Y = (float*)(p.ws + OFF_Y);
  const float* src = sv + ((size_t)(c * CHL) * 8 + h) * 384;
  const int f0 = lane, f1 = lane + 64, f2_ = lane + 128, f3 = lane + 192, f4 = lane + 256, f5 = lane + 320;
  const int go0 = (f0 / 96) * 3072 + (f0 % 96) * 4, go1 = (f1 / 96) * 3072 + (f1 % 96) * 4, go2 = (f2_ / 96) * 3072 + (f2_ % 96) * 4;
  const int go3 = (f3 / 96) * 3072 + (f3 % 96) * 4, go4 = (f4 / 96) * 3072 + (f4 % 96) * 4, go5 = (f5 / 96) * 3072 + (f5 % 96) * 4;
  SCAN_DMA(src, wl);
  constexpr int NG = CHL / 4;
  f32x4 KK[4], KN[4];
#define SCAN_STEP(KC, KNX, rec, nrec, tstep) do { \
    f32x4 W_[4], B_[4]; \
    SCV_LD4(W_, rec, 0); SCV_LD4(B_, rec, 32); SB_; \
    float d_[4]; \
    _Pragma("unroll") for (int i = 0; i < 4; ++i) { \
      f2 a_ = S2[i * 8] * SCV_PAIR(KC, 0); \
      _Pragma("unroll") for (int jp = 1; jp < 8; ++jp) a_ += S2[i * 8 + jp] * SCV_PAIR(KC, jp); \
      d_[i] = red4(a_[0] + a_[1]); } \
    asm volatile("" : "+v"(d_[0]), "+v"(d_[1]), "+v"(d_[2]), "+v"(d_[3]) :: "memory"); SB_; \
    f32x4 K_[4]; f32x4 R_[4]; f32x4 v4_ = {0.f, 0.f, 0.f, 0.f}; \
    if (MODE != 0) { SCV_LD4(K_, rec, 48); v4_ = ((const f32x4*)(rec))[80 + ra]; } \
    if (MODE == 2) SCV_LD4(R_, rec, 64); \
    if ((nrec) != nullptr) SCV_LD4(KNX, nrec, 16); \
    SB_; \
    _Pragma("unroll") for (int i = 0; i < 4; ++i) { \
      const f2 ns_ = (f2){-d_[i], -d_[i]}; \
      _Pragma("unroll") for (int jp = 0; jp < 8; ++jp) S2[i * 8 + jp] = S2[i * 8 + jp] * SCV_PAIR(W_, jp) + ns_ * SCV_PAIR(B_, jp); } \
    PIN16(0); PIN16(16); SB_; \
    if (MODE != 0) { \
      _Pragma("unroll") for (int i = 0; i < 4; ++i) { \
        const f2 vi_ = (f2){v4_[i], v4_[i]}; \
        _Pragma("unroll") for (int jp = 0; jp < 8; ++jp) S2[i * 8 + jp] += vi_ * SCV_PAIR(K_, jp); } \
      PIN16(0); PIN16(16); SB_; } \
    if (MODE == 2) { \
      float y_ = 0.f; \
      _Pragma("unroll") for (int i = 0; i < 4; ++i) { \
        f2 a_ = S2[i * 8] * SCV_PAIR(R_, 0); \
        _Pragma("unroll") for (int jp = 1; jp < 8; ++jp) a_ += S2[i * 8 + jp] * SCV_PAIR(R_, jp); \
        const float e_ = red4(a_[0] + a_[1]); \
        y_ = (cb == i) ? e_ : y_; } \
      Y[(size_t)(tstep) * 512 + h * 64 + lane] = y_;         \
      SB_; } \
  } while (0)
  for (int g = 0; g < NG; ++g) {
    asm volatile("s_waitcnt vmcnt(0)" ::: "memory");
    if (g + 1 < NG) SCAN_DMA(src + (size_t)(g + 1) * 4 * 3072, wl + ((g + 1) & 1) * 1536);
    const float* Lb = wl + (g & 1) * 1536;
    const int tb = c * CHL + g * 4;
    SCV_LD4(KK, Lb, 16); SB_;
    SCAN_STEP(KK, KN, Lb, Lb + 384, tb);
    SCAN_STEP(KN, KK, Lb + 384, Lb + 768, tb + 1);
    SCAN_STEP(KK, KN, Lb + 768, Lb + 1152, tb + 2);
    SCAN_STEP(KN, KK, Lb + 1152, (const float*)nullptr, tb + 3);
  }
  if (MODE != 2) {
    float* o = (float*)(p.ws + (MODE == 0 ? OFF_SP : OFF_SL)) + (size_t)(h * NCH + c) * 4096 + (4 * ra) * 64 + 16 * cb;
#pragma unroll
    for (int i = 0; i < 4; ++i)
#pragma unroll
      for (int q = 0; q < 4; ++q) *(float4*)(o + i * 64 + 4 * q) = make_float4(S2[i * 8 + 2 * q][0], S2[i * 8 + 2 * q][1], S2[i * 8 + 2 * q + 1][0], S2[i * 8 + 2 * q + 1][1]);
  }
#undef SCAN_STEP
}

__device__ void phase_scan_a(const Params& p, char* smem) {
  const int wid = __builtin_amdgcn_readfirstlane(threadIdx.x >> 6);
  float* wl = (float*)smem + wid * 3072;
  const int nw = gridDim.x * 8;
  for (int id = wid * (int)gridDim.x + (int)blockIdx.x; id < 8 * NCH; id += nw) scan_task<0>(p, id & 7, id >> 3, wl);
  for (int id = wid * (int)gridDim.x + (int)blockIdx.x; id < 16 * NCH; id += nw) { if (id >= 8 * NCH) scan_task<1>(p, id & 7, (id - 8 * NCH) >> 3, wl); }
}

__device__ __forceinline__ float rdlane(float v, int l) { return __uint_as_float(__builtin_amdgcn_readlane(__float_as_uint(v), l)); }

__device__ void scan_b_row(const Params& p, int h, int row, float* pbuf  ) {
  const int lane = threadIdx.x & 63;
  const float* SP = (const float*)(p.ws + OFF_SP) + (size_t)h * NCH * 4096;
  const float* SL = (const float*)(p.ws + OFF_SL) + (size_t)h * NCH * 4096 + row * 64 + lane;
  float* SI = (float*)(p.ws + OFF_SI) + (size_t)h * NCH * 4096 + row * 64 + lane;
  float sreg = 0.f;
  SI[0] = 0.f;
#define SB_DMA(c_, buf_) do { _Pragma("unroll") for (int i_ = 0; i_ < 16; ++i_) \
    __builtin_amdgcn_global_load_lds((const unsigned*)(SP + (size_t)(c_) * 4096 + (i_ * 64 + lane) * 4), (LAS unsigned*)((buf_) + i_ * 256), 16, 0, 0); } while (0)
  float lcur = SL[0];
  SB_DMA(0, pbuf);
  for (int c = 0; c < NCH - 1; ++c) {
    float* cb = pbuf + (c & 1) * 4096;
    float lnext = 0.f;
    if (c + 1 < NCH - 1) {
      lnext = SL[(size_t)(c + 1) * 4096];
      SB_DMA(c + 1, pbuf + ((c + 1) & 1) * 4096);
      asm volatile("s_waitcnt vmcnt(17)" ::: "memory");
    } else {
      asm volatile("s_waitcnt vmcnt(0)" ::: "memory");
    }
    float a0 = lcur, a1 = 0.f, a2 = 0.f, a3 = 0.f;
#pragma unroll
    for (int k = 0; k < 64; k += 4) {
      a0 = __builtin_fmaf(rdlane(sreg, k), cb[k * 64 + lane], a0); a1 = __builtin_fmaf(rdlane(sreg, k + 1), cb[(k + 1) * 64 + lane], a1);
      a2 = __builtin_fmaf(rdlane(sreg, k + 2), cb[(k + 2) * 64 + lane], a2); a3 = __builtin_fmaf(rdlane(sreg, k + 3), cb[(k + 3) * 64 + lane], a3);
    }
    sreg = (a0 + a1) + (a2 + a3);
    SI[(size_t)(c + 1) * 4096] = sreg;
    lcur = lnext;
  }
#undef SB_DMA
}

__device__ void transpose_convert_wave(const float* src, u16* dst, int R, int C, int nbatch, int id0, int id1, int wv, int nwaves) {
  const int lane = threadIdx.x & 63, ng = lane & 15, g = lane >> 4;
  const int tr = R / 64, tc = C / 64;
#pragma unroll 1
  for (int id = id0 + wv; id < id1; id += nwaves) {
    const int b = id / (tr * tc), rem = id % (tr * tc);
    const int r0 = (rem / tc) * 64, c0 = (rem % tc) * 64;
    const float* s = src + (size_t)b * R * C + (size_t)(r0 + 8 * g) * C + c0 + 4 * ng;
    u16* d = dst + (size_t)b * C * R + (size_t)(c0 + 4 * ng) * R + r0 + 8 * g;
#pragma unroll
    for (int hf = 0; hf < 2; ++hf) {
      float4 v[8];
#pragma unroll
      for (int i = 0; i < 8; ++i) v[i] = *(const float4*)(s + (size_t)(hf * 32 + i) * C);
      uint4 o0, o1, o2, o3;
      o0.x = pack2bf(v[0].x, v[1].x); o0.y = pack2bf(v[2].x, v[3].x); o0.z = pack2bf(v[4].x, v[5].x); o0.w = pack2bf(v[6].x, v[7].x);
      o1.x = pack2bf(v[0].y, v[1].y); o1.y = pack2bf(v[2].y, v[3].y); o1.z = pack2bf(v[4].y, v[5].y); o1.w = pack2bf(v[6].y, v[7].y);
      o2.x = pack2bf(v[0].z, v[1].z); o2.y = pack2bf(v[2].z, v[3].z); o2.z = pack2bf(v[4].z, v[5].z); o2.w = pack2bf(v[6].z, v[7].z);
      o3.x = pack2bf(v[0].w, v[1].w); o3.y = pack2bf(v[2].w, v[3].w); o3.z = pack2bf(v[4].w, v[5].w); o3.w = pack2bf(v[6].w, v[7].w);
      *(uint4*)(d + hf * 32) = o0; *(uint4*)(d + (size_t)R + hf * 32) = o1; *(uint4*)(d + (size_t)2 * R + hf * 32) = o2; *(uint4*)(d + (size_t)3 * R + hf * 32) = o3;
    }
  }
}
constexpr int PREP_GU_TILES = NE * 16 * 32, PREP_DN_TILES = NE * 16 * 16, PREP_TILES = PREP_GU_TILES + PREP_DN_TILES;
constexpr int PREP_SPLIT = 0;
__device__ void prep_expert_range(const Params& p, int lo, int hi, int wv, int nwaves) {
  if (lo < PREP_GU_TILES) transpose_convert_wave(p.exp_w_gu, (u16*)(p.ws + OFF_WGUT), 1024, 2048, NE, lo, hi < PREP_GU_TILES ? hi : PREP_GU_TILES, wv, nwaves);
  if (hi > PREP_GU_TILES) {
    const int l2 = (lo > PREP_GU_TILES ? lo : PREP_GU_TILES) - PREP_GU_TILES;
    transpose_convert_wave(p.exp_w_down, (u16*)(p.ws + OFF_WDNT), 1024, 1024, NE, l2, hi - PREP_GU_TILES, wv, nwaves);
  }
}

__device__ void scan_b_block(const Params& p, int h, int rg, float* ring  ) {
  const int lane = threadIdx.x & 63, w = __builtin_amdgcn_readfirstlane(threadIdx.x >> 6);
  const int row = rg * 8 + w;
  const float* SP = (const float*)(p.ws + OFF_SP) + (size_t)h * NCH * 4096;
  const float* SL = (const float*)(p.ws + OFF_SL) + (size_t)h * NCH * 4096 + row * 64 + lane;
  float* SI = (float*)(p.ws + OFF_SI) + (size_t)h * NCH * 4096 + row * 64 + lane;
  float* lring = ring + 3 * 4096 + w * 192;
  float sreg = 0.f;
  SI[0] = 0.f;
#define SBB_DMA(c_, slot_) do { \
    __builtin_amdgcn_global_load_lds((const unsigned*)(SP + (size_t)(c_) * 4096 + ((2 * w) * 64 + lane) * 4), (LAS unsigned*)(ring + (slot_) * 4096 + (2 * w) * 256), 16, 0, 0); \
    __builtin_amdgcn_global_load_lds((const unsigned*)(SP + (size_t)(c_) * 4096 + ((2 * w + 1) * 64 + lane) * 4), (LAS unsigned*)(ring + (slot_) * 4096 + (2 * w + 1) * 256), 16, 0, 0); \
    __builtin_amdgcn_global_load_lds((const unsigned*)(SL + (size_t)(c_) * 4096), (LAS unsigned*)(lring + (slot_) * 64), 4, 0, 0); } while (0)
  constexpr int LASTC = NCH - 2;
  SBB_DMA(0, 0);
  SBB_DMA(1, 1);
  for (int c = 0; c < NCH - 1; ++c) {
    asm volatile("s_waitcnt vmcnt(3)" ::: "memory");
    __builtin_amdgcn_s_barrier();
    const int cn = (c + 2 <= LASTC) ? (c + 2) : LASTC;
    SBB_DMA(cn, (c + 2) % 3);
    const float* cb = ring + (c % 3) * 4096;
    float a0 = lring[(c % 3) * 64 + lane], a1 = 0.f, a2 = 0.f, a3 = 0.f;
#pragma unroll
    for (int k = 0; k < 64; k += 4) {
      a0 = __builtin_fmaf(rdlane(sreg, k), cb[k * 64 + lane], a0); a1 = __builtin_fmaf(rdlane(sreg, k + 1), cb[(k + 1) * 64 + lane], a1);
      a2 = __builtin_fmaf(rdlane(sreg, k + 2), cb[(k + 2) * 64 + lane], a2); a3 = __builtin_fmaf(rdlane(sreg, k + 3), cb[(k + 3) * 64 + lane], a3);
    }
    sreg = (a0 + a1) + (a2 + a3);
    SI[(size_t)(c + 1) * 4096] = sreg;
  }
  asm volatile("s_waitcnt vmcnt(0)" ::: "memory");
  __syncthreads();
#undef SBB_DMA
}

__device__ void phase_scan_c(const Params& p, char* smem) {
  const int wid = __builtin_amdgcn_readfirstlane(threadIdx.x >> 6);
  const int nw = gridDim.x * 4;
  if (wid < 4) {
    float* wl = (float*)smem + wid * 3072;
    for (int id = wid * (int)gridDim.x + (int)blockIdx.x; id < 8 * NCH; id += nw) scan_task<2>(p, id & 7, id >> 3, wl);
  } else {
    prep_expert_range(p, PREP_SPLIT, PREP_TILES, (wid - 4) * (int)gridDim.x + (int)blockIdx.x, nw);
  }
}

__device__ void phase_rwkv_out(const Params& p) {
  const float* Y = (const float*)(p.ws + OFF_Y); const float* sv = (const float*)(p.ws + OFF_SV);
  const float* G = (const float*)(p.ws + OFF_G); const float* BON = (const float*)(p.ws + OFF_BONUS);
  u16* mix = (u16*)(p.ws + OFF_MIX);
  const int tid = threadIdx.x, lane = tid & 63, h = tid >> 6;
  const float lw = p.rwkv_ln_w[tid], lb = p.rwkv_ln_b[tid];
  for (int t = blockIdx.x; t < T; t += gridDim.x) {
    float y = Y[(size_t)t * 512 + tid];
    float mean = wave_sum(y) * (1.f / 64.f);
    float d = y - mean;
    float var = wave_sum(d * d) * (1.f / 64.f);
    float o = d * rsqrtf(var + 64e-5f) * lw + lb;
    float v = sv[((size_t)t * 8 + h) * 384 + 320 + lane];
    o = (o + BON[(size_t)t * 8 + h] * v) * G[(size_t)t * 512 + tid];
    mix[(size_t)t * 1024 + 512 + tid] = f2bf(o);
  }
}

typedef short s16x2 __attribute__((ext_vector_type(2)));
__device__ __forceinline__ float irelu(float x) { return __int_as_float(max(__float_as_int(x), 0)); }
__device__ __forceinline__ u16 score_key(float s) {
  s = fminf(fmaxf(s, -60000.f), 60000.f);
  u16 b = __half_as_ushort(__float2half_rn(s));
  return (b & 0x8000u) ? (u16)(~b) : (u16)(b | 0x8000u);
}

__device__ __forceinline__ void topk_level1(const u32* hq, int lane, u32& Bs, u32& cnt_above) {
  u32 ssum = 0;
#pragma unroll
  for (int d = 0; d < 16; ++d) ssum += hq[16 * lane + d];
  u32 suf = ssum;
#pragma unroll
  for (int off = 1; off < 64; off <<= 1) { u32 o = __shfl_down(suf, off); if (lane + off < 64) suf += o; }
  unsigned long long m = __ballot(suf >= 256u);
  const int Ls = 63 - __clzll(m);
  const u32 above = __shfl(suf, Ls) - __shfl(ssum, Ls);
  const u32 c1 = (lane < 16) ? hq[16 * Ls + lane] : 0u;
  u32 suf2 = c1;
#pragma unroll
  for (int off = 1; off < 16; off <<= 1) { u32 o = __shfl_down(suf2, off); if (lane + off < 64) suf2 += o; }
  unsigned long long m2 = __ballot((lane < 16) && (above + suf2 >= 256u));
  const int js = 63 - __clzll(m2);
  Bs = (u32)(16 * Ls + js);
  cnt_above = above + __shfl(suf2, js) - __shfl(c1, js);
}

constexpr int TK_CAP = 512;
__device__ __forceinline__ u32 topk_candidates(const u16* keys, int n, int c0, int c1, u32 Bs, u32* h2, u16* list, int lane) {
  u32 running = 0;
  for (int it = c0; it < c1; ++it) {
    const int base = it * 512 + lane;
    u32 kv8[8];
#pragma unroll
    for (int e = 0; e < 8; ++e) kv8[e] = keys[base + e * 64];
#pragma unroll
    for (int e = 0; e < 8; ++e) {
      const int idx = base + e * 64;
      const u32 k = kv8[e];
      const u32 bin = k >> 6;
      const bool f = (idx < n) && (bin >= Bs);
      const unsigned long long m = __ballot(f);
      if (m) {
        const u32 r = running + __builtin_amdgcn_mbcnt_hi((u32)(m >> 32), __builtin_amdgcn_mbcnt_lo((u32)m, 0u));
        if (f) {
          if (r < (u32)TK_CAP) list[r] = (u16)idx;
          if (bin == Bs) atomicAdd(&h2[k & 63u], 1u);
        }
        running += (u32)__popcll(m);
      }
    }
  }
  return running;
}

__device__ __forceinline__ void topk_emit(const u16* keys, const u16* list, int cnt, u32 Kstar, u32 need_eq, u32& base_gt, u32& base_eq, u16* selout, int lane) {
  for (int i0 = 0; i0 < cnt; i0 += 64) {
    const int i = i0 + lane;
    const bool v = i < cnt;
    const u32 idx = v ? (u32)list[i] : 0u;
    const u32 k = keys[idx];
    const bool g = v && k > Kstar, q = v && k == Kstar;
    const unsigned long long mg = __ballot(g), me = __ballot(q);
    const u32 gb = base_gt + __builtin_amdgcn_mbcnt_hi((u32)(mg >> 32), __builtin_amdgcn_mbcnt_lo((u32)mg, 0u));
    const u32 eb = base_eq + __builtin_amdgcn_mbcnt_hi((u32)(me >> 32), __builtin_amdgcn_mbcnt_lo((u32)me, 0u));
    if (g) selout[gb + min(eb, need_eq)] = (u16)idx;
    else if (q && eb < need_eq) selout[gb + eb] = (u16)idx;
    base_gt += (u32)__popcll(mg); base_eq += (u32)__popcll(me);
  }
}

__device__ __forceinline__ u32 topk_pass1(const u16* keys, int n, int c0, int c1, u32 Bs, u32* h2, int lane) {
  u32 cg = 0;
  for (int it = c0; it < c1; ++it) {
    const int base = it * 512 + lane * 8;
    uint4 kv = *(const uint4*)(keys + base);
    u32 w[4] = {kv.x, kv.y, kv.z, kv.w};
#pragma unroll
    for (int e = 0; e < 8; ++e) {
      u32 k = (e & 1) ? (w[e >> 1] >> 16) : (w[e >> 1] & 0xFFFFu);
      const bool valid = (base + e < n);
      const u32 bin = k >> 6;
      if (valid && bin == Bs) atomicAdd(&h2[k & 63u], 1u);
      cg += (valid && bin > Bs) ? 1u : 0u;
    }
  }
#pragma unroll
  for (int o = 32; o >= 1; o >>= 1) cg += __shfl_xor(cg, o);
  return cg;
}

__device__ __forceinline__ void topk_pass2(const u16* keys, int n, int c0, int c1, u32 Kstar, u32 need_eq, u32 base_gt, u32 base_eq, u16* selout, int lane) {
  for (int it = c0; it < c1; ++it) {
    const int base = it * 512 + lane * 8;
    uint4 kv = *(const uint4*)(keys + base);
    u32 w[4] = {kv.x, kv.y, kv.z, kv.w};
    bool g[8], q[8];
    u32 lcg = 0, lce = 0, tg = 0, te = 0;
#pragma unroll
    for (int e = 0; e < 8; ++e) {
      u32 k = (e & 1) ? (w[e >> 1] >> 16) : (w[e >> 1] & 0xFFFFu);
      const bool valid = (base + e < n);
      g[e] = valid && k > Kstar; q[e] = valid && k == Kstar;
      const unsigned long long mg = __ballot(g[e]), me = __ballot(q[e]);
      lcg += __builtin_amdgcn_mbcnt_hi((u32)(mg >> 32), __builtin_amdgcn_mbcnt_lo((u32)mg, 0u));
      lce += __builtin_amdgcn_mbcnt_hi((u32)(me >> 32), __builtin_amdgcn_mbcnt_lo((u32)me, 0u));
      tg += __popcll(mg); te += __popcll(me);
    }
    u32 gb = base_gt + lcg, eb = base_eq + lce;
#pragma unroll
    for (int e = 0; e < 8; ++e) {
      if (g[e]) selout[gb + min(eb, need_eq)] = (u16)(base + e);
      else if (q[e] && eb < need_eq) selout[gb + eb] = (u16)(base + e);
      gb += g[e] ? 1u : 0u; eb += q[e] ? 1u : 0u;
    }
    base_gt += tg; base_eq += te;
  }
}

__device__ void phase_topk(const Params& p, char* smem) {
  u16* keys = (u16*)smem;
  u32* hist = (u32*)(smem + 131072);
  u32* hist2 = hist + 4096;
  const u16* iq = (const u16*)(p.ws + OFF_IQ); const u16* ik = (const u16*)(p.ws + OFF_IK);
  const float* iw = (const float*)(p.ws + OFF_IW);
  u16* sel = (u16*)(p.ws + OFF_SEL);
  const int tid = threadIdx.x, lane = tid & 63, wid = tid >> 6;
  const int r = lane & 31, hh = lane >> 5;
  const int ngroups = (T - 256) / 4;
  if (blockIdx.x < 64) scan_b_block(p, blockIdx.x >> 3, blockIdx.x & 7, (float*)smem);
  int* const queue = (int*)(p.ws + OFF_CNT) + 48;
  volatile int* const qslot = (volatile int*)(smem + SM_TAIL + 32);
  for (;;) {
    __syncthreads();
    if (tid == 0) *qslot = atomicAdd(queue, 1);
    __syncthreads();
    const int gq = *qslot;
    if (gq >= ngroups) break;
    const int gsel = ngroups - 1 - gq;
    const int t0 = 256 + gsel * 4;
    for (int i = tid; i < 4096 + 288; i += NTHREADS) hist[i] = 0u;
    __syncthreads();
    PROF_T0(1)
    const u16* iqp = iq + ((size_t)(t0 + (r & 3)) * 8 + (r >> 2)) * 32 + 8 * hh;
    const bf16x8 a0 = *(const bf16x8*)iqp, a1 = *(const bf16x8*)(iqp + 16);
    float wq[16];
#pragma unroll
    for (int i = 0; i < 16; ++i) wq[i] = iw[(size_t)(t0 + (i & 3)) * 8 + 2 * (i >> 2) + hh];
    const int ntiles = (t0 + 4 + 31) >> 5;
#define TK_LOAD(KT, B0, B1) do { if ((KT) < ntiles) { const u16* ikp_ = ik + (size_t)(KT) * 1024 + hh * 256 + r * 8; \
      B0 = *(const bf16x8*)ikp_; B1 = *(const bf16x8*)(ikp_ + 512); } } while (0)
#define TK_TAIL2(SA, SB, LASTT) do { \
      const s16x2 hp_ = __builtin_bit_cast(s16x2, __builtin_amdgcn_cvt_pkrtz(SA, SB)); \
      const s16x2 sh_ = {15, 15}; \
      u32 k2_ = __builtin_bit_cast(u32, hp_) ^ (__builtin_bit_cast(u32, hp_ >> sh_) | 0x80008000u);     \
      if (LASTT) { if (key > t0 + hh) k2_ &= 0xFFFF0000u; if (key > t0 + 2 + hh) k2_ &= 0x0000FFFFu; } \
      keysa[key] = (u16)k2_; keysb[key] = (u16)(k2_ >> 16); \
      if (!(LASTT) || (k2_ & 0xFFFFu)) atomicAdd((u32*)((char*)hista + ((k2_ >> 4) & 0xFFCu)), 1u); \
      if (!(LASTT) || (k2_ >> 16)) atomicAdd((u32*)((char*)histb + ((k2_ >> 20) & 0xFFCu)), 1u); \
    } while (0)
#define TK_PROC(KT, B0, B1) do { \
      const int key = (KT) * 32 + r; \
      f32x16 acc; \
      _Pragma("unroll") for (int i_ = 0; i_ < 16; ++i_) acc[i_] = 0.f; \
      acc = __builtin_amdgcn_mfma_f32_32x32x16_bf16(a0, B0, acc, 0, 0, 0); \
      acc = __builtin_amdgcn_mfma_f32_32x32x16_bf16(a1, B1, acc, 0, 0, 0); \
      float s0 = 0.f, s1 = 0.f, s2 = 0.f, s3 = 0.f; \
      _Pragma("unroll") for (int i_ = 0; i_ < 16; i_ += 4) { \
        s0 = __builtin_fmaf(wq[i_], irelu(acc[i_]), s0); s1 = __builtin_fmaf(wq[i_ + 1], irelu(acc[i_ + 1]), s1); \
        s2 = __builtin_fmaf(wq[i_ + 2], irelu(acc[i_ + 2]), s2); s3 = __builtin_fmaf(wq[i_ + 3], irelu(acc[i_ + 3]), s3); } \
      auto sw01 = __builtin_amdgcn_permlane32_swap(__float_as_uint(s0), __float_as_uint(s1), false, false); \
      auto sw23 = __builtin_amdgcn_permlane32_swap(__float_as_uint(s2), __float_as_uint(s3), false, false); \
      const float sa = __uint_as_float(sw01[0]) + __uint_as_float(sw01[1]);     \
      const float sb = __uint_as_float(sw23[0]) + __uint_as_float(sw23[1]);     \
      if ((KT) == ntiles - 1) TK_TAIL2(sa, sb, true); else TK_TAIL2(sa, sb, false); \
    } while (0)
    u32* const hista = hist + hh * 1024;
    u32* const histb = hist + (2 + hh) * 1024;
    u16* const keysa = keys + hh * 16384;
    u16* const keysb = keys + (2 + hh) * 16384;
    {
      bf16x8 bA0, bA1, bB0, bB1, bC0, bC1, bD0, bD1, bE0, bE1, bF0, bF1, bG0, bG1, bH0, bH1;
      bA0 = bA1 = bB0 = bB1 = bC0 = bC1 = bD0 = bD1 = bE0 = bE1 = bF0 = bF1 = bG0 = bG1 = bH0 = bH1 = a0;
      int kt = wid;
#define TK_LOADP(KT, B0, B1) do { const int kc_ = (KT) < ntiles ? (KT) : ntiles - 1; const u16* ikp_ = ik + (size_t)kc_ * 1024 + hh * 256 + r * 8; \
      B0 = *(const bf16x8*)ikp_; B1 = *(const bf16x8*)(ikp_ + 512); } while (0)
      TK_LOADP(kt, bA0, bA1); TK_LOADP(kt + 8, bB0, bB1); TK_LOADP(kt + 16, bC0, bC1); TK_LOADP(kt + 24, bD0, bD1);
      TK_LOADP(kt + 32, bE0, bE1); TK_LOADP(kt + 40, bF0, bF1); TK_LOADP(kt + 48, bG0, bG1); TK_LOADP(kt + 56, bH0, bH1);
#define TK_LOADC(KT, B0, B1) do { const int kc_ = (KT) < ntiles ? (KT) : ntiles - 1; const u16* ikp_ = ik + (size_t)kc_ * 1024 + hh * 256 + r * 8; \
      B0 = *(const bf16x8*)ikp_; B1 = *(const bf16x8*)(ikp_ + 512); } while (0)
      for (; kt + 56 < ntiles; kt += 64) {
        TK_PROC(kt, bA0, bA1); TK_LOADC(kt + 64, bA0, bA1);
        TK_PROC(kt + 8, bB0, bB1); TK_LOADC(kt + 72, bB0, bB1);
        TK_PROC(kt + 16, bC0, bC1); TK_LOADC(kt + 80, bC0, bC1);
        TK_PROC(kt + 24, bD0, bD1); TK_LOADC(kt + 88, bD0, bD1);
        TK_PROC(kt + 32, bE0, bE1); TK_LOADC(kt + 96, bE0, bE1);
        TK_PROC(kt + 40, bF0, bF1); TK_LOADC(kt + 104, bF0, bF1);
        TK_PROC(kt + 48, bG0, bG1); TK_LOADC(kt + 112, bG0, bG1);
        TK_PROC(kt + 56, bH0, bH1); TK_LOADC(kt + 120, bH0, bH1);
      }
      if (kt < ntiles) {
        TK_PROC(kt, bA0, bA1);
        if (kt + 8 < ntiles) TK_PROC(kt + 8, bB0, bB1);
        if (kt + 16 < ntiles) TK_PROC(kt + 16, bC0, bC1);
        if (kt + 24 < ntiles) TK_PROC(kt + 24, bD0, bD1);
        if (kt + 32 < ntiles) TK_PROC(kt + 32, bE0, bE1);
        if (kt + 40 < ntiles) TK_PROC(kt + 40, bF0, bF1);
        if (kt + 48 < ntiles) TK_PROC(kt + 48, bG0, bG1);
      }
    }
    __syncthreads();
    PROF_T1(1)
    PROF_T0(2)
    {
      const int q = wid & 3, half = wid >> 2;
      const int tq = t0 + q, n = tq + 1;
      const u16* kq = keys + q * 16384;
      u32* h2 = hist2 + q * 64;
      u32* misc = hist2 + 256 + q * 4;
      u16* lists = (u16*)(hist2 + 288);
      u16* mylist = lists + (q * 2 + half) * TK_CAP;
      const int niter = (n + 511) >> 9, nh = (niter + 1) >> 1;
      const int c0 = half ? nh : 0, c1 = half ? niter : nh;
      u32 Bs, cnt_above;
      topk_level1(hist + q * 1024, lane, Bs, cnt_above);
      const u32 nc = topk_candidates(kq, n, c0, c1, Bs, h2, mylist, lane);
      if (lane == 0) misc[half] = nc;
      __syncthreads();
      if (half == 0) {
        const u32 c2 = h2[lane];
        const u32 need = 256u - cnt_above;
        u32 suf3 = c2;
#pragma unroll
        for (int off = 1; off < 64; off <<= 1) { u32 o = __shfl_down(suf3, off); if (lane + off < 64) suf3 += o; }
        unsigned long long m3 = __ballot(suf3 >= need);
        const int vs = 63 - __clzll(m3);
        const u32 Kstar = (Bs << 6) | (u32)vs;
        const u32 cnt_gt = cnt_above + __shfl(suf3, vs) - __shfl(c2, vs);
        const u32 need_eq = 256u - cnt_gt;
        const u32 na = misc[0], nb = misc[1];
        u16* so = sel + (size_t)tq * 256;
        if (na <= (u32)TK_CAP && nb <= (u32)TK_CAP) {
          u32 bg = 0, be = 0;
          topk_emit(kq, lists + (q * 2) * TK_CAP, (int)na, Kstar, need_eq, bg, be, so, lane);
          topk_emit(kq, lists + (q * 2 + 1) * TK_CAP, (int)nb, Kstar, need_eq, bg, be, so, lane);
        } else {
          topk_pass2(kq, n, 0, niter, Kstar, need_eq, 0u, 0u, so, lane);
        }
      }
    }
    __syncthreads();
    PROF_T1(2)
  }
}

typedef _Float16 h2_t __attribute__((ext_vector_type(2)));
__device__ __forceinline__ float dot2h(u32 a, u32 b, float c) { return __builtin_amdgcn_fdot2(__builtin_bit_cast(h2_t, a), __builtin_bit_cast(h2_t, b), c, false); }
__device__ __forceinline__ float hlo(u32 a) { return (float)(__builtin_bit_cast(h2_t, a)[0]); }
__device__ __forceinline__ float hhi(u32 a) { return (float)(__builtin_bit_cast(h2_t, a)[1]); }

__device__ __forceinline__ float dpp_xor1(float v) {
  return __uint_as_float(__builtin_amdgcn_update_dpp(0u, __float_as_uint(v), 0xB1, 0xF, 0xF, true));
}

__device__ void phase_attn(const Params& p, char* smem) {
  const u16* qh = (const u16*)(p.ws + OFF_QR); const u16* kh = (const u16*)(p.ws + OFF_KR); const u16* vh = (const u16*)(p.ws + OFF_VV);
  const u16* sel = (const u16*)(p.ws + OFF_SEL); const float* qsh = (const float*)(p.ws + OFF_QSH);
  u16* mix = (u16*)(p.ws + OFF_MIX);
  uint4* sK = (uint4*)smem;
  uint4* sV = (uint4*)(smem + 65536);
  const int tid = threadIdx.x;
  const int ql = tid >> 1, hp = tid & 1, rot = (tid >> 1) & 3;
  for (int it2 = 0; it2 < 2; ++it2) {
    const int item0 = it2 ? (511 - (int)blockIdx.x) : (int)blockIdx.x;
    for (int item = item0; item >= 0 && item < 512; item += (it2 ? -(int)gridDim.x : (int)gridDim.x)) {
      if (it2 == 0 && item >= 256) break;
      if (it2 == 1 && item < 256) break;
      const int h = item & 7, qb = item >> 3;
      const int t = qb * 256 + ql;
      const uint4* qp = (const uint4*)(qh + ((size_t)h * T + t) * 64) + 4 * hp;
      const uint4 q0 = qp[(0 + rot) & 3], q1 = qp[(1 + rot) & 3], q2 = qp[(2 + rot) & 3], q3 = qp[(3 + rot) & 3];
      const float nshift = -0.5f * qsh[(size_t)h * T + t];
      float acc[32];
#pragma unroll
      for (int i = 0; i < 32; ++i) acc[i] = 0.f;
      float lsum = 0.f;
      const int nsel = (t + 1 < 256) ? (t + 1) : 256;
      const bool dense = t < 256;
      const uint4* sp = (const uint4*)(sel + (size_t)t * 256);
      u16* const win = (u16*)(smem + 131072) + ql * 32;
      int ptr = 0, wbase = 0;
      const int nchunks = (qb >> 1) + 1;
      const int o0 = 4 * hp + ((0 + rot) & 3), o1 = 4 * hp + ((1 + rot) & 3), o2 = 4 * hp + ((2 + rot) & 3), o3 = 4 * hp + ((3 + rot) & 3);
      uint4 t0, t1, t2, t3, t4, t5, t6, t7, u0, u1, u2, u3, u4, u5, u6, u7, wv0, wv1;
#define ATT_CLOAD(cc) do { \
        const uint4* kg = (const uint4*)(kh + ((size_t)h * T + (cc) * 512) * 64) + tid; \
        const uint4* vg = (const uint4*)(vh + ((size_t)h * T + (cc) * 512) * 64) + tid; \
        t0 = kg[0]; t1 = kg[512]; t2 = kg[1024]; t3 = kg[1536]; t4 = kg[2048]; t5 = kg[2560]; t6 = kg[3072]; t7 = kg[3584]; \
        u0 = vg[0]; u1 = vg[512]; u2 = vg[1024]; u3 = vg[1536]; u4 = vg[2048]; u5 = vg[2560]; u6 = vg[3072]; u7 = vg[3584]; } while (0)
#define ATT_WLOAD() do { const int wi_ = (wbase >> 3) + 2 * hp; wv0 = sp[wi_ < 31 ? wi_ : 31]; wv1 = sp[wi_ + 1 < 31 ? wi_ + 1 : 31]; } while (0)
#define ATT_WSTORE() do { *(uint4*)(win + 16 * hp) = wv0; *(uint4*)(win + 16 * hp + 8) = wv1; } while (0)
      ATT_CLOAD(0);
      ATT_WLOAD();
      for (int c = 0; c < nchunks; ++c) {
        PROF_T0(3)
        __syncthreads();
        {
          uint4* dk = sK + tid; uint4* dv = sV + tid;
          dk[0] = t0; dk[512] = t1; dk[1024] = t2; dk[1536] = t3; dk[2048] = t4; dk[2560] = t5; dk[3072] = t6; dk[3584] = t7;
          dv[0] = u0; dv[512] = u1; dv[1024] = u2; dv[1536] = u3; dv[2048] = u4; dv[2560] = u5; dv[3072] = u6; dv[3584] = u7;
          ATT_WSTORE();
        }
        __syncthreads();
        PROF_T1(3)
        PROF_T0(4)
        if (c + 1 < nchunks) ATT_CLOAD(c + 1);
        const int cbase = c * 512, cend = cbase + 512;
        int nextidx = dense ? ptr : (int)win[ptr - wbase];
        while (ptr < nsel && nextidx < cend) {
          const int lk = nextidx - cbase;
          const uint4* krow = sK + lk * 8;
          const uint4* vrow = sV + lk * 8;
          ++ptr;
          int nidx2 = ptr;
          if (!dense) {
            if (ptr - wbase >= 32) { wbase = ptr & ~7; ATT_WLOAD(); ATT_WSTORE(); }
            nidx2 = (int)win[ptr - wbase];
          }
          const uint4 ka = krow[o0], kb = krow[o1], kc = krow[o2], kd = krow[o3];
          const uint4 va = vrow[o0], vb = vrow[o1], vc = vrow[o2], vd = vrow[o3];
          float d0 = nshift, d1 = 0.f, d2 = 0.f, d3 = 0.f;
#define ATT_DOT(Q, KV) { d0 = dot2h(Q.x, KV.x, d0); d1 = dot2h(Q.y, KV.y, d1); d2 = dot2h(Q.z, KV.z, d2); d3 = dot2h(Q.w, KV.w, d3); }
          ATT_DOT(q0, ka) ATT_DOT(q1, kb) ATT_DOT(q2, kc) ATT_DOT(q3, kd)
          float d = (d0 + d1) + (d2 + d3);
          d += dpp_xor1(d);
          const float pe = __builtin_amdgcn_exp2f(d);
          lsum += pe;
#define ATT_MIX(A, W) do { asm("v_fma_mix_f32 %0, %2, %3, %0 op_sel_hi:[0,1,0]\n\tv_fma_mix_f32 %1, %2, %3, %1 op_sel:[0,1,0] op_sel_hi:[0,1,0]" \
            : "+v"(acc[A]), "+v"(acc[(A) + 1]) : "v"(pe), "v"(W)); } while (0)
#define ATT_PV(J, VV) { ATT_MIX(8 * J + 0, VV.x); ATT_MIX(8 * J + 2, VV.y); ATT_MIX(8 * J + 4, VV.z); ATT_MIX(8 * J + 6, VV.w); }
          ATT_PV(0, va) ATT_PV(1, vb) ATT_PV(2, vc) ATT_PV(3, vd)
          nextidx = nidx2;
        }
        PROF_T1(4)
        if (!dense) { wbase = ptr & ~7; ATT_WLOAD(); }
      }
#undef ATT_CLOAD
#undef ATT_WLOAD
#undef ATT_WSTORE
      const float inv = 1.f / lsum;
      u16* orow = mix + (size_t)t * 1024 + h * 64;
#define ATT_OUT(J, O) { uint4 o; o.x = pack2bf(acc[8 * J] * inv, acc[8 * J + 1] * inv); o.y = pack2bf(acc[8 * J + 2] * inv, acc[8 * J + 3] * inv); \
        o.z = pack2bf(acc[8 * J + 4] * inv, acc[8 * J + 5] * inv); o.w = pack2bf(acc[8 * J + 6] * inv, acc[8 * J + 7] * inv); *(uint4*)(orow + (O) * 8) = o; }
      ATT_OUT(0, o0) ATT_OUT(1, o1) ATT_OUT(2, o2) ATT_OUT(3, o3)
    }
  }
}

__device__ void phase_gemm_out(const Params& p, char* smem) {
  g8::SchedDense S{(const char*)(p.ws + OFF_MIX), (const char*)(p.ws + OFF_WOUTT), 1024, T / 256, 4, (T / 256) * 4, (int)gridDim.x, (int)blockIdx.x};
  g8::EpiF32 E{(float*)(p.ws + OFF_H1), p.x, 1024};
  g8::gemm_phase<g8::SchedDense, g8::EpiF32, false>((LAS unsigned char*)smem, 1024, S, E, nullptr);
}

__device__ void phase_router(const Params& p, char* smem) {
  const float* h1 = (const float*)(p.ws + OFF_H1);
  u16* xn2 = (u16*)(p.ws + OFF_XN);
  int* toke = (int*)(p.ws + OFF_TOKE); float* tokg = (float*)(p.ws + OFF_TOKG); int* tokp = (int*)(p.ws + OFF_TOKP);
  int* cnt = (int*)(p.ws + OFF_CNT);
  const int tid = threadIdx.x, lane = tid & 63, wid = tid >> 6;
  const int e = lane & 31, kh = lane >> 5;
  float* xs = (float*)smem;
  float* part = (float*)(smem + 65536);
  float wreg[64];
  {
    const int k0 = wid * 128 + kh * 64;
#pragma unroll
    for (int j = 0; j < 64; ++j) wreg[j] = p.router_w[(size_t)(k0 + j) * 32 + e] * p.norm2_w[k0 + j];
  }
  const float rb = p.router_b[e];
  float4 nw4[4];
#pragma unroll
  for (int i = 0; i < 4; ++i) nw4[i] = ((const float4*)p.norm2_w)[lane + 64 * i];
  for (int b0 = blockIdx.x * 16; b0 < T; b0 += gridDim.x * 16) {
    float4 va[4], vb[4];
    {
      const float4* hra = (const float4*)(h1 + (size_t)(b0 + wid * 2) * D);
      const float4* hrb = hra + D / 4;
#pragma unroll
      for (int i = 0; i < 4; ++i) { va[i] = hra[lane + 64 * i]; vb[i] = hrb[lane + 64 * i]; }
    }
    __syncthreads();
    float ssa = 0.f, ssb = 0.f;
#pragma unroll
    for (int i = 0; i < 4; ++i) {
      ssa += va[i].x * va[i].x + va[i].y * va[i].y + va[i].z * va[i].z + va[i].w * va[i].w;
      ssb += vb[i].x * vb[i].x + vb[i].y * vb[i].y + vb[i].z * vb[i].z + vb[i].w * vb[i].w;
    }
#pragma unroll
    for (int o = 32; o >= 1; o >>= 1) { ssa += __shfl_xor(ssa, o); ssb += __shfl_xor(ssb, o); }
    const float rsa = rsqrtf(ssa * (1.f / D) + 1e-6f), rsb = rsqrtf(ssb * (1.f / D) + 1e-6f);
#pragma unroll
    for (int i = 0; i < 4; ++i) {
      const float4 w = nw4[i];
      const float4 ya = make_float4(va[i].x * rsa, va[i].y * rsa, va[i].z * rsa, va[i].w * rsa);
      const float4 yb = make_float4(vb[i].x * rsb, vb[i].y * rsb, vb[i].z * rsb, vb[i].w * rsb);
      *(float4*)(xs + (wid * 2) * 1024 + (lane + 64 * i) * 4) = ya;
      *(float4*)(xs + (wid * 2 + 1) * 1024 + (lane + 64 * i) * 4) = yb;
      uint2 oa, ob; oa.x = pack2bf(ya.x * w.x, ya.y * w.y); oa.y = pack2bf(ya.z * w.z, ya.w * w.w);
      ob.x = pack2bf(yb.x * w.x, yb.y * w.y); ob.y = pack2bf(yb.z * w.z, yb.w * w.w);
      *(uint2*)(xn2 + (size_t)(b0 + wid * 2) * D + (lane + 64 * i) * 4) = oa;
      *(uint2*)(xn2 + (size_t)(b0 + wid * 2 + 1) * D + (lane + 64 * i) * 4) = ob;
    }
    __syncthreads();
    for (int tl = 0; tl < 16; ++tl) {
      const f32x4* xr = (const f32x4*)(xs + tl * 1024 + wid * 128 + kh * 64);
      float a0 = 0.f, a1 = 0.f, a2 = 0.f, a3 = 0.f;
#pragma unroll
      for (int j = 0; j < 16; ++j) {
        const f32x4 x4 = xr[j];
        a0 += x4[0] * wreg[4 * j]; a1 += x4[1] * wreg[4 * j + 1]; a2 += x4[2] * wreg[4 * j + 2]; a3 += x4[3] * wreg[4 * j + 3];
      }
      float a = (a0 + a1) + (a2 + a3);
      a += __shfl_xor(a, 32);
      if (lane < 32) part[(tl * 8 + wid) * 32 + e] = a;
    }
    __syncthreads();
    {
      const int tl = wid * 2 + kh, t = b0 + tl;
      float val = rb;
#pragma unroll
      for (int w = 0; w < 8; ++w) val += part[(tl * 8 + w) * 32 + e];
      float tv[4]; int te[4];
#pragma unroll
      for (int k = 0; k < 4; ++k) {
        float bv = val; int bi = e;
#pragma unroll
        for (int off = 16; off >= 1; off >>= 1) {
          float ov = __shfl_xor(bv, off); int oi = __shfl_xor(bi, off);
          if (ov > bv || (ov == bv && oi < bi)) { bv = ov; bi = oi; }
        }
        tv[k] = bv; te[k] = bi;
        if (e == bi) val = -INFINITY;
      }
      const float m = tv[0];
      float ex[4], s = 0.f;
#pragma unroll
      for (int k = 0; k < 4; ++k) { ex[k] = __expf(tv[k] - m); s += ex[k]; }
      if (e < 4) {
        const int ee = (e == 0) ? te[0] : (e == 1) ? te[1] : (e == 2) ? te[2] : te[3];
        const float gg = ((e == 0) ? ex[0] : (e == 1) ? ex[1] : (e == 2) ? ex[2] : ex[3]) / s;
        const int pos = atomicAdd(&cnt[ee], 1);
        toke[(size_t)t * 4 + e] = ee; tokg[(size_t)t * 4 + e] = gg; tokp[(size_t)t * 4 + e] = pos;
      }
    }
  }
}

__device__ __forceinline__ int expert_tstart(const int* cnt, int e) {
  int s = 0;
  for (int i = 0; i < e; ++i) s += (cnt[i] + 255) >> 8;
  return s;
}

__device__ __forceinline__ int* moe_tile_starts(const Params& p, char* smem) {
  int* ts = (int*)(smem + SM_TAIL + 64);
  const int* cnt = (const int*)(p.ws + OFF_CNT);
  __syncthreads();
  if (threadIdx.x <= NE) ts[threadIdx.x] = expert_tstart(cnt, threadIdx.x);
  __syncthreads();
  return ts;
}

__device__ void phase_fill_rows(const Params& p, char* smem) {
  const int* toke = (const int*)(p.ws + OFF_TOKE); const int* tokp = (const int*)(p.ws + OFF_TOKP);
  int* rowtok = (int*)(p.ws + OFF_ROWTOK);
  const int* ts = moe_tile_starts(p, smem);
  int gtid = blockIdx.x * NTHREADS + threadIdx.x, gsz = gridDim.x * NTHREADS;
  for (int i = gtid; i < T * 4; i += gsz) rowtok[ts[toke[i]] * 256 + tokp[i]] = i >> 2;
}

__device__ void phase_gemm_gu(const Params& p, char* smem) {
  const int* ts = moe_tile_starts(p, smem);
  g8::SchedMoE<8, true> S{(const char*)(p.ws + OFF_XN), (const char*)(p.ws + OFF_WGUT), 1024, ts, (int)gridDim.x, (int)blockIdx.x};
  g8::EpiGU E{(u16*)(p.ws + OFF_Z), p.exp_b_gu};
  g8::gemm_phase<g8::SchedMoE<8, true>, g8::EpiGU, true>((LAS unsigned char*)smem, 1024, S, E, (const int*)(p.ws + OFF_ROWTOK));
}

__device__ void phase_gemm_dn(const Params& p, char* smem) {
  const int* ts = moe_tile_starts(p, smem);
  g8::SchedMoE<4, false> S{(const char*)(p.ws + OFF_Z), (const char*)(p.ws + OFF_WDNT), 1024, ts, (int)gridDim.x, (int)blockIdx.x};
  g8::EpiDN E{(u16*)(p.ws + OFF_SV), p.exp_b_down};
  g8::gemm_phase<g8::SchedMoE<4, false>, g8::EpiDN, false>((LAS unsigned char*)smem, 1024, S, E, nullptr);
}

__device__ void phase_combine(const Params& p, char* smem) {
  const int* toke = (const int*)(p.ws + OFF_TOKE); const float* tokg = (const float*)(p.ws + OFF_TOKG); const int* tokp = (const int*)(p.ws + OFF_TOKP);
  const float* h1 = (const float*)(p.ws + OFF_H1); const u16* yb = (const u16*)(p.ws + OFF_SV);
  const int* ts = moe_tile_starts(p, smem);
  const int tid = threadIdx.x;
  const int sub = tid & 127, tl = tid >> 7;
  for (int t0 = blockIdx.x * 4; t0 < T; t0 += gridDim.x * 4) {
    const int t = t0 + tl;
    float4 a = *(const float4*)(h1 + (size_t)t * D + sub * 8), b = *(const float4*)(h1 + (size_t)t * D + sub * 8 + 4);
    float o[8] = {a.x, a.y, a.z, a.w, b.x, b.y, b.z, b.w};
#pragma unroll
    for (int k = 0; k < 4; ++k) {
      const int e = toke[t * 4 + k]; const float gte = tokg[t * 4 + k];
      const size_t row = (size_t)ts[e] * 256 + tokp[t * 4 + k];
      uint4 w = *(const uint4*)(yb + row * 1024 + sub * 8);
      u32 ww[4] = {w.x, w.y, w.z, w.w};
#pragma unroll
      for (int i = 0; i < 4; ++i) { o[2 * i] += gte * __uint_as_float(ww[i] << 16); o[2 * i + 1] += gte * __uint_as_float(ww[i] & 0xFFFF0000u); }
    }
    *(float4*)(p.out + (size_t)t * D + sub * 8) = make_float4(o[0], o[1], o[2], o[3]);
    *(float4*)(p.out + (size_t)t * D + sub * 8 + 4) = make_float4(o[4], o[5], o[6], o[7]);
  }
}

enum { PH_INIT = 0, PH_PREP, PH_GEMM_IN, PH_POST, PH_SCAN_A, PH_TOPK, PH_SCAN_B, PH_SCAN_C, PH_ATTN, PH_RWKV_OUT, PH_GEMM_OUT, PH_ROUTER, PH_FILL, PH_GEMM_GU, PH_GEMM_DN, PH_COMBINE, PH_COUNT };

template <int PH>
__device__ __forceinline__ void run_phase(const Params& p, char* smem) {
  if (PH == PH_INIT) { phase_init(p); phase_norm1(p); }
  if (PH == PH_PREP) {
    transpose_convert(p.w_in, (u16*)(p.ws + OFF_WINT), 1024, DIN, DINP, 1, smem, blockIdx.x, gridDim.x);
    transpose_convert(p.w_out, (u16*)(p.ws + OFF_WOUTT), 1024, 1024, 1024, 1, smem, blockIdx.x, gridDim.x);
  }
  if (PH == PH_GEMM_IN) phase_gemm_in(p, smem);
  if (PH == PH_POST) { phase_post_attn(p); phase_post_rwkv(p, smem); }
  if (PH == PH_SCAN_A) phase_scan_a(p, smem);
  if (PH == PH_TOPK) phase_topk(p, smem);
  if (PH == PH_SCAN_B) { }
  if (PH == PH_SCAN_C) phase_scan_c(p, smem);
  if (PH == PH_ATTN) phase_attn(p, smem);
  if (PH == PH_RWKV_OUT) phase_rwkv_out(p);
  if (PH == PH_GEMM_OUT) phase_gemm_out(p, smem);
  if (PH == PH_ROUTER) phase_router(p, smem);
  if (PH == PH_FILL) phase_fill_rows(p, smem);
  if (PH == PH_GEMM_GU) phase_gemm_gu(p, smem);
  if (PH == PH_GEMM_DN) phase_gemm_dn(p, smem);
  if (PH == PH_COMBINE) phase_combine(p, smem);
}

#ifndef FUSED
#define FUSED 1
#endif

template <int PH>
__global__ void __launch_bounds__(NTHREADS) phase_kernel(Params p) {
  extern __shared__ __attribute__((aligned(16))) char smem[];
  run_phase<PH>(p, smem);
}

__host__ __device__ constexpr bool barrier_after(int ph) { return !(ph == PH_INIT || ph == PH_SCAN_B || ph == PH_SCAN_C); }

template <int PH>
__device__ __forceinline__ void run_from(const Params& p, char* smem, cg::grid_group& grid, const XcdBarrier& xb) {
#ifdef REPEAT_PH
  if constexpr (PH == REPEAT_PH) { run_phase<PH>(p, smem); xcd_barrier(xb); }
#endif
  run_phase<PH>(p, smem);
  if constexpr (PH + 1 < PH_COUNT) {
    if constexpr (barrier_after(PH)) xcd_barrier(xb);
    else __syncthreads();
    run_from<PH + 1>(p, smem, grid, xb);
  }
}

__global__ void __launch_bounds__(NTHREADS) fwd_megakernel(Params p) {
  extern __shared__ __attribute__((aligned(16))) char smem[];
  uint4& xb_words = *(uint4*)(smem + SM_TAIL);
  cg::grid_group grid = cg::this_grid();
  if (threadIdx.x == 0) { xb_words = make_uint4(0u, 0u, 0u, 0u); g_prof = 0ull; }
  __syncthreads();
  XcdBarrier xb = xcd_barrier_post((unsigned*)(p.ws + OFF_BAR), (volatile LAS unsigned*)&xb_words);
  if (p.ws == nullptr) grid.sync();
  run_from<0>(p, smem, grid, xb);
  if (PROBE_ID != 0 && blockIdx.x == PROF_BLOCK && threadIdx.x == 0) {
    const unsigned long long t0 = __builtin_amdgcn_s_memrealtime(), w = g_prof * PROF_AMP;
    while (__builtin_amdgcn_s_memrealtime() - t0 < w) __builtin_amdgcn_s_sleep(8);
  }
}

template <int PH>
static void launch_phase(const Params& p, int grid, hipStream_t stream) {
  static bool attr_set = false;
  if (!attr_set) { (void)hipFuncSetAttribute((const void*)phase_kernel<PH>, hipFuncAttributeMaxDynamicSharedMemorySize, LDS_BYTES); attr_set = true; }
  hipLaunchKernelGGL(phase_kernel<PH>, dim3(grid), dim3(NTHREADS), LDS_BYTES, stream, p);
}

template <int PH>
static void launch_all(const Params& p, int grid, hipStream_t stream) {
  launch_phase<PH>(p, grid, stream);
  if constexpr (PH + 1 < PH_COUNT) launch_all<PH + 1>(p, grid, stream);
}

extern "C" void kernel_launch(void* const* d_in, const int* in_sizes, int n_in, void* d_out, int out_size, void* d_ws, size_t ws_size,
                              hipStream_t stream) {
  if (ws_size < WS_NEEDED) { fprintf(stderr, "workspace too small: %zu < %zu\n", ws_size, (size_t)WS_NEEDED); return; }
  Params p{};
  p.x = (const float*)d_in[0]; p.positions = (const int*)d_in[1]; p.norm1_w = (const float*)d_in[2]; p.w_in = (const float*)d_in[3];
  p.q_norm_w = (const float*)d_in[4]; p.k_norm_w = (const float*)d_in[5]; p.rwkv_mu = (const float*)d_in[6]; p.rwkv_w0 = (const float*)d_in[7];
  p.rwkv_w2 = (const float*)d_in[8]; p.rwkv_a0 = (const float*)d_in[9]; p.rwkv_a2 = (const float*)d_in[10]; p.rwkv_g2 = (const float*)d_in[11];
  p.rwkv_k_k = (const float*)d_in[12]; p.rwkv_k_a = (const float*)d_in[13]; p.rwkv_r_k = (const float*)d_in[14]; p.rwkv_ln_w = (const float*)d_in[15];
  p.rwkv_ln_b = (const float*)d_in[16]; p.w_out = (const float*)d_in[17]; p.norm2_w = (const float*)d_in[18]; p.router_w = (const float*)d_in[19];
  p.router_b = (const float*)d_in[20]; p.exp_w_gu = (const float*)d_in[21]; p.exp_b_gu = (const float*)d_in[22]; p.exp_w_down = (const float*)d_in[23];
  p.exp_b_down = (const float*)d_in[24];
  p.out = (float*)d_out; p.ws = (char*)d_ws;
#if FUSED
  static int grid_blocks = 0;
  if (!grid_blocks) {
    (void)hipFuncSetAttribute((const void*)fwd_megakernel, hipFuncAttributeMaxDynamicSharedMemorySize, LDS_BYTES);
    int dev = 0, cus = 0, per_cu = 0;
    (void)hipGetDevice(&dev);
    (void)hipDeviceGetAttribute(&cus, hipDeviceAttributeMultiprocessorCount, dev);
    (void)hipOccupancyMaxActiveBlocksPerMultiprocessor(&per_cu, fwd_megakernel, NTHREADS, LDS_BYTES);
    if (per_cu < 1) { fprintf(stderr, "occupancy query returned %d\n", per_cu); per_cu = 1; }
    grid_blocks = cus;
  }
  (void)hipMemsetAsync((char*)d_ws + OFF_BAR, 0, 16384, stream);
  void* args[] = {(void*)&p};
  hipError_t e = hipLaunchCooperativeKernel((void*)fwd_megakernel, dim3(grid_blocks), dim3(NTHREADS), args, LDS_BYTES, stream);
  if (e != hipSuccess) fprintf(stderr, "cooperative launch failed: %s (grid %d)\n", hipGetErrorString(e), grid_blocks);
#else
  launch_all<0>(p, 256, stream);
#endif
}
```

```cpp
#include <hip/hip_runtime.h>
#include <hip/hip_bf16.h>
#include <hip/hip_fp16.h>
#include <hip/hip_cooperative_groups.h>
#include <stdint.h>
#include <stdio.h>
namespace cg = cooperative_groups;

typedef unsigned short u16;
typedef unsigned int u32;
using bf16x8 = __attribute__((ext_vector_type(8))) short;
using f32x4 = __attribute__((ext_vector_type(4))) float;
using f32x16 = __attribute__((ext_vector_type(16))) float;

constexpr int T = 16384, D = 1024, DIN = 3496, DINP = 3584;
constexpr int NCH = 128, CHL = T / NCH;
constexpr int NE = 32, DFF = 1024;
constexpr int ROWCAP = 73728;
constexpr int C_Q = 0, C_K = 512, C_V = 1024, C_IQ = 1536, C_IK = 1792, C_IW = 1824, C_RW = 1832;
constexpr int NTHREADS = 512;
constexpr int LDS_BYTES = 159 * 1024;

constexpr size_t SZ_WGUT = (size_t)NE * 2048 * 1024 * 2;
constexpr size_t SZ_WDNT = (size_t)NE * 1024 * 1024 * 2;
constexpr size_t SZ_WINT = (size_t)DINP * 1024 * 2;
constexpr size_t SZ_WOUTT = (size_t)1024 * 1024 * 2;
constexpr size_t SZ_XN = (size_t)T * 1024 * 2;
constexpr size_t SZ_Z = (size_t)T * DINP * 4;
constexpr size_t SZ_QKV = (size_t)T * 512 * 2;
constexpr size_t SZ_IQ = (size_t)T * 256 * 2;
constexpr size_t SZ_IK = (size_t)T * 32 * 2;
constexpr size_t SZ_IW = (size_t)T * 8 * 4;
constexpr size_t SZ_SV = (size_t)T * 8 * 384 * 4;
constexpr size_t SZ_G = (size_t)T * 512 * 4;
constexpr size_t SZ_BONUS = (size_t)T * 8 * 4;
constexpr size_t SZ_Y = (size_t)T * 512 * 4;
constexpr size_t SZ_SMAT = (size_t)8 * NCH * 4096 * 4;
constexpr size_t SZ_SEL = (size_t)T * 256 * 2;
constexpr size_t SZ_MIX = (size_t)T * 1024 * 2;
constexpr size_t SZ_H1 = (size_t)T * 1024 * 4;
constexpr size_t SZ_TOK = (size_t)T * 4 * 4;
constexpr size_t SZ_ROWTOK = (size_t)ROWCAP * 4;

constexpr size_t OFF_WGUT = 0;
constexpr size_t OFF_WDNT = OFF_WGUT + SZ_WGUT;
constexpr size_t OFF_WINT = OFF_WDNT + SZ_WDNT;
constexpr size_t OFF_WOUTT = OFF_WINT + SZ_WINT;
constexpr size_t OFF_XN = OFF_WOUTT + SZ_WOUTT;
constexpr size_t OFF_Z = OFF_XN + SZ_XN;
constexpr size_t OFF_QR = OFF_Z + SZ_Z;
constexpr size_t OFF_KR = OFF_QR + SZ_QKV;
constexpr size_t OFF_VV = OFF_KR + SZ_QKV;
constexpr size_t OFF_IQ = OFF_VV + SZ_QKV;
constexpr size_t OFF_IK = OFF_IQ + SZ_IQ;
constexpr size_t OFF_IW = OFF_IK + SZ_IK;
constexpr size_t OFF_SV = OFF_IW + SZ_IW;
constexpr size_t OFF_G = OFF_SV + SZ_SV;
constexpr size_t OFF_BONUS = OFF_G + SZ_G;
constexpr size_t OFF_Y = OFF_BONUS + SZ_BONUS;
constexpr size_t OFF_SP = OFF_Y + SZ_Y;
constexpr size_t OFF_SL = OFF_SP + SZ_SMAT;
constexpr size_t OFF_SI = OFF_SL + SZ_SMAT;
constexpr size_t OFF_SEL = OFF_SI + SZ_SMAT;
constexpr size_t OFF_MIX = OFF_SEL + SZ_SEL;
constexpr size_t OFF_H1 = OFF_MIX + SZ_MIX;
constexpr size_t OFF_TOKE = OFF_H1 + SZ_H1;
constexpr size_t OFF_TOKG = OFF_TOKE + SZ_TOK;
constexpr size_t OFF_TOKP = OFF_TOKG + SZ_TOK;
constexpr size_t OFF_ROWTOK = OFF_TOKP + SZ_TOK;
constexpr size_t OFF_CNT = OFF_ROWTOK + SZ_ROWTOK;
constexpr size_t OFF_QSH = OFF_CNT + 4096;
constexpr size_t OFF_BAR = OFF_QSH + (size_t)T * 8 * 4;
constexpr size_t WS_NEEDED = OFF_BAR + 16384;

struct Params {
  const float* x; const int* positions; const float* norm1_w; const float* w_in;
  const float* q_norm_w; const float* k_norm_w; const float* rwkv_mu; const float* rwkv_w0;
  const float* rwkv_w2; const float* rwkv_a0; const float* rwkv_a2; const float* rwkv_g2;
  const float* rwkv_k_k; const float* rwkv_k_a; const float* rwkv_r_k; const float* rwkv_ln_w;
  const float* rwkv_ln_b; const float* w_out; const float* norm2_w; const float* router_w;
  const float* router_b; const float* exp_w_gu; const float* exp_b_gu; const float* exp_w_down;
  const float* exp_b_down;
  float* out;
  char* ws;
};

__device__ __forceinline__ u16 f2bf(float f) {
  u32 u = __float_as_uint(f);
  u += 0x7FFFu + ((u >> 16) & 1u);
  return (u16)(u >> 16);
}
__device__ __forceinline__ float bf2f(u16 h) { return __uint_as_float(((u32)h) << 16); }
__device__ __forceinline__ u32 pack2bf(float a, float b) { return (u32)f2bf(a) | ((u32)f2bf(b) << 16); }
__device__ __forceinline__ float wave_sum(float v) {
#pragma unroll
  for (int o = 32; o >= 1; o >>= 1) v += __shfl_xor(v, o);
  return v;
}
__device__ __forceinline__ float sigmoidf_(float x) { return 1.f / (1.f + __expf(-x)); }

__device__ __forceinline__ void sincos_big(float ang, float& s, float& c) {
  double a = (double)ang * 0.15915494309189535;
  double r = a - rint(a);
  float rf = (float)r;
  s = __builtin_amdgcn_sinf(rf);
  c = __builtin_amdgcn_cosf(rf);
}


#define XB_TMO      128
#define XB_XCNT(j)  (256  + 64 * (j))
#define XB_XSUB(j)  (1280 + 64 * (j))
#define XB_XGEN(j)  (2304 + 64 * (j))
#define XB_TOP      3328
#define XB_TOPGEN   3392
#define XCD_BAR_WORDS 3456
#define XB_SPIN_CAP (1u << 22)
#define LAS __attribute__((address_space(3)))
__device__ __forceinline__ unsigned xb_ld(unsigned* p)              { return __hip_atomic_load(p, __ATOMIC_RELAXED, __HIP_MEMORY_SCOPE_AGENT); }
__device__ __forceinline__ unsigned xb_add(unsigned* p, unsigned v) { return __hip_atomic_fetch_add(p, v, __ATOMIC_RELAXED, __HIP_MEMORY_SCOPE_AGENT); }
__device__ __forceinline__ unsigned xb_xcc_id() { return (unsigned)__builtin_amdgcn_s_getreg((3 << 11) | 20) & 0xFu; }
#define XB_SPIN(cond, bar) do { unsigned _sp = 0; while (cond) { __builtin_amdgcn_s_sleep(1); \
    if ((++_sp & 255u) == 0u) { if (xb_ld(&(bar)[XB_TMO])) break; if (_sp > XB_SPIN_CAP) { atomicAdd(&(bar)[XB_TMO], 1u); break; } } } } while (0)
struct XcdBarrier { unsigned* bar; unsigned x; volatile LAS unsigned* st; };
__device__ __forceinline__ XcdBarrier xcd_barrier_post(unsigned* bar, volatile LAS unsigned* st) {
  XcdBarrier b; b.bar = bar; b.x = xb_xcc_id(); b.st = st;
  if (threadIdx.x == 0) (void)xb_add(&bar[XB_XCNT(b.x)], 1u);
  return b;
}
__device__ __forceinline__ void xcd_barrier_complete(unsigned* bar, unsigned x, unsigned& nloc, unsigned& nx) {
  const unsigned G = gridDim.x * gridDim.y * gridDim.z;
  unsigned sum, cnt, mine, sp = 0u;
  for (;;) {
    sum = 0u; cnt = 0u; mine = 0u;
#pragma unroll
    for (unsigned j = 0; j < 16; ++j) { const unsigned c = xb_ld(&bar[XB_XCNT(j)]); sum += c; cnt += (c > 0u) ? 1u : 0u; mine = (j == x) ? c : mine; }
    if (sum == G) break;
    __builtin_amdgcn_s_sleep(1);
    if ((++sp & 255u) == 0u) { if (xb_ld(&bar[XB_TMO])) break; if (sp > XB_SPIN_CAP) { atomicAdd(&bar[XB_TMO], 1u); break; } }
  }
  nloc = mine > 0u ? mine : 1u; nx = cnt > 0u ? cnt : 1u;
}
__device__ __forceinline__ void xcd_barrier(const XcdBarrier& b) {
  asm volatile("s_waitcnt vmcnt(0)" ::: "memory");
  __syncthreads();
  if (threadIdx.x == 0) {
    unsigned* bar = b.bar;
    __builtin_amdgcn_s_waitcnt(0);
    unsigned nloc = b.st[0], nx = b.st[1];
    if (nloc == 0u) { xcd_barrier_complete(bar, b.x, nloc, nx); b.st[0] = nloc; b.st[1] = nx; }
    const unsigned old = xb_add(&bar[XB_XSUB(b.x)], 1u);
    const unsigned gen = old / nloc;
    if (old + 1u == (gen + 1u) * nloc) {
      __builtin_amdgcn_fence(__ATOMIC_RELEASE, "agent");
      asm volatile("s_waitcnt vmcnt(0)" ::: "memory");
      const unsigned og = xb_add(&bar[XB_TOP], 1u);
      const unsigned tg = og / nx;
      if (og + 1u == (tg + 1u) * nx) xb_add(&bar[XB_TOPGEN], 1u);
      else XB_SPIN(xb_ld(&bar[XB_TOPGEN]) == tg, bar);
      __builtin_amdgcn_fence(__ATOMIC_ACQUIRE, "agent");
      xb_add(&bar[XB_XGEN(b.x)], 1u);
      asm volatile("s_waitcnt vmcnt(0)" ::: "memory");
    } else {
      XB_SPIN(xb_ld(&bar[XB_XGEN(b.x)]) == gen, bar);
      __builtin_amdgcn_fence(__ATOMIC_ACQUIRE, "agent");
      asm volatile("s_waitcnt vmcnt(0)" ::: "memory");
    }
  }
  __syncthreads();
}


#ifndef PROBE_ID
#define PROBE_ID 0
#endif
#define PROF_BLOCK 100
#define PROF_AMP 4
#define g_prof (*(unsigned long long*)(smem + 157 * 1024 + 16))
#define PROF_T0(id) unsigned long long _pt0_##id = 0; if (PROBE_ID == (id) && blockIdx.x == PROF_BLOCK && threadIdx.x == 0) _pt0_##id = __builtin_amdgcn_s_memrealtime();
#define PROF_T1(id) if (PROBE_ID == (id) && blockIdx.x == PROF_BLOCK && threadIdx.x == 0) g_prof += __builtin_amdgcn_s_memrealtime() - _pt0_##id;

__device__ void phase_init(const Params& p) {
  int* cnt = (int*)(p.ws + OFF_CNT);
  int* rowtok = (int*)(p.ws + OFF_ROWTOK);
  int gtid = blockIdx.x * NTHREADS + threadIdx.x;
  int gsz = gridDim.x * NTHREADS;
  if (gtid < 64) cnt[gtid] = 0;
  for (int i = gtid; i < ROWCAP; i += gsz) rowtok[i] = -1;
}

__device__ void transpose_convert(const float* src, u16* dst, int R, int C, int Cpad, int nbatch, char* smem, int bid, int nblk) {
  float* tile = (float*)smem;
  int tr = R / 64, tc = Cpad / 64;
  int ntile = tr * tc * nbatch;
  int tid = threadIdx.x;
  for (int id = bid; id < ntile; id += nblk) {
    int b = id / (tr * tc), rem = id % (tr * tc);
    int r0 = (rem / tc) * 64, c0 = (rem % tc) * 64;
    const float* s = src + (size_t)b * R * C;
    u16* d = dst + (size_t)b * Cpad * R;
#pragma unroll
    for (int i = 0; i < 8; ++i) {
      int r = (tid >> 6) + 8 * i, c = tid & 63;
      float v = (c0 + c < C) ? s[(size_t)(r0 + r) * C + c0 + c] : 0.f;
      tile[r * 65 + c] = v;
    }
    __syncthreads();
    {
      int cc = tid >> 3, rg = tid & 7;
      u32 w[4];
#pragma unroll
      for (int i = 0; i < 4; ++i) w[i] = pack2bf(tile[(rg * 8 + 2 * i) * 65 + cc], tile[(rg * 8 + 2 * i + 1) * 65 + cc]);
      uint4 o; o.x = w[0]; o.y = w[1]; o.z = w[2]; o.w = w[3];
      *(uint4*)(d + (size_t)(c0 + cc) * R + r0 + rg * 8) = o;
    }
    __syncthreads();
  }
}

__device__ void phase_norm1(const Params& p) {
  u16* xn = (u16*)(p.ws + OFF_XN);
  int lane = threadIdx.x & 63, wid = threadIdx.x >> 6;
  int gw = blockIdx.x * 8 + wid, nw = gridDim.x * 8;
  for (int t = gw; t < T; t += nw) {
    const float4* xr = (const float4*)(p.x + (size_t)t * D);
    float4 v[4]; float ss = 0.f;
#pragma unroll
    for (int i = 0; i < 4; ++i) { v[i] = xr[lane + 64 * i]; ss += v[i].x * v[i].x + v[i].y * v[i].y + v[i].z * v[i].z + v[i].w * v[i].w; }
    ss = wave_sum(ss);
    float rstd = rsqrtf(ss * (1.f / D) + 1e-6f);
#pragma unroll
    for (int i = 0; i < 4; ++i) {
      float4 w = ((const float4*)p.norm1_w)[lane + 64 * i];
      uint2 o; o.x = pack2bf(v[i].x * rstd * w.x, v[i].y * rstd * w.y); o.y = pack2bf(v[i].z * rstd * w.z, v[i].w * rstd * w.w);
      *(uint2*)(xn + (size_t)t * D + (lane + 64 * i) * 4) = o;
    }
  }
}

namespace g8 {
constexpr int BM = 256, BK = 64, HALF = 128, HTB = HALF * BK * 2, STAGE_BYTES = 8 * HTB;
__device__ __forceinline__ int lds_byte(int r, int c) { const int st = (r >> 4) * 2 + (c >> 5), rr = r & 15, cc = c & 31, ob = rr * 64 + cc * 2; return st * 1024 + (ob ^ (((ob >> 9) & 1) << 5)); }
__device__ __forceinline__ void stage_rc(int b, int& R, int& C) { const int st = b / 1024, sb = b % 1024, swz = sb ^ (((sb >> 9) & 1) << 5); R = (st >> 1) * 16 + swz / 64; C = (st & 1) * 32 + (swz % 64) / 2; }

struct Unit {
  const char* A;
  const char* B;
  unsigned hstepB;
  int row0;
  int col0;
  int aux;
};

template <class Sched, class Epi, bool GATHER>
__device__ __forceinline__ void gemm_phase(LAS unsigned char* lds, const int K, const Sched& S, const Epi& E, const int* __restrict__ rowtok) {
  const int tid = threadIdx.x, wid = __builtin_amdgcn_readfirstlane(tid >> 6), lane = tid & 63, wr = wid >> 2, wc = wid & 3, fr = lane & 15, fq = lane >> 4;
  const int nt = K / BK;
  int R0, C0, R1, C1;
  stage_rc(tid * 16, R0, C0); stage_rc(tid * 16 + 8192, R1, C1);
  const unsigned voffB0 = (unsigned)(R0 * K + C0) * 2u, voffB1 = (unsigned)(R1 * K + C1) * 2u;
  unsigned ac00, ac01, ac10, ac11, an00, an01, an10, an11;
#define G8_AOFF(u, o00, o01, o10, o11) do { \
    if (GATHER) { int t00 = rowtok[(u).row0 + R0], t01 = rowtok[(u).row0 + R1], t10 = rowtok[(u).row0 + HALF + R0], t11 = rowtok[(u).row0 + HALF + R1]; \
      t00 = t00 < 0 ? 0 : t00; t01 = t01 < 0 ? 0 : t01; t10 = t10 < 0 ? 0 : t10; t11 = t11 < 0 ? 0 : t11; \
      o00 = (unsigned)(t00 * K + C0) * 2u; o01 = (unsigned)(t01 * K + C1) * 2u; o10 = (unsigned)(t10 * K + C0) * 2u; o11 = (unsigned)(t11 * K + C1) * 2u; } \
    else { o00 = (unsigned)(R0 * K + C0) * 2u; o01 = (unsigned)(R1 * K + C1) * 2u; o10 = (unsigned)((HALF + R0) * K + C0) * 2u; o11 = (unsigned)((HALF + R1) * K + C1) * 2u; } } while (0)
  const size_t kstep = (size_t)(BK * 2);
  const unsigned ldsw = (unsigned)wid * 1024u;
  const int aoff = lds_byte(wr * 64 + fr, fq * 8), boff = lds_byte(wc * 32 + fr, fq * 8);
#define G8_SA(b, h) (((b) * 2 + (h)) * HTB)
#define G8_SB(b, h) ((4 + (b) * 2 + (h)) * HTB)
#define G8_STAGE(bufoff, gbase, v0, v1) do { \
    __builtin_amdgcn_global_load_lds((const unsigned*)((const char*)(gbase) + (v0)), (LAS unsigned*)(lds + (bufoff) + ldsw), 16, 0, 0); \
    __builtin_amdgcn_global_load_lds((const unsigned*)((const char*)(gbase) + (v1)), (LAS unsigned*)(lds + (bufoff) + ldsw + 8192), 16, 0, 0); } while (0)
#define G8_LDA(dst, b, h) do { _Pragma("unroll") for (int m = 0; m < 4; ++m) _Pragma("unroll") for (int k = 0; k < 2; ++k) dst[m][k] = *(const LAS bf16x8*)(lds + G8_SA(b, h) + aoff + m * 2048 + k * 1024); } while (0)
#define G8_LDB(dst, b, h) do { _Pragma("unroll") for (int n = 0; n < 2; ++n) _Pragma("unroll") for (int k = 0; k < 2; ++k) dst[n][k] = *(const LAS bf16x8*)(lds + G8_SB(b, h) + boff + n * 2048 + k * 1024); } while (0)
#define G8_MMA(ai, bj, At_, Bt_) do { __builtin_amdgcn_s_setprio(1); _Pragma("unroll") for (int m = 0; m < 4; ++m) _Pragma("unroll") for (int n = 0; n < 2; ++n) _Pragma("unroll") for (int k = 0; k < 2; ++k) \
    acc[ai][bj][m][n] = __builtin_amdgcn_mfma_f32_16x16x32_bf16(Bt_[n][k], At_[m][k], acc[ai][bj][m][n], 0, 0, 0); __builtin_amdgcn_s_setprio(0); } while (0)
#define G8_WAIT_V(n) asm volatile("s_waitcnt vmcnt(" #n ")" ::: "memory")
#define G8_WAIT_L(n) asm volatile("s_waitcnt lgkmcnt(" #n ")" ::: "memory")
#define G8_BAR __builtin_amdgcn_s_barrier()
#define G8_SCHED __builtin_amdgcn_sched_barrier(0)
  Unit cur, nxt; int ui = 0;
  if (!S.next(0, cur)) return;
  f32x4 acc[2][2][4][2];
#pragma unroll
  for (int a = 0; a < 2; ++a)
#pragma unroll
    for (int b = 0; b < 2; ++b)
#pragma unroll
      for (int m = 0; m < 4; ++m)
#pragma unroll
        for (int n = 0; n < 2; ++n) acc[a][b][m][n] = (f32x4){0.f, 0.f, 0.f, 0.f};
  bf16x8 At[4][2], B0[2][2], B1[2][2];
  const char* cA = cur.A; const char* cB = cur.B; unsigned chB = cur.hstepB;
  G8_AOFF(cur, ac00, ac01, ac10, ac11);
  an00 = ac00; an01 = ac01; an10 = ac10; an11 = ac11;
  G8_STAGE(G8_SB(0, 0), cB, voffB0, voffB1); G8_STAGE(G8_SA(0, 0), cA, ac00, ac01); G8_STAGE(G8_SB(0, 1), cB + chB, voffB0, voffB1); G8_STAGE(G8_SA(0, 1), cA, ac10, ac11);
  if (wr == 1) G8_BAR;
  G8_WAIT_V(4); G8_BAR;
  G8_STAGE(G8_SB(1, 0), cB + kstep, voffB0, voffB1); G8_STAGE(G8_SA(1, 0), cA + kstep, ac00, ac01); G8_STAGE(G8_SB(1, 1), cB + chB + kstep, voffB0, voffB1);
  G8_WAIT_V(6); G8_BAR;
  for (;;) {
    const bool has_next = S.next(ui + 1, nxt);
    const char* nA = has_next ? nxt.A : cA; const char* nB = has_next ? nxt.B : cB; const unsigned nhB = has_next ? nxt.hstepB : chB;
    if (GATHER) { if (has_next) G8_AOFF(nxt, an00, an01, an10, an11); else { an00 = ac00; an01 = ac01; an10 = ac10; an11 = ac11; } }
    for (int t = 0; t < nt; t += 2) {
      const bool last = (t == nt - 2);
      const char* a1 = cA + (size_t)(t + 1) * kstep;
      const char* a2 = last ? nA : cA + (size_t)(t + 2) * kstep; const char* b2 = last ? nB : cB + (size_t)(t + 2) * kstep;
      const char* a3 = a2 + kstep; const char* b3 = b2 + kstep;
      const unsigned hb2 = last ? nhB : chB;
      const unsigned x00 = last ? an00 : ac00, x01 = last ? an01 : ac01, x10 = last ? an10 : ac10, x11 = last ? an11 : ac11;
      G8_LDB(B0, 0, 0); G8_SCHED; G8_LDA(At, 0, 0); G8_STAGE(G8_SA(1, 1), a1, ac10, ac11);
      G8_WAIT_L(8); G8_BAR; G8_WAIT_L(0); G8_MMA(0, 0, At, B0); G8_BAR; G8_SCHED;
      G8_LDB(B1, 0, 1); G8_STAGE(G8_SB(0, 0), b2, voffB0, voffB1);
      G8_BAR; G8_WAIT_L(0); G8_MMA(0, 1, At, B1); G8_BAR;
      G8_LDA(At, 0, 1); G8_STAGE(G8_SA(0, 0), a2, x00, x01);
      G8_BAR; G8_WAIT_L(0); G8_MMA(1, 0, At, B0); G8_BAR; G8_SCHED;
      G8_STAGE(G8_SB(0, 1), b2 + hb2, voffB0, voffB1);
      G8_WAIT_V(6); G8_BAR; G8_MMA(1, 1, At, B1); G8_BAR;
      G8_LDB(B0, 1, 0); G8_SCHED; G8_LDA(At, 1, 0); G8_STAGE(G8_SA(0, 1), a2, x10, x11);
      G8_WAIT_L(8); G8_BAR; G8_WAIT_L(0); G8_MMA(0, 0, At, B0); G8_BAR; G8_SCHED;
      G8_LDB(B1, 1, 1); G8_STAGE(G8_SB(1, 0), b3, voffB0, voffB1);
      G8_BAR; G8_WAIT_L(0); G8_MMA(0, 1, At, B1); G8_BAR;
      G8_LDA(At, 1, 1); G8_STAGE(G8_SA(1, 0), a3, x00, x01);
      G8_BAR; G8_WAIT_L(0); G8_MMA(1, 0, At, B0); G8_BAR; G8_SCHED;
      G8_STAGE(G8_SB(1, 1), b3 + hb2, voffB0, voffB1);
      G8_WAIT_V(6); G8_BAR; G8_MMA(1, 1, At, B1); G8_BAR;
    }
    E(acc, cur, wr, wc, fr, fq);
    if (!has_next) break;
#pragma unroll
    for (int a = 0; a < 2; ++a)
#pragma unroll
      for (int b = 0; b < 2; ++b)
#pragma unroll
        for (int m = 0; m < 4; ++m)
#pragma unroll
          for (int n = 0; n < 2; ++n) acc[a][b][m][n] = (f32x4){0.f, 0.f, 0.f, 0.f};
    cur = nxt; cA = nA; cB = nB; chB = nhB; ++ui;
    ac00 = an00; ac01 = an01; ac10 = an10; ac11 = an11;
  }
  G8_WAIT_V(0);
  if (wr == 0) G8_BAR;
  G8_BAR;
#undef G8_AOFF
#undef G8_SA
#undef G8_SB
#undef G8_STAGE
#undef G8_LDA
#undef G8_LDB
#undef G8_MMA
#undef G8_WAIT_V
#undef G8_WAIT_L
#undef G8_BAR
#undef G8_SCHED
}

struct SchedDense {
  const char* A; const char* Bt; int K, nM, nN, nwg, G, c;
  __device__ __forceinline__ bool next(int i, Unit& u) const {
    const int L = i * G + c; if (L >= nwg) return false;
    int wgid = L; { const int q = nwg / 8, r = nwg % 8, xcd = wgid % 8, off = wgid / 8; wgid = (xcd < r ? xcd * (q + 1) : r * (q + 1) + (xcd - r) * q) + off; }
    const int nig = 8 * nN, gid = wgid / nig, fm = gid * 8, gsz = (nM - fm) < 8 ? (nM - fm) : 8;
    const int pm = fm + ((wgid % nig) % gsz), pn = (wgid % nig) / gsz;
    u.A = A + (size_t)pm * BM * K * 2; u.B = Bt + (size_t)pn * BM * K * 2; u.hstepB = (unsigned)(HALF * K * 2);
    u.row0 = pm * BM; u.col0 = pn * BM; u.aux = 0; return true;
  }
};
template <int NCOLT, bool GU>
struct SchedMoE {
  const char* A; const char* W; int K; const int* ts; int G, c;
  __device__ __forceinline__ bool next(int i, Unit& u) const {
    const int id = i * G + c; const int ntiles = ts[NE];
    if (id >= ntiles * NCOLT) return false;
    const int tile = id / NCOLT, pn = id % NCOLT;
    int e = 0;
    while (e < NE - 1 && ts[e + 1] <= tile) ++e;
    u.row0 = tile * BM; u.aux = e;
    if (GU) { u.A = A; u.B = W + ((size_t)e * 2048 + pn * 128) * K * 2; u.hstepB = (unsigned)(1024 * K * 2); u.col0 = pn * 128; }
    else { u.A = A + (size_t)tile * BM * K * 2; u.B = W + ((size_t)e * 1024 + pn * 256) * K * 2; u.hstepB = (unsigned)(HALF * K * 2); u.col0 = pn * 256; }
    return true;
  }
};

struct EpiF32 {
  float* C; const float* resid; int ldc;
  __device__ __forceinline__ void operator()(const f32x4 (&acc)[2][2][4][2], const Unit& u, int wr, int wc, int fr, int fq) const {
    const int row0 = u.row0 + wr * 64 + fr, col0 = u.col0 + wc * 32 + 4 * fq;
#pragma unroll
    for (int ai = 0; ai < 2; ++ai)
#pragma unroll
      for (int m = 0; m < 4; ++m) {
        const size_t ro = (size_t)(row0 + ai * HALF + m * 16) * ldc + col0;
#pragma unroll
        for (int bj = 0; bj < 2; ++bj)
#pragma unroll
          for (int n = 0; n < 2; ++n) {
            f32x4 v = acc[ai][bj][m][n];
            if (resid) v += *(const f32x4*)(resid + ro + bj * HALF + n * 16);
            *(f32x4*)(C + ro + bj * HALF + n * 16) = v;
          }
      }
  }
};
struct EpiGU {
  u16* O; const float* bias_all;
  __device__ __forceinline__ void operator()(const f32x4 (&acc)[2][2][4][2], const Unit& u, int wr, int wc, int fr, int fq) const {
    const float* bias = bias_all + (size_t)u.aux * 2048;
    const int row0 = u.row0 + wr * 64 + fr, col0 = u.col0 + wc * 32 + 4 * fq;
    f32x4 bg[2], bl[2];
#pragma unroll
    for (int n = 0; n < 2; ++n) { bg[n] = *(const f32x4*)(bias + col0 + n * 16); bl[n] = *(const f32x4*)(bias + 1024 + col0 + n * 16); }
#pragma unroll
    for (int ai = 0; ai < 2; ++ai)
#pragma unroll
      for (int m = 0; m < 4; ++m) {
        u16* rowp = O + (size_t)(row0 + ai * HALF + m * 16) * 1024 + col0;
#pragma unroll
        for (int n = 0; n < 2; ++n) {
          const f32x4 g4 = acc[ai][0][m][n] + bg[n], l4 = acc[ai][1][m][n] + bl[n];
          float a[4];
#pragma unroll
          for (int j = 0; j < 4; ++j) {
            const float glu = fminf(g4[j], 7.f), lin = fminf(fmaxf(l4[j], -7.f), 7.f);
            a[j] = (lin + 1.f) * glu * (1.f / (1.f + __expf(-1.702f * glu)));
          }
          uint2 w; w.x = pack2bf(a[0], a[1]); w.y = pack2bf(a[2], a[3]);
          *(uint2*)(rowp + n * 16) = w;
        }
      }
  }
};
struct EpiDN {
  u16* O; const float* bias_all;
  __device__ __forceinline__ void operator()(const f32x4 (&acc)[2][2][4][2], const Unit& u, int wr, int wc, int fr, int fq) const {
    const float* bias = bias_all + (size_t)u.aux * 1024;
    const int row0 = u.row0 + wr * 64 + fr, col0 = u.col0 + wc * 32 + 4 * fq;
    f32x4 bv[2][2];
#pragma unroll
    for (int bj = 0; bj < 2; ++bj)
#pragma unroll
      for (int n = 0; n < 2; ++n) bv[bj][n] = *(const f32x4*)(bias + col0 + bj * HALF + n * 16);
#pragma unroll
    for (int ai = 0; ai < 2; ++ai)
#pragma unroll
      for (int m = 0; m < 4; ++m) {
        u16* rowp = O + (size_t)(row0 + ai * HALF + m * 16) * 1024 + col0;
#pragma unroll
        for (int bj = 0; bj < 2; ++bj)
#pragma unroll
          for (int n = 0; n < 2; ++n) {
            const f32x4 v = acc[ai][bj][m][n] + bv[bj][n];
            uint2 w; w.x = pack2bf(v[0], v[1]); w.y = pack2bf(v[2], v[3]);
            *(uint2*)(rowp + bj * HALF + n * 16) = w;
          }
      }
  }
};
}

constexpr int SM_TAIL = 157 * 1024;
__device__ void phase_gemm_in(const Params& p, char* smem) {
  g8::SchedDense S{(const char*)(p.ws + OFF_XN), (const char*)(p.ws + OFF_WINT), D, T / 256, DINP / 256, (T / 256) * (DINP / 256), (int)gridDim.x, (int)blockIdx.x};
  g8::EpiF32 E{(float*)(p.ws + OFF_Z), nullptr, DINP};
  g8::gemm_phase<g8::SchedDense, g8::EpiF32, false>((LAS unsigned char*)smem, D, S, E, nullptr);
}

__device__ void phase_post_attn(const Params& p) {
  const float* z = (const float*)(p.ws + OFF_Z);
  u16* qr = (u16*)(p.ws + OFF_QR); u16* kr = (u16*)(p.ws + OFF_KR); u16* vv = (u16*)(p.ws + OFF_VV);
  u16* iq = (u16*)(p.ws + OFF_IQ); u16* ik = (u16*)(p.ws + OFF_IK); float* iw = (float*)(p.ws + OFF_IW);
  const float INVF8[8] = {1.0f, 0.1939227432012558f, 0.03760603070259094f, 0.007292664609849453f,
                          0.0014142135623842478f, 0.00027424818836152554f, 5.318296098266728e-05f, 1.0313386155758053e-05f};
  const float INVF4[4] = {1.0f, 0.03760603070259094f, 0.0014142135623842478f, 5.318296098266728e-05f};
  int lane = threadIdx.x & 63, wid = threadIdx.x >> 6;
  int gw = blockIdx.x * 8 + wid, nw = gridDim.x * 8;
  const int sub = lane & 7;
  float* qsh = (float*)(p.ws + OFF_QSH);
  float kwmax = fabsf(p.k_norm_w[lane]);
#pragma unroll
  for (int o = 32; o >= 1; o >>= 1) kwmax = fmaxf(kwmax, __shfl_xor(kwmax, o));
  for (int t = gw; t < T; t += nw) {
    const float* zr = z + (size_t)t * DINP;
    const float pos = (float)p.positions[t];
    float cs8[8], sn8[8];
#pragma unroll
    for (int i = 0; i < 8; ++i) sincos_big(pos * INVF8[i], sn8[i], cs8[i]);
#pragma unroll
    for (int which = 0; which < 2; ++which) {
      const float* src = zr + (which ? C_K : C_Q) + lane * 8;
      const float* nw_ = (which ? p.k_norm_w : p.q_norm_w) + sub * 8;
      float4 a = *(const float4*)src, b = *(const float4*)(src + 4);
      float v[8] = {a.x, a.y, a.z, a.w, b.x, b.y, b.z, b.w};
      float ss = 0.f;
#pragma unroll
      for (int i = 0; i < 8; ++i) ss += v[i] * v[i];
      ss += __shfl_xor(ss, 1); ss += __shfl_xor(ss, 2); ss += __shfl_xor(ss, 4);
      float rstd = rsqrtf(ss * (1.f / 64.f) + 1e-6f);
      float y[8], o[8];
#pragma unroll
      for (int i = 0; i < 8; ++i) y[i] = v[i] * rstd * nw_[i];
#pragma unroll
      for (int i = 0; i < 8; ++i) {
        float oth = __shfl_xor(y[i], 1);
        float r0 = y[i] * cs8[i] - oth * sn8[i];
        float r1 = y[i] * cs8[i] + oth * sn8[i];
        o[i] = (sub == 0) ? r0 : ((sub == 1) ? r1 : y[i]);
      }
      const float sc = which ? 1.f : (0.125f * 1.4426950408889634f);
      u32 hw[4]; float n2 = 0.f;
#pragma unroll
      for (int i = 0; i < 4; ++i) {
        __half h0 = __float2half_rn(o[2 * i] * sc), h1 = __float2half_rn(o[2 * i + 1] * sc);
        float f0 = __half2float(h0), f1 = __half2float(h1);
        n2 += f0 * f0 + f1 * f1;
        hw[i] = (u32)__half_as_ushort(h0) | ((u32)__half_as_ushort(h1) << 16);
      }
      uint4 w; w.x = hw[0]; w.y = hw[1]; w.z = hw[2]; w.w = hw[3];
      const int hd = lane >> 3;
      *(uint4*)((which ? kr : qr) + ((size_t)hd * T + t) * 64 + sub * 8) = w;
      if (which == 0) {
        n2 += __shfl_xor(n2, 1); n2 += __shfl_xor(n2, 2); n2 += __shfl_xor(n2, 4);
        if (sub == 0) qsh[(size_t)hd * T + t] = sqrtf(n2) * 8.f * kwmax * 1.01f;
      }
    }
    {
      const float* src = zr + C_V + lane * 8;
      float4 a = *(const float4*)src, b = *(const float4*)(src + 4);
      float v[8] = {a.x, a.y, a.z, a.w, b.x, b.y, b.z, b.w};
      u32 hw[4];
#pragma unroll
      for (int i = 0; i < 4; ++i) hw[i] = (u32)__half_as_ushort(__float2half_rn(v[2 * i])) | ((u32)__half_as_ushort(__float2half_rn(v[2 * i + 1])) << 16);
      uint4 w; w.x = hw[0]; w.y = hw[1]; w.z = hw[2]; w.w = hw[3];
      *(uint4*)(vv + ((size_t)(lane >> 3) * T + t) * 64 + sub * 8) = w;
    }
    float cs4[4], sn4[4];
#pragma unroll
    for (int i = 0; i < 4; ++i) sincos_big(pos * INVF4[i], sn4[i], cs4[i]);
    {
      float4 a = *(const float4*)(zr + C_IQ + lane * 4);
      float y[4] = {a.x, a.y, a.z, a.w}, o[4];
#pragma unroll
      for (int i = 0; i < 4; ++i) {
        float oth = __shfl_xor(y[i], 1);
        float r0 = y[i] * cs4[i] - oth * sn4[i];
        float r1 = y[i] * cs4[i] + oth * sn4[i];
        o[i] = (sub == 0) ? r0 : ((sub == 1) ? r1 : y[i]);
      }
      uint2 w; w.x = pack2bf(o[0], o[1]); w.y = pack2bf(o[2], o[3]);
      *(uint2*)(iq + (size_t)t * 256 + lane * 4) = w;
    }
    {
      float4 a = (lane < 8) ? *(const float4*)(zr + C_IK + lane * 4) : make_float4(0, 0, 0, 0);
      float y[4] = {a.x, a.y, a.z, a.w}, o[4];
#pragma unroll
      for (int i = 0; i < 4; ++i) {
        float oth = __shfl_xor(y[i], 1);
        float r0 = y[i] * cs4[i] - oth * sn4[i];
        float r1 = y[i] * cs4[i] + oth * sn4[i];
        o[i] = (sub == 0) ? r0 : ((sub == 1) ? r1 : y[i]);
      }
      if (lane < 8) {
        uint2 w; w.x = pack2bf(o[0], o[1]); w.y = pack2bf(o[2], o[3]);
        *(uint2*)(ik + (size_t)(t >> 5) * 1024 + (size_t)(((lane >> 2) * 2 + ((lane >> 1) & 1)) * 256 + (t & 31) * 8 + (lane & 1) * 4)) = w;
        iw[(size_t)t * 8 + lane] = zr[C_IW + lane];
      }
    }
  }
}

__device__ void phase_post_rwkv(const Params& p, char* smem) {
  const float* z = (const float*)(p.ws + OFF_Z);
  float* sv = (float*)(p.ws + OFF_SV); float* G = (float*)(p.ws + OFF_G); float* BON = (float*)(p.ws + OFF_BONUS);
  float* lora = (float*)smem;
  const int tid = threadIdx.x, lane = tid & 63, h = tid >> 6, c = tid;
  const float mu_r = p.rwkv_mu[c], mu_k = p.rwkv_mu[512 + c], mu_v = p.rwkv_mu[1024 + c];
  const float w0 = p.rwkv_w0[c], a0 = p.rwkv_a0[c], kkw = p.rwkv_k_k[c], kaw = p.rwkv_k_a[c], rkw = p.rwkv_r_k[c];
  float wr2[32], ar2[32], gr2[64];
#pragma unroll
  for (int j = 0; j < 32; ++j) { wr2[j] = p.rwkv_w2[j * 512 + c]; ar2[j] = p.rwkv_a2[j * 512 + c]; }
#pragma unroll
  for (int j = 0; j < 64; ++j) gr2[j] = p.rwkv_g2[j * 512 + c];
  for (int tg = blockIdx.x; tg < T / 8; tg += gridDim.x) {
    const int t0 = tg * 8;
#pragma unroll
    for (int i = 0; i < 2; ++i) {
      int item = tid + 512 * i, tok = item >> 7, j = item & 127, t = t0 + tok;
      int col = C_RW + 1536 + j;
      float zc = z[(size_t)t * DINP + col];
      float zp = (t > 0) ? z[(size_t)(t - 1) * DINP + col] : 0.f;
      float xs = zc + (zp - zc) * p.rwkv_mu[1536 + j];
      float o = (j < 32) ? tanhf(xs) : ((j < 64) ? xs : sigmoidf_(xs));
      lora[tok * 128 + j] = o;
    }
    __syncthreads();
    float zr9[9], zk9[9], zv9[9];
#pragma unroll
    for (int k = 0; k < 9; ++k) {
      const int t = t0 - 1 + k;
      if (t >= 0) { const float* zp_ = z + (size_t)t * DINP + C_RW; zr9[k] = zp_[c]; zk9[k] = zp_[512 + c]; zv9[k] = zp_[1024 + c]; }
      else { zr9[k] = 0.f; zk9[k] = 0.f; zv9[k] = 0.f; }
    }
#pragma unroll
    for (int k = 0; k < 8; ++k) {
      const f32x4* lr = (const f32x4*)(lora + k * 128);
      float w0_ = 0.f, w1_ = 0.f, a0_ = 0.f, a1_ = 0.f, g0_ = 0.f, g1_ = 0.f;
#pragma unroll
      for (int j = 0; j < 8; ++j) {
        const f32x4 lw = lr[j];
        w0_ += lw[0] * wr2[4 * j] + lw[2] * wr2[4 * j + 2]; w1_ += lw[1] * wr2[4 * j + 1] + lw[3] * wr2[4 * j + 3];
      }
      asm volatile("" : "+v"(w0_), "+v"(w1_) :: "memory");
#pragma unroll
      for (int j = 0; j < 8; ++j) {
        const f32x4 la = lr[8 + j];
        a0_ += la[0] * ar2[4 * j] + la[2] * ar2[4 * j + 2]; a1_ += la[1] * ar2[4 * j + 1] + la[3] * ar2[4 * j + 3];
      }
      asm volatile("" : "+v"(a0_), "+v"(a1_) :: "memory");
#pragma unroll
      for (int j = 0; j < 8; ++j) {
        const f32x4 lg = lr[16 + j];
        g0_ += lg[0] * gr2[4 * j] + lg[2] * gr2[4 * j + 2]; g1_ += lg[1] * gr2[4 * j + 1] + lg[3] * gr2[4 * j + 3];
      }
      asm volatile("" : "+v"(g0_), "+v"(g1_) :: "memory");
#pragma unroll
      for (int j = 8; j < 16; ++j) {
        const f32x4 lg = lr[16 + j];
        g0_ += lg[0] * gr2[4 * j] + lg[2] * gr2[4 * j + 2]; g1_ += lg[1] * gr2[4 * j + 1] + lg[3] * gr2[4 * j + 3];
      }
      asm volatile("" : "+v"(g0_), "+v"(g1_) :: "memory");
      const float aw_k = w0_ + w1_, aa_k = a0_ + a1_, ag_k = g0_ + g1_;
      const int t = t0 + k;
      const float rc = zr9[k + 1], kc = zk9[k + 1], vc = zv9[k + 1];
      const float rp = zr9[k], kp = zk9[k], vp = zv9[k];
      float r = rc + (rp - rc) * mu_r, kx = kc + (kp - kc) * mu_k, v = vc + (vp - vc) * mu_v;
      float xw = -(w0 + aw_k);
      float sp = fmaxf(xw, 0.f) + log1pf(__expf(-fabsf(xw)));
      float logw = -sp - 0.5f;
      float decay = __expf(-__expf(logw));
      float a = sigmoidf_(a0 + aa_k);
      float kk = kx * kkw;
      float ss = wave_sum(kk * kk);
      kk *= rsqrtf(fmaxf(ss, 1e-24f));
      float kmod = kx * (1.f + (a - 1.f) * kaw);
      float bon = wave_sum(r * kmod * rkw);
      float* o = sv + ((size_t)t * 8 + h) * 384 + lane;
      o[0] = decay; o[64] = kk; o[128] = kk * a; o[192] = kmod; o[256] = r; o[320] = v;
      G[(size_t)t * 512 + c] = ag_k;
      if (lane == 0) BON[(size_t)t * 8 + h] = bon;
    }
    __syncthreads();
  }
}

typedef float f2 __attribute__((ext_vector_type(2)));
#define SB_ __builtin_amdgcn_sched_barrier(0)
#define PIN16(o) asm volatile("" : "+v"(S2[o+0]), "+v"(S2[o+1]), "+v"(S2[o+2]), "+v"(S2[o+3]), "+v"(S2[o+4]), "+v"(S2[o+5]), "+v"(S2[o+6]), "+v"(S2[o+7]), \
    "+v"(S2[o+8]), "+v"(S2[o+9]), "+v"(S2[o+10]), "+v"(S2[o+11]), "+v"(S2[o+12]), "+v"(S2[o+13]), "+v"(S2[o+14]), "+v"(S2[o+15]) :: "memory")
#define SC_LO(v) ((f2){(v)[0], (v)[1]})
#define SC_HI(v) ((f2){(v)[2], (v)[3]})

__device__ __forceinline__ float dpp_qp1(float v) { return __uint_as_float(__builtin_amdgcn_update_dpp(0u, __float_as_uint(v), 0xB1, 0xF, 0xF, true)); }
__device__ __forceinline__ float dpp_qp2(float v) { return __uint_as_float(__builtin_amdgcn_update_dpp(0u, __float_as_uint(v), 0x4E, 0xF, 0xF, true)); }
__device__ __forceinline__ float red4(float v) { v += dpp_qp1(v); v += dpp_qp2(v); return v; }

#define SCAN_DMA(base, ldsbuf) do { \
    __builtin_amdgcn_global_load_lds((const unsigned*)((base) + go0), (LAS unsigned*)(ldsbuf), 16, 0, 0); \
    __builtin_amdgcn_global_load_lds((const unsigned*)((base) + go1), (LAS unsigned*)((ldsbuf) + 256), 16, 0, 0); \
    __builtin_amdgcn_global_load_lds((const unsigned*)((base) + go2), (LAS unsigned*)((ldsbuf) + 512), 16, 0, 0); \
    __builtin_amdgcn_global_load_lds((const unsigned*)((base) + go3), (LAS unsigned*)((ldsbuf) + 768), 16, 0, 0); \
    __builtin_amdgcn_global_load_lds((const unsigned*)((base) + go4), (LAS unsigned*)((ldsbuf) + 1024), 16, 0, 0); \
    __builtin_amdgcn_global_load_lds((const unsigned*)((base) + go5), (LAS unsigned*)((ldsbuf) + 1280), 16, 0, 0); } while (0)

#define SCV_LD4(V, rec, q) do { const f32x4* rc_ = (const f32x4*)(rec) + (q) + 4 * cb; V[0] = rc_[0]; V[1] = rc_[1]; V[2] = rc_[2]; V[3] = rc_[3]; } while (0)
#define SCV_PAIR(V, jp) (((jp) & 1) ? SC_HI(V[(jp) >> 1]) : SC_LO(V[(jp) >> 1]))

template <int MODE>
__device__ void scan_task(const Params& p, int h, int c, float* wl  ) {
  const int lane = threadIdx.x & 63;
  const int ra = lane >> 2, cb = lane & 3;
  const float* sv = (const float*)(p.ws + OFF_SV);
  f2 S2[32];
  if (MODE == 0) {
#pragma unroll
    for (int i = 0; i < 4; ++i)
#pragma unroll
      for (int jp = 0; jp < 8; ++jp) S2[i * 8 + jp] = (f2){(4 * ra + i == 16 * cb + 2 * jp) ? 1.f : 0.f, (4 * ra + i == 16 * cb + 2 * jp + 1) ? 1.f : 0.f};
  } else if (MODE == 1) {
#pragma unroll
    for (int j = 0; j < 32; ++j) S2[j] = (f2){0.f, 0.f};
  } else {
    const float* si = (const float*)(p.ws + OFF_SI) + (size_t)(h * NCH + c) * 4096 + (4 * ra) * 64 + 16 * cb;
#pragma unroll
    for (int i = 0; i < 4; ++i)
#pragma unroll
      for (int q = 0; q < 4; ++q) { const float4 u = *(const float4*)(si + i * 64 + 4 * q); S2[i * 8 + 2 * q] = (f2){u.x, u.y}; S2[i * 8 + 2 * q + 1] = (f2){u.z, u.w}; }
  }
  float* Y = (float*)(p.ws + OFF_Y);
  const float* src = sv + ((size_t)(c * CHL) * 8 + h) * 384;
  const int f0 = lane, f1 = lane + 64, f2_ = lane + 128, f3 = lane + 192, f4 = lane + 256, f5 = lane + 320;
  const int go0 = (f0 / 96) * 3072 + (f0 % 96) * 4, go1 = (f1 / 96) * 3072 + (f1 % 96) * 4, go2 = (f2_ / 96) * 3072 + (f2_ % 96) * 4;
  const int go3 = (f3 / 96) * 3072 + (f3 % 96) * 4, go4 = (f4 / 96) * 3072 + (f4 % 96) * 4, go5 = (f5 / 96) * 3072 + (f5 % 96) * 4;
  SCAN_DMA(src, wl);
  constexpr int NG = CHL / 4;
  f32x4 KK[4], KN[4];
#define SCAN_STEP(KC, KNX, rec, nrec, tstep) do { \
    f32x4 W_[4], B_[4]; \
    SCV_LD4(W_, rec, 0); SCV_LD4(B_, rec, 32); SB_; \
    float d_[4]; \
    _Pragma("unroll") for (int i = 0; i < 4; ++i) { \
      f2 a_ = S2[i * 8] * SCV_PAIR(KC, 0); \
      _Pragma("unroll") for (int jp = 1; jp < 8; ++jp) a_ += S2[i * 8 + jp] * SCV_PAIR(KC, jp); \
      d_[i] = red4(a_[0] + a_[1]); } \
    asm volatile("" : "+v"(d_[0]), "+v"(d_[1]), "+v"(d_[2]), "+v"(d_[3]) :: "memory"); SB_; \
    f32x4 K_[4]; f32x4 R_[4]; f32x4 v4_ = {0.f, 0.f, 0.f, 0.f}; \
    if (MODE != 0) { SCV_LD4(K_, rec, 48); v4_ = ((const f32x4*)(rec))[80 + ra]; } \
    if (MODE == 2) SCV_LD4(R_, rec, 64); \
    if ((nrec) != nullptr) SCV_LD4(KNX, nrec, 16); \
    SB_; \
    _Pragma("unroll") for (int i = 0; i < 4; ++i) { \
      const f2 ns_ = (f2){-d_[i], -d_[i]}; \
      _Pragma("unroll") for (int jp = 0; jp < 8; ++jp) S2[i * 8 + jp] = S2[i * 8 + jp] * SCV_PAIR(W_, jp) + ns_ * SCV_PAIR(B_, jp); } \
    PIN16(0); PIN16(16); SB_; \
    if (MODE != 0) { \
      _Pragma("unroll") for (int i = 0; i < 4; ++i) { \
        const f2 vi_ = (f2){v4_[i], v4_[i]}; \
        _Pragma("unroll") for (int jp = 0; jp < 8; ++jp) S2[i * 8 + jp] += vi_ * SCV_PAIR(K_, jp); } \
      PIN16(0); PIN16(16); SB_; } \
    if (MODE == 2) { \
      float y_ = 0.f; \
      _Pragma("unroll") for (int i = 0; i < 4; ++i) { \
        f2 a_ = S2[i * 8] * SCV_PAIR(R_, 0); \
        _Pragma("unroll") for (int jp = 1; jp < 8; ++jp) a_ += S2[i * 8 + jp] * SCV_PAIR(R_, jp); \
        const float e_ = red4(a_[0] + a_[1]); \
        y_ = (cb == i) ? e_ : y_; } \
      Y[(size_t)(tstep) * 512 + h * 64 + lane] = y_;         \
      SB_; } \
  } while (0)
  for (int g = 0; g < NG; ++g) {
    asm volatile("s_waitcnt vmcnt(0)" ::: "memory");
    if (g + 1 < NG) SCAN_DMA(src + (size_t)(g + 1) * 4 * 3072, wl + ((g + 1) & 1) * 1536);
    const float* Lb = wl + (g & 1) * 1536;
    const int tb = c * CHL + g * 4;
    SCV_LD4(KK, Lb, 16); SB_;
    SCAN_STEP(KK, KN, Lb, Lb + 384, tb);
    SCAN_STEP(KN, KK, Lb + 384, Lb + 768, tb + 1);
    SCAN_STEP(KK, KN, Lb + 768, Lb + 1152, tb + 2);
    SCAN_STEP(KN, KK, Lb + 1152, (const float*)nullptr, tb + 3);
  }
  if (MODE != 2) {
    float* o = (float*)(p.ws + (MODE == 0 ? OFF_SP : OFF_SL)) + (size_t)(h * NCH + c) * 4096 + (4 * ra) * 64 + 16 * cb;
#pragma unroll
    for (int i = 0; i < 4; ++i)
#pragma unroll
      for (int q = 0; q < 4; ++q) *(float4*)(o + i * 64 + 4 * q) = make_float4(S2[i * 8 + 2 * q][0], S2[i * 8 + 2 * q][1], S2[i * 8 + 2 * q + 1][0], S2[i * 8 + 2 * q + 1][1]);
  }
#undef SCAN_STEP
}

__device__ void phase_scan_a(const Params& p, char* smem) {
  const int wid = __builtin_amdgcn_readfirstlane(threadIdx.x >> 6);
  float* wl = (float*)smem + wid * 3072;
  const int nw = gridDim.x * 8;
  for (int id = wid * (int)gridDim.x + (int)blockIdx.x; id < 8 * NCH; id += nw) scan_task<0>(p, id & 7, id >> 3, wl);
  for (int id = wid * (int)gridDim.x + (int)blockIdx.x; id < 16 * NCH; id += nw) { if (id >= 8 * NCH) scan_task<1>(p, id & 7, (id - 8 * NCH) >> 3, wl); }
}

__device__ __forceinline__ float rdlane(float v, int l) { return __uint_as_float(__builtin_amdgcn_readlane(__float_as_uint(v), l)); }

__device__ void scan_b_row(const Params& p, int h, int row, float* pbuf  ) {
  const int lane = threadIdx.x & 63;
  const float* SP = (const float*)(p.ws + OFF_SP) + (size_t)h * NCH * 4096;
  const float* SL = (const float*)(p.ws + OFF_SL) + (size_t)h * NCH * 4096 + row * 64 + lane;
  float* SI = (float*)(p.ws + OFF_SI) + (size_t)h * NCH * 4096 + row * 64 + lane;
  float sreg = 0.f;
  SI[0] = 0.f;
#define SB_DMA(c_, buf_) do { _Pragma("unroll") for (int i_ = 0; i_ < 16; ++i_) \
    __builtin_amdgcn_global_load_lds((const unsigned*)(SP + (size_t)(c_) * 4096 + (i_ * 64 + lane) * 4), (LAS unsigned*)((buf_) + i_ * 256), 16, 0, 0); } while (0)
  float lcur = SL[0];
  SB_DMA(0, pbuf);
  for (int c = 0; c < NCH - 1; ++c) {
    float* cb = pbuf + (c & 1) * 4096;
    float lnext = 0.f;
    if (c + 1 < NCH - 1) {
      lnext = SL[(size_t)(c + 1) * 4096];
      SB_DMA(c + 1, pbuf + ((c + 1) & 1) * 4096);
      asm volatile("s_waitcnt vmcnt(17)" ::: "memory");
    } else {
      asm volatile("s_waitcnt vmcnt(0)" ::: "memory");
    }
    float a0 = lcur, a1 = 0.f, a2 = 0.f, a3 = 0.f;
#pragma unroll
    for (int k = 0; k < 64; k += 4) {
      a0 = __builtin_fmaf(rdlane(sreg, k), cb[k * 64 + lane], a0); a1 = __builtin_fmaf(rdlane(sreg, k + 1), cb[(k + 1) * 64 + lane], a1);
      a2 = __builtin_fmaf(rdlane(sreg, k + 2), cb[(k + 2) * 64 + lane], a2); a3 = __builtin_fmaf(rdlane(sreg, k + 3), cb[(k + 3) * 64 + lane], a3);
    }
    sreg = (a0 + a1) + (a2 + a3);
    SI[(size_t)(c + 1) * 4096] = sreg;
    lcur = lnext;
  }
#undef SB_DMA
}

__device__ void transpose_convert_wave(const float* src, u16* dst, int R, int C, int nbatch, int id0, int id1, int wv, int nwaves) {
  const int lane = threadIdx.x & 63, ng = lane & 15, g = lane >> 4;
  const int tr = R / 64, tc = C / 64;
#pragma unroll 1
  for (int id = id0 + wv; id < id1; id += nwaves) {
    const int b = id / (tr * tc), rem = id % (tr * tc);
    const int r0 = (rem / tc) * 64, c0 = (rem % tc) * 64;
    const float* s = src + (size_t)b * R * C + (size_t)(r0 + 8 * g) * C + c0 + 4 * ng;
    u16* d = dst + (size_t)b * C * R + (size_t)(c0 + 4 * ng) * R + r0 + 8 * g;
#pragma unroll
    for (int hf = 0; hf < 2; ++hf) {
      float4 v[8];
#pragma unroll
      for (int i = 0; i < 8; ++i) v[i] = *(const float4*)(s + (size_t)(hf * 32 + i) * C);
      uint4 o0, o1, o2, o3;
      o0.x = pack2bf(v[0].x, v[1].x); o0.y = pack2bf(v[2].x, v[3].x); o0.z = pack2bf(v[4].x, v[5].x); o0.w = pack2bf(v[6].x, v[7].x);
      o1.x = pack2bf(v[0].y, v[1].y); o1.y = pack2bf(v[2].y, v[3].y); o1.z = pack2bf(v[4].y, v[5].y); o1.w = pack2bf(v[6].y, v[7].y);
      o2.x = pack2bf(v[0].z, v[1].z); o2.y = pack2bf(v[2].z, v[3].z); o2.z = pack2bf(v[4].z, v[5].z); o2.w = pack2bf(v[6].z, v[7].z);
      o3.x = pack2bf(v[0].w, v[1].w); o3.y = pack2bf(v[2].w, v[3].w); o3.z = pack2bf(v[4].w, v[5].w); o3.w = pack2bf(v[6].w, v[7].w);
      *(uint4*)(d + hf * 32) = o0; *(uint4*)(d + (size_t)R + hf * 32) = o1; *(uint4*)(d + (size_t)2 * R + hf * 32) = o2; *(uint4*)(d + (size_t)3 * R + hf * 32) = o3;
    }
  }
}
constexpr int PREP_GU_TILES = NE * 16 * 32, PREP_DN_TILES = NE * 16 * 16, PREP_TILES = PREP_GU_TILES + PREP_DN_TILES;
constexpr int PREP_SPLIT = 0;
__device__ void prep_expert_range(const Params& p, int lo, int hi, int wv, int nwaves) {
  if (lo < PREP_GU_TILES) transpose_convert_wave(p.exp_w_gu, (u16*)(p.ws + OFF_WGUT), 1024, 2048, NE, lo, hi < PREP_GU_TILES ? hi : PREP_GU_TILES, wv, nwaves);
  if (hi > PREP_GU_TILES) {
    const int l2 = (lo > PREP_GU_TILES ? lo : PREP_GU_TILES) - PREP_GU_TILES;
    transpose_convert_wave(p.exp_w_down, (u16*)(p.ws + OFF_WDNT), 1024, 1024, NE, l2, hi - PREP_GU_TILES, wv, nwaves);
  }
}

__device__ void scan_b_block(const Params& p, int h, int rg, float* ring  ) {
  const int lane = threadIdx.x & 63, w = __builtin_amdgcn_readfirstlane(threadIdx.x >> 6);
  const int row = rg * 8 + w;
  const float* SP = (const float*)(p.ws + OFF_SP) + (size_t)h * NCH * 4096;
  const float* SL = (const float*)(p.ws + OFF_SL) + (size_t)h * NCH * 4096 + row * 64 + lane;
  float* SI = (float*)(p.ws + OFF_SI) + (size_t)h * NCH * 4096 + row * 64 + lane;
  float* lring = ring + 3 * 4096 + w * 192;
  float sreg = 0.f;
  SI[0] = 0.f;
#define SBB_DMA(c_, slot_) do { \
    __builtin_amdgcn_global_load_lds((const unsigned*)(SP + (size_t)(c_) * 4096 + ((2 * w) * 64 + lane) * 4), (LAS unsigned*)(ring + (slot_) * 4096 + (2 * w) * 256), 16, 0, 0); \
    __builtin_amdgcn_global_load_lds((const unsigned*)(SP + (size_t)(c_) * 4096 + ((2 * w + 1) * 64 + lane) * 4), (LAS unsigned*)(ring + (slot_) * 4096 + (2 * w + 1) * 256), 16, 0, 0); \
    __builtin_amdgcn_global_load_lds((const unsigned*)(SL + (size_t)(c_) * 4096), (LAS unsigned*)(lring + (slot_) * 64), 4, 0, 0); } while (0)
  constexpr int LASTC = NCH - 2;
  SBB_DMA(0, 0);
  SBB_DMA(1, 1);
  for (int c = 0; c < NCH - 1; ++c) {
    asm volatile("s_waitcnt vmcnt(3)" ::: "memory");
    __builtin_amdgcn_s_barrier();
    const int cn = (c + 2 <= LASTC) ? (c + 2) : LASTC;
    SBB_DMA(cn, (c + 2) % 3);
    const float* cb = ring + (c % 3) * 4096;
    float a0 = lring[(c % 3) * 64 + lane], a1 = 0.f, a2 = 0.f, a3 = 0.f;
#pragma unroll
    for (int k = 0; k < 64; k += 4) {
      a0 = __builtin_fmaf(rdlane(sreg, k), cb[k * 64 + lane], a0); a1 = __builtin_fmaf(rdlane(sreg, k + 1), cb[(k + 1) * 64 + lane], a1);
      a2 = __builtin_fmaf(rdlane(sreg, k + 2), cb[(k + 2) * 64 + lane], a2); a3 = __builtin_fmaf(rdlane(sreg, k + 3), cb[(k + 3) * 64 + lane], a3);
    }
    sreg = (a0 + a1) + (a2 + a3);
    SI[(size_t)(c + 1) * 4096] = sreg;
  }
  asm volatile("s_waitcnt vmcnt(0)" ::: "memory");
  __syncthreads();
#undef SBB_DMA
}

__device__ void phase_scan_c(const Params& p, char* smem) {
  const int wid = __builtin_amdgcn_readfirstlane(threadIdx.x >> 6);
  const int nw = gridDim.x * 4;
  if (wid < 4) {
    float* wl = (float*)smem + wid * 3072;
    for (int id = wid * (int)gridDim.x + (int)blockIdx.x; id < 8 * NCH; id += nw) scan_task<2>(p, id & 7, id >> 3, wl);
  }
}

__device__ void phase_rwkv_out(const Params& p) {
  const float* Y = (const float*)(p.ws + OFF_Y); const float* sv = (const float*)(p.ws + OFF_SV);
  const float* G = (const float*)(p.ws + OFF_G); const float* BON = (const float*)(p.ws + OFF_BONUS);
  u16* mix = (u16*)(p.ws + OFF_MIX);
  const int tid = threadIdx.x, lane = tid & 63, h = tid >> 6;
  const float lw = p.rwkv_ln_w[tid], lb = p.rwkv_ln_b[tid];
  for (int t = blockIdx.x; t < T; t += gridDim.x) {
    float y = Y[(size_t)t * 512 + tid];
    float mean = wave_sum(y) * (1.f / 64.f);
    float d = y - mean;
    float var = wave_sum(d * d) * (1.f / 64.f);
    float o = d * rsqrtf(var + 64e-5f) * lw + lb;
    float v = sv[((size_t)t * 8 + h) * 384 + 320 + lane];
    o = (o + BON[(size_t)t * 8 + h] * v) * G[(size_t)t * 512 + tid];
    mix[(size_t)t * 1024 + 512 + tid] = f2bf(o);
  }
}

typedef short s16x2 __attribute__((ext_vector_type(2)));
__device__ __forceinline__ float irelu(float x) { return __int_as_float(max(__float_as_int(x), 0)); }
__device__ __forceinline__ u16 score_key(float s) {
  s = fminf(fmaxf(s, -60000.f), 60000.f);
  u16 b = __half_as_ushort(__float2half_rn(s));
  return (b & 0x8000u) ? (u16)(~b) : (u16)(b | 0x8000u);
}

__device__ __forceinline__ void topk_level1(const u32* hq, int lane, u32& Bs, u32& cnt_above) {
  u32 ssum = 0;
#pragma unroll
  for (int d = 0; d < 16; ++d) ssum += hq[16 * lane + d];
  u32 suf = ssum;
#pragma unroll
  for (int off = 1; off < 64; off <<= 1) { u32 o = __shfl_down(suf, off); if (lane + off < 64) suf += o; }
  unsigned long long m = __ballot(suf >= 256u);
  const int Ls = 63 - __clzll(m);
  const u32 above = __shfl(suf, Ls) - __shfl(ssum, Ls);
  const u32 c1 = (lane < 16) ? hq[16 * Ls + lane] : 0u;
  u32 suf2 = c1;
#pragma unroll
  for (int off = 1; off < 16; off <<= 1) { u32 o = __shfl_down(suf2, off); if (lane + off < 64) suf2 += o; }
  unsigned long long m2 = __ballot((lane < 16) && (above + suf2 >= 256u));
  const int js = 63 - __clzll(m2);
  Bs = (u32)(16 * Ls + js);
  cnt_above = above + __shfl(suf2, js) - __shfl(c1, js);
}

constexpr int TK_CAP = 512;
__device__ __forceinline__ u32 topk_candidates(const u16* keys, int n, int c0, int c1, u32 Bs, u32* h2, u16* list, int lane) {
  u32 running = 0;
  for (int it = c0; it < c1; ++it) {
    const int base = it * 512 + lane;
    u32 kv8[8];
#pragma unroll
    for (int e = 0; e < 8; ++e) kv8[e] = keys[base + e * 64];
#pragma unroll
    for (int e = 0; e < 8; ++e) {
      const int idx = base + e * 64;
      const u32 k = kv8[e];
      const u32 bin = k >> 6;
      const bool f = (idx < n) && (bin >= Bs);
      const unsigned long long m = __ballot(f);
      if (m) {
        const u32 r = running + __builtin_amdgcn_mbcnt_hi((u32)(m >> 32), __builtin_amdgcn_mbcnt_lo((u32)m, 0u));
        if (f) {
          if (r < (u32)TK_CAP) list[r] = (u16)idx;
          if (bin == Bs) atomicAdd(&h2[k & 63u], 1u);
        }
        running += (u32)__popcll(m);
      }
    }
  }
  return running;
}

__device__ __forceinline__ void topk_emit(const u16* keys, const u16* list, int cnt, u32 Kstar, u32 need_eq, u32& base_gt, u32& base_eq, u16* selout, int lane) {
  for (int i0 = 0; i0 < cnt; i0 += 64) {
    const int i = i0 + lane;
    const bool v = i < cnt;
    const u32 idx = v ? (u32)list[i] : 0u;
    const u32 k = keys[idx];
    const bool g = v && k > Kstar, q = v && k == Kstar;
    const unsigned long long mg = __ballot(g), me = __ballot(q);
    const u32 gb = base_gt + __builtin_amdgcn_mbcnt_hi((u32)(mg >> 32), __builtin_amdgcn_mbcnt_lo((u32)mg, 0u));
    const u32 eb = base_eq + __builtin_amdgcn_mbcnt_hi((u32)(me >> 32), __builtin_amdgcn_mbcnt_lo((u32)me, 0u));
    if (g) selout[gb + min(eb, need_eq)] = (u16)idx;
    else if (q && eb < need_eq) selout[gb + eb] = (u16)idx;
    base_gt += (u32)__popcll(mg); base_eq += (u32)__popcll(me);
  }
}

__device__ __forceinline__ u32 topk_pass1(const u16* keys, int n, int c0, int c1, u32 Bs, u32* h2, int lane) {
  u32 cg = 0;
  for (int it = c0; it < c1; ++it) {
    const int base = it * 512 + lane * 8;
    uint4 kv = *(const uint4*)(keys + base);
    u32 w[4] = {kv.x, kv.y, kv.z, kv.w};
#pragma unroll
    for (int e = 0; e < 8; ++e) {
      u32 k = (e & 1) ? (w[e >> 1] >> 16) : (w[e >> 1] & 0xFFFFu);
      const bool valid = (base + e < n);
      const u32 bin = k >> 6;
      if (valid && bin == Bs) atomicAdd(&h2[k & 63u], 1u);
      cg += (valid && bin > Bs) ? 1u : 0u;
    }
  }
#pragma unroll
  for (int o = 32; o >= 1; o >>= 1) cg += __shfl_xor(cg, o);
  return cg;
}

__device__ __forceinline__ void topk_pass2(const u16* keys, int n, int c0, int c1, u32 Kstar, u32 need_eq, u32 base_gt, u32 base_eq, u16* selout, int lane) {
  for (int it = c0; it < c1; ++it) {
    const int base = it * 512 + lane * 8;
    uint4 kv = *(const uint4*)(keys + base);
    u32 w[4] = {kv.x, kv.y, kv.z, kv.w};
    bool g[8], q[8];
    u32 lcg = 0, lce = 0, tg = 0, te = 0;
#pragma unroll
    for (int e = 0; e < 8; ++e) {
      u32 k = (e & 1) ? (w[e >> 1] >> 16) : (w[e >> 1] & 0xFFFFu);
      const bool valid = (base + e < n);
      g[e] = valid && k > Kstar; q[e] = valid && k == Kstar;
      const unsigned long long mg = __ballot(g[e]), me = __ballot(q[e]);
      lcg += __builtin_amdgcn_mbcnt_hi((u32)(mg >> 32), __builtin_amdgcn_mbcnt_lo((u32)mg, 0u));
      lce += __builtin_amdgcn_mbcnt_hi((u32)(me >> 32), __builtin_amdgcn_mbcnt_lo((u32)me, 0u));
      tg += __popcll(mg); te += __popcll(me);
    }
    u32 gb = base_gt + lcg, eb = base_eq + lce;
#pragma unroll
    for (int e = 0; e < 8; ++e) {
      if (g[e]) selout[gb + min(eb, need_eq)] = (u16)(base + e);
      else if (q[e] && eb < need_eq) selout[gb + eb] = (u16)(base + e);
      gb += g[e] ? 1u : 0u; eb += q[e] ? 1u : 0u;
    }
    base_gt += tg; base_eq += te;
  }
}

__device__ void phase_topk(const Params& p, char* smem) {
  u16* keys = (u16*)smem;
  u32* hist = (u32*)(smem + 131072);
  u32* hist2 = hist + 4096;
  const u16* iq = (const u16*)(p.ws + OFF_IQ); const u16* ik = (const u16*)(p.ws + OFF_IK);
  const float* iw = (const float*)(p.ws + OFF_IW);
  u16* sel = (u16*)(p.ws + OFF_SEL);
  const int tid = threadIdx.x, lane = tid & 63, wid = tid >> 6;
  const int r = lane & 31, hh = lane >> 5;
  const int ngroups = (T - 256) / 4;
  if (blockIdx.x < 64) scan_b_block(p, blockIdx.x >> 3, blockIdx.x & 7, (float*)smem);
  int* const queue = (int*)(p.ws + OFF_CNT) + 48;
  volatile int* const qslot = (volatile int*)(smem + SM_TAIL + 32);
  for (;;) {
    __syncthreads();
    if (tid == 0) *qslot = atomicAdd(queue, 1);
    __syncthreads();
    const int gq = *qslot;
    if (gq >= ngroups) break;
    const int gsel = ngroups - 1 - gq;
    const int t0 = 256 + gsel * 4;
    for (int i = tid; i < 4096 + 288; i += NTHREADS) hist[i] = 0u;
    __syncthreads();
    PROF_T0(1)
    const u16* iqp = iq + ((size_t)(t0 + (r & 3)) * 8 + (r >> 2)) * 32 + 8 * hh;
    const bf16x8 a0 = *(const bf16x8*)iqp, a1 = *(const bf16x8*)(iqp + 16);
    float wq[16];
#pragma unroll
    for (int i = 0; i < 16; ++i) wq[i] = iw[(size_t)(t0 + (i & 3)) * 8 + 2 * (i >> 2) + hh];
    const int ntiles = (t0 + 4 + 31) >> 5;
#define TK_LOAD(KT, B0, B1) do { if ((KT) < ntiles) { const u16* ikp_ = ik + (size_t)(KT) * 1024 + hh * 256 + r * 8; \
      B0 = *(const bf16x8*)ikp_; B1 = *(const bf16x8*)(ikp_ + 512); } } while (0)
#define TK_TAIL2(SA, SB, LASTT) do { \
      const s16x2 hp_ = __builtin_bit_cast(s16x2, __builtin_amdgcn_cvt_pkrtz(SA, SB)); \
      const s16x2 sh_ = {15, 15}; \
      u32 k2_ = __builtin_bit_cast(u32, hp_) ^ (__builtin_bit_cast(u32, hp_ >> sh_) | 0x80008000u);     \
      if (LASTT) { if (key > t0 + hh) k2_ &= 0xFFFF0000u; if (key > t0 + 2 + hh) k2_ &= 0x0000FFFFu; } \
      keysa[key] = (u16)k2_; keysb[key] = (u16)(k2_ >> 16); \
      if (!(LASTT) || (k2_ & 0xFFFFu)) atomicAdd((u32*)((char*)hista + ((k2_ >> 4) & 0xFFCu)), 1u); \
      if (!(LASTT) || (k2_ >> 16)) atomicAdd((u32*)((char*)histb + ((k2_ >> 20) & 0xFFCu)), 1u); \
    } while (0)
#define TK_PROC(KT, B0, B1) do { \
      const int key = (KT) * 32 + r; \
      f32x16 acc; \
      _Pragma("unroll") for (int i_ = 0; i_ < 16; ++i_) acc[i_] = 0.f; \
      acc = __builtin_amdgcn_mfma_f32_32x32x16_bf16(a0, B0, acc, 0, 0, 0); \
      acc = __builtin_amdgcn_mfma_f32_32x32x16_bf16(a1, B1, acc, 0, 0, 0); \
      float s0 = 0.f, s1 = 0.f, s2 = 0.f, s3 = 0.f; \
      _Pragma("unroll") for (int i_ = 0; i_ < 16; i_ += 4) { \
        s0 = __builtin_fmaf(wq[i_], irelu(acc[i_]), s0); s1 = __builtin_fmaf(wq[i_ + 1], irelu(acc[i_ + 1]), s1); \
        s2 = __builtin_fmaf(wq[i_ + 2], irelu(acc[i_ + 2]), s2); s3 = __builtin_fmaf(wq[i_ + 3], irelu(acc[i_ + 3]), s3); } \
      auto sw01 = __builtin_amdgcn_permlane32_swap(__float_as_uint(s0), __float_as_uint(s1), false, false); \
      auto sw23 = __builtin_amdgcn_permlane32_swap(__float_as_uint(s2), __float_as_uint(s3), false, false); \
      const float sa = __uint_as_float(sw01[0]) + __uint_as_float(sw01[1]);     \
      const float sb = __uint_as_float(sw23[0]) + __uint_as_float(sw23[1]);     \
      if ((KT) == ntiles - 1) TK_TAIL2(sa, sb, true); else TK_TAIL2(sa, sb, false); \
    } while (0)
    u32* const hista = hist + hh * 1024;
    u32* const histb = hist + (2 + hh) * 1024;
    u16* const keysa = keys + hh * 16384;
    u16* const keysb = keys + (2 + hh) * 16384;
    {
      bf16x8 bA0, bA1, bB0, bB1, bC0, bC1, bD0, bD1, bE0, bE1, bF0, bF1, bG0, bG1, bH0, bH1;
      bA0 = bA1 = bB0 = bB1 = bC0 = bC1 = bD0 = bD1 = bE0 = bE1 = bF0 = bF1 = bG0 = bG1 = bH0 = bH1 = a0;
      int kt = wid;
#define TK_LOADP(KT, B0, B1) do { const int kc_ = (KT) < ntiles ? (KT) : ntiles - 1; const u16* ikp_ = ik + (size_t)kc_ * 1024 + hh * 256 + r * 8; \
      B0 = *(const bf16x8*)ikp_; B1 = *(const bf16x8*)(ikp_ + 512); } while (0)
      TK_LOADP(kt, bA0, bA1); TK_LOADP(kt + 8, bB0, bB1); TK_LOADP(kt + 16, bC0, bC1); TK_LOADP(kt + 24, bD0, bD1);
      TK_LOADP(kt + 32, bE0, bE1); TK_LOADP(kt + 40, bF0, bF1); TK_LOADP(kt + 48, bG0, bG1); TK_LOADP(kt + 56, bH0, bH1);
#define TK_LOADC(KT, B0, B1) do { const int kc_ = (KT) < ntiles ? (KT) : ntiles - 1; const u16* ikp_ = ik + (size_t)kc_ * 1024 + hh * 256 + r * 8; \
      B0 = *(const bf16x8*)ikp_; B1 = *(const bf16x8*)(ikp_ + 512); } while (0)
      for (; kt + 56 < ntiles; kt += 64) {
        TK_PROC(kt, bA0, bA1); TK_LOADC(kt + 64, bA0, bA1);
        TK_PROC(kt + 8, bB0, bB1); TK_LOADC(kt + 72, bB0, bB1);
        TK_PROC(kt + 16, bC0, bC1); TK_LOADC(kt + 80, bC0, bC1);
        TK_PROC(kt + 24, bD0, bD1); TK_LOADC(kt + 88, bD0, bD1);
        TK_PROC(kt + 32, bE0, bE1); TK_LOADC(kt + 96, bE0, bE1);
        TK_PROC(kt + 40, bF0, bF1); TK_LOADC(kt + 104, bF0, bF1);
        TK_PROC(kt + 48, bG0, bG1); TK_LOADC(kt + 112, bG0, bG1);
        TK_PROC(kt + 56, bH0, bH1); TK_LOADC(kt + 120, bH0, bH1);
      }
      if (kt < ntiles) {
        TK_PROC(kt, bA0, bA1);
        if (kt + 8 < ntiles) TK_PROC(kt + 8, bB0, bB1);
        if (kt + 16 < ntiles) TK_PROC(kt + 16, bC0, bC1);
        if (kt + 24 < ntiles) TK_PROC(kt + 24, bD0, bD1);
        if (kt + 32 < ntiles) TK_PROC(kt + 32, bE0, bE1);
        if (kt + 40 < ntiles) TK_PROC(kt + 40, bF0, bF1);
        if (kt + 48 < ntiles) TK_PROC(kt + 48, bG0, bG1);
      }
    }
    __syncthreads();
    PROF_T1(1)
    PROF_T0(2)
    {
      const int q = wid & 3, half = wid >> 2;
      const int tq = t0 + q, n = tq + 1;
      const u16* kq = keys + q * 16384;
      u32* h2 = hist2 + q * 64;
      u32* misc = hist2 + 256 + q * 4;
      u16* lists = (u16*)(hist2 + 288);
      u16* mylist = lists + (q * 2 + half) * TK_CAP;
      const int niter = (n + 511) >> 9, nh = (niter + 1) >> 1;
      const int c0 = half ? nh : 0, c1 = half ? niter : nh;
      u32 Bs, cnt_above;
      topk_level1(hist + q * 1024, lane, Bs, cnt_above);
      const u32 nc = topk_candidates(kq, n, c0, c1, Bs, h2, mylist, lane);
      if (lane == 0) misc[half] = nc;
      __syncthreads();
      if (half == 0) {
        const u32 c2 = h2[lane];
        const u32 need = 256u - cnt_above;
        u32 suf3 = c2;
#pragma unroll
        for (int off = 1; off < 64; off <<= 1) { u32 o = __shfl_down(suf3, off); if (lane + off < 64) suf3 += o; }
        unsigned long long m3 = __ballot(suf3 >= need);
        const int vs = 63 - __clzll(m3);
        const u32 Kstar = (Bs << 6) | (u32)vs;
        const u32 cnt_gt = cnt_above + __shfl(suf3, vs) - __shfl(c2, vs);
        const u32 need_eq = 256u - cnt_gt;
        const u32 na = misc[0], nb = misc[1];
        u16* so = sel + (size_t)tq * 256;
        if (na <= (u32)TK_CAP && nb <= (u32)TK_CAP) {
          u32 bg = 0, be = 0;
          topk_emit(kq, lists + (q * 2) * TK_CAP, (int)na, Kstar, need_eq, bg, be, so, lane);
          topk_emit(kq, lists + (q * 2 + 1) * TK_CAP, (int)nb, Kstar, need_eq, bg, be, so, lane);
        } else {
          topk_pass2(kq, n, 0, niter, Kstar, need_eq, 0u, 0u, so, lane);
        }
      }
    }
    __syncthreads();
    PROF_T1(2)
  }
}

typedef _Float16 h2_t __attribute__((ext_vector_type(2)));
__device__ __forceinline__ float dot2h(u32 a, u32 b, float c) { return __builtin_amdgcn_fdot2(__builtin_bit_cast(h2_t, a), __builtin_bit_cast(h2_t, b), c, false); }
__device__ __forceinline__ float hlo(u32 a) { return (float)(__builtin_bit_cast(h2_t, a)[0]); }
__device__ __forceinline__ float hhi(u32 a) { return (float)(__builtin_bit_cast(h2_t, a)[1]); }

__device__ __forceinline__ float dpp_xor1(float v) {
  return __uint_as_float(__builtin_amdgcn_update_dpp(0u, __float_as_uint(v), 0xB1, 0xF, 0xF, true));
}

constexpr int PREP_HALF_TILES = 2 * PREP_TILES;
__device__ __forceinline__ void prep_half_addr(const Params& p, int hid, int lane, const float*& s, u16*& d, int& C) {
  const int ng = lane & 15, g = lane >> 4;
  const int tile = hid >> 1, hf = hid & 1;
  const bool gu = tile < PREP_GU_TILES;
  const int id = gu ? tile : tile - PREP_GU_TILES;
  const int tc = gu ? 32 : 16;
  C = gu ? 2048 : 1024;
  const float* src = gu ? p.exp_w_gu : p.exp_w_down;
  u16* dst = (u16*)(p.ws + (gu ? OFF_WGUT : OFF_WDNT));
  const int b = id / (16 * tc), rem = id % (16 * tc);
  const int r0 = (rem / tc) * 64 + hf * 32 + 8 * g, c0 = (rem % tc) * 64 + 4 * ng;
  s = src + (size_t)b * 1024 * C + (size_t)r0 * C + c0;
  d = dst + (size_t)b * C * 1024 + (size_t)c0 * 1024 + r0;
}
#define PREP_HALF_LOAD(s_, C_) do { pv0 = *(const float4*)(s_); pv1 = *(const float4*)((s_) + (size_t)(C_)); pv2 = *(const float4*)((s_) + (size_t)2 * (C_)); \
    pv3 = *(const float4*)((s_) + (size_t)3 * (C_)); pv4 = *(const float4*)((s_) + (size_t)4 * (C_)); pv5 = *(const float4*)((s_) + (size_t)5 * (C_)); \
    pv6 = *(const float4*)((s_) + (size_t)6 * (C_)); pv7 = *(const float4*)((s_) + (size_t)7 * (C_)); } while (0)
#define PREP_HALF_STORE(d_) do { uint4 o0_, o1_, o2_, o3_; \
    o0_.x = pack2bf(pv0.x, pv1.x); o0_.y = pack2bf(pv2.x, pv3.x); o0_.z = pack2bf(pv4.x, pv5.x); o0_.w = pack2bf(pv6.x, pv7.x); \
    o1_.x = pack2bf(pv0.y, pv1.y); o1_.y = pack2bf(pv2.y, pv3.y); o1_.z = pack2bf(pv4.y, pv5.y); o1_.w = pack2bf(pv6.y, pv7.y); \
    o2_.x = pack2bf(pv0.z, pv1.z); o2_.y = pack2bf(pv2.z, pv3.z); o2_.z = pack2bf(pv4.z, pv5.z); o2_.w = pack2bf(pv6.z, pv7.z); \
    o3_.x = pack2bf(pv0.w, pv1.w); o3_.y = pack2bf(pv2.w, pv3.w); o3_.z = pack2bf(pv4.w, pv5.w); o3_.w = pack2bf(pv6.w, pv7.w); \
    *(uint4*)(d_) = o0_; *(uint4*)((d_) + 1024) = o1_; *(uint4*)((d_) + 2048) = o2_; *(uint4*)((d_) + 3072) = o3_; } while (0)

__device__ void phase_attn(const Params& p, char* smem) {
  const u16* qh = (const u16*)(p.ws + OFF_QR); const u16* kh = (const u16*)(p.ws + OFF_KR); const u16* vh = (const u16*)(p.ws + OFF_VV);
  const u16* sel = (const u16*)(p.ws + OFF_SEL); const float* qsh = (const float*)(p.ws + OFF_QSH);
  u16* mix = (u16*)(p.ws + OFF_MIX);
  uint4* sK = (uint4*)smem;
  uint4* sV = (uint4*)(smem + 65536);
  const int tid = threadIdx.x;
  const int ql = tid >> 1, hp = tid & 1, rot = (tid >> 1) & 3;
  const int pwid = __builtin_amdgcn_readfirstlane(tid >> 6), plane = tid & 63;
  int pslot = 0;
  float4 pv0, pv1, pv2, pv3, pv4, pv5, pv6, pv7;
  for (int it2 = 0; it2 < 2; ++it2) {
    const int item0 = it2 ? (511 - (int)blockIdx.x) : (int)blockIdx.x;
    for (int item = item0; item >= 0 && item < 512; item += (it2 ? -(int)gridDim.x : (int)gridDim.x)) {
      if (it2 == 0 && item >= 256) break;
      if (it2 == 1 && item < 256) break;
      const int h = item & 7, qb = item >> 3;
      const int t = qb * 256 + ql;
      const uint4* qp = (const uint4*)(qh + ((size_t)h * T + t) * 64) + 4 * hp;
      const uint4 q0 = qp[(0 + rot) & 3], q1 = qp[(1 + rot) & 3], q2 = qp[(2 + rot) & 3], q3 = qp[(3 + rot) & 3];
      const float nshift = -0.5f * qsh[(size_t)h * T + t];
      float acc[32];
#pragma unroll
      for (int i = 0; i < 32; ++i) acc[i] = 0.f;
      float lsum = 0.f;
      const int nsel = (t + 1 < 256) ? (t + 1) : 256;
      const bool dense = t < 256;
      const uint4* sp = (const uint4*)(sel + (size_t)t * 256);
      u16* const win = (u16*)(smem + 131072) + ql * 32;
      int ptr = 0, wbase = 0;
      const int nchunks = (qb >> 1) + 1;
      const int o0 = 4 * hp + ((0 + rot) & 3), o1 = 4 * hp + ((1 + rot) & 3), o2 = 4 * hp + ((2 + rot) & 3), o3 = 4 * hp + ((3 + rot) & 3);
      uint4 t0, t1, t2, t3, t4, t5, t6, t7, u0, u1, u2, u3, u4, u5, u6, u7, wv0, wv1;
#define ATT_CLOAD(cc) do { \
        const uint4* kg = (const uint4*)(kh + ((size_t)h * T + (cc) * 512) * 64) + tid; \
        const uint4* vg = (const uint4*)(vh + ((size_t)h * T + (cc) * 512) * 64) + tid; \
        t0 = kg[0]; t1 = kg[512]; t2 = kg[1024]; t3 = kg[1536]; t4 = kg[2048]; t5 = kg[2560]; t6 = kg[3072]; t7 = kg[3584]; \
        u0 = vg[0]; u1 = vg[512]; u2 = vg[1024]; u3 = vg[1536]; u4 = vg[2048]; u5 = vg[2560]; u6 = vg[3072]; u7 = vg[3584]; } while (0)
#define ATT_WLOAD() do { const int wi_ = (wbase >> 3) + 2 * hp; wv0 = sp[wi_ < 31 ? wi_ : 31]; wv1 = sp[wi_ + 1 < 31 ? wi_ + 1 : 31]; } while (0)
#define ATT_WSTORE() do { *(uint4*)(win + 16 * hp) = wv0; *(uint4*)(win + 16 * hp + 8) = wv1; } while (0)
      ATT_CLOAD(0);
      ATT_WLOAD();
      for (int c = 0; c < nchunks; ++c) {
        PROF_T0(3)
        __syncthreads();
        {
          uint4* dk = sK + tid; uint4* dv = sV + tid;
          dk[0] = t0; dk[512] = t1; dk[1024] = t2; dk[1536] = t3; dk[2048] = t4; dk[2560] = t5; dk[3072] = t6; dk[3584] = t7;
          dv[0] = u0; dv[512] = u1; dv[1024] = u2; dv[1536] = u3; dv[2048] = u4; dv[2560] = u5; dv[3072] = u6; dv[3584] = u7;
          ATT_WSTORE();
        }
        __syncthreads();
        PROF_T1(3)
        PROF_T0(4)
        if (c + 1 < nchunks) ATT_CLOAD(c + 1);
        const int phid = (pslot * (int)gridDim.x + (int)blockIdx.x) * 8 + pwid;
        ++pslot;
        u16* pd = nullptr;
        if (phid < PREP_HALF_TILES) { const float* ps; int pC; prep_half_addr(p, phid, plane, ps, pd, pC); PREP_HALF_LOAD(ps, pC); }
        const int cbase = c * 512, cend = cbase + 512;
        int nextidx = dense ? ptr : (int)win[ptr - wbase];
        while (ptr < nsel && nextidx < cend) {
          const int lk = nextidx - cbase;
          const uint4* krow = sK + lk * 8;
          const uint4* vrow = sV + lk * 8;
          ++ptr;
          int nidx2 = ptr;
          if (!dense) {
            if (ptr - wbase >= 32) { wbase = ptr & ~7; ATT_WLOAD(); ATT_WSTORE(); }
            nidx2 = (int)win[ptr - wbase];
          }
          const uint4 ka = krow[o0], kb = krow[o1], kc = krow[o2], kd = krow[o3];
          const uint4 va = vrow[o0], vb = vrow[o1], vc = vrow[o2], vd = vrow[o3];
          float d0 = nshift, d1 = 0.f, d2 = 0.f, d3 = 0.f;
#define ATT_DOT(Q, KV) { d0 = dot2h(Q.x, KV.x, d0); d1 = dot2h(Q.y, KV.y, d1); d2 = dot2h(Q.z, KV.z, d2); d3 = dot2h(Q.w, KV.w, d3); }
          ATT_DOT(q0, ka) ATT_DOT(q1, kb) ATT_DOT(q2, kc) ATT_DOT(q3, kd)
          float d = (d0 + d1) + (d2 + d3);
          d += dpp_xor1(d);
          const float pe = __builtin_amdgcn_exp2f(d);
          lsum += pe;
#define ATT_MIX(A, W) do { asm("v_fma_mix_f32 %0, %2, %3, %0 op_sel_hi:[0,1,0]\n\tv_fma_mix_f32 %1, %2, %3, %1 op_sel:[0,1,0] op_sel_hi:[0,1,0]" \
            : "+v"(acc[A]), "+v"(acc[(A) + 1]) : "v"(pe), "v"(W)); } while (0)
#define ATT_PV(J, VV) { ATT_MIX(8 * J + 0, VV.x); ATT_MIX(8 * J + 2, VV.y); ATT_MIX(8 * J + 4, VV.z); ATT_MIX(8 * J + 6, VV.w); }
          ATT_PV(0, va) ATT_PV(1, vb) ATT_PV(2, vc) ATT_PV(3, vd)
          nextidx = nidx2;
        }
        PROF_T1(4)
        if (phid < PREP_HALF_TILES) PREP_HALF_STORE(pd);
        if (!dense) { wbase = ptr & ~7; ATT_WLOAD(); }
      }
#undef ATT_CLOAD
#undef ATT_WLOAD
#undef ATT_WSTORE
      const float inv = 1.f / lsum;
      u16* orow = mix + (size_t)t * 1024 + h * 64;
#define ATT_OUT(J, O) { uint4 o; o.x = pack2bf(acc[8 * J] * inv, acc[8 * J + 1] * inv); o.y = pack2bf(acc[8 * J + 2] * inv, acc[8 * J + 3] * inv); \
        o.z = pack2bf(acc[8 * J + 4] * inv, acc[8 * J + 5] * inv); o.w = pack2bf(acc[8 * J + 6] * inv, acc[8 * J + 7] * inv); *(uint4*)(orow + (O) * 8) = o; }
      ATT_OUT(0, o0) ATT_OUT(1, o1) ATT_OUT(2, o2) ATT_OUT(3, o3)
    }
  }
  for (;; ++pslot) {
    const int phid = (pslot * (int)gridDim.x + (int)blockIdx.x) * 8 + pwid;
    if (phid >= PREP_HALF_TILES) break;
    const float* ps; u16* pd; int pC; prep_half_addr(p, phid, plane, ps, pd, pC); PREP_HALF_LOAD(ps, pC); PREP_HALF_STORE(pd);
  }
}

__device__ void phase_gemm_out(const Params& p, char* smem) {
  g8::SchedDense S{(const char*)(p.ws + OFF_MIX), (const char*)(p.ws + OFF_WOUTT), 1024, T / 256, 4, (T / 256) * 4, (int)gridDim.x, (int)blockIdx.x};
  g8::EpiF32 E{(float*)(p.ws + OFF_H1), p.x, 1024};
  g8::gemm_phase<g8::SchedDense, g8::EpiF32, false>((LAS unsigned char*)smem, 1024, S, E, nullptr);
}

__device__ void phase_router(const Params& p, char* smem) {
  const float* h1 = (const float*)(p.ws + OFF_H1);
  u16* xn2 = (u16*)(p.ws + OFF_XN);
  int* toke = (int*)(p.ws + OFF_TOKE); float* tokg = (float*)(p.ws + OFF_TOKG); int* tokp = (int*)(p.ws + OFF_TOKP);
  int* cnt = (int*)(p.ws + OFF_CNT);
  const int tid = threadIdx.x, lane = tid & 63, wid = tid >> 6;
  const int e = lane & 31, kh = lane >> 5;
  float* xs = (float*)smem;
  float* part = (float*)(smem + 65536);
  float wreg[64];
  {
    const int k0 = wid * 128 + kh * 64;
#pragma unroll
    for (int j = 0; j < 64; ++j) wreg[j] = p.router_w[(size_t)(k0 + j) * 32 + e] * p.norm2_w[k0 + j];
  }
  const float rb = p.router_b[e];
  float4 nw4[4];
#pragma unroll
  for (int i = 0; i < 4; ++i) nw4[i] = ((const float4*)p.norm2_w)[lane + 64 * i];
  for (int b0 = blockIdx.x * 16; b0 < T; b0 += gridDim.x * 16) {
    float4 va[4], vb[4];
    {
      const float4* hra = (const float4*)(h1 + (size_t)(b0 + wid * 2) * D);
      const float4* hrb = hra + D / 4;
#pragma unroll
      for (int i = 0; i < 4; ++i) { va[i] = hra[lane + 64 * i]; vb[i] = hrb[lane + 64 * i]; }
    }
    __syncthreads();
    float ssa = 0.f, ssb = 0.f;
#pragma unroll
    for (int i = 0; i < 4; ++i) {
      ssa += va[i].x * va[i].x + va[i].y * va[i].y + va[i].z * va[i].z + va[i].w * va[i].w;
      ssb += vb[i].x * vb[i].x + vb[i].y * vb[i].y + vb[i].z * vb[i].z + vb[i].w * vb[i].w;
    }
#pragma unroll
    for (int o = 32; o >= 1; o >>= 1) { ssa += __shfl_xor(ssa, o); ssb += __shfl_xor(ssb, o); }
    const float rsa = rsqrtf(ssa * (1.f / D) + 1e-6f), rsb = rsqrtf(ssb * (1.f / D) + 1e-6f);
#pragma unroll
    for (int i = 0; i < 4; ++i) {
      const float4 w = nw4[i];
      const float4 ya = make_float4(va[i].x * rsa, va[i].y * rsa, va[i].z * rsa, va[i].w * rsa);
      const float4 yb = make_float4(vb[i].x * rsb, vb[i].y * rsb, vb[i].z * rsb, vb[i].w * rsb);
      *(float4*)(xs + (wid * 2) * 1024 + (lane + 64 * i) * 4) = ya;
      *(float4*)(xs + (wid * 2 + 1) * 1024 + (lane + 64 * i) * 4) = yb;
      uint2 oa, ob; oa.x = pack2bf(ya.x * w.x, ya.y * w.y); oa.y = pack2bf(ya.z * w.z, ya.w * w.w);
      ob.x = pack2bf(yb.x * w.x, yb.y * w.y); ob.y = pack2bf(yb.z * w.z, yb.w * w.w);
      *(uint2*)(xn2 + (size_t)(b0 + wid * 2) * D + (lane + 64 * i) * 4) = oa;
      *(uint2*)(xn2 + (size_t)(b0 + wid * 2 + 1) * D + (lane + 64 * i) * 4) = ob;
    }
    __syncthreads();
    for (int tl = 0; tl < 16; ++tl) {
      const f32x4* xr = (const f32x4*)(xs + tl * 1024 + wid * 128 + kh * 64);
      float a0 = 0.f, a1 = 0.f, a2 = 0.f, a3 = 0.f;
#pragma unroll
      for (int j = 0; j < 16; ++j) {
        const f32x4 x4 = xr[j];
        a0 += x4[0] * wreg[4 * j]; a1 += x4[1] * wreg[4 * j + 1]; a2 += x4[2] * wreg[4 * j + 2]; a3 += x4[3] * wreg[4 * j + 3];
      }
      float a = (a0 + a1) + (a2 + a3);
      a += __shfl_xor(a, 32);
      if (lane < 32) part[(tl * 8 + wid) * 32 + e] = a;
    }
    __syncthreads();
    {
      const int tl = wid * 2 + kh, t = b0 + tl;
      float val = rb;
#pragma unroll
      for (int w = 0; w < 8; ++w) val += part[(tl * 8 + w) * 32 + e];
      float tv[4]; int te[4];
#pragma unroll
      for (int k = 0; k < 4; ++k) {
        float bv = val; int bi = e;
#pragma unroll
        for (int off = 16; off >= 1; off >>= 1) {
          float ov = __shfl_xor(bv, off); int oi = __shfl_xor(bi, off);
          if (ov > bv || (ov == bv && oi < bi)) { bv = ov; bi = oi; }
        }
        tv[k] = bv; te[k] = bi;
        if (e == bi) val = -INFINITY;
      }
      const float m = tv[0];
      float ex[4], s = 0.f;
#pragma unroll
      for (int k = 0; k < 4; ++k) { ex[k] = __expf(tv[k] - m); s += ex[k]; }
      if (e < 4) {
        const int ee = (e == 0) ? te[0] : (e == 1) ? te[1] : (e == 2) ? te[2] : te[3];
        const float gg = ((e == 0) ? ex[0] : (e == 1) ? ex[1] : (e == 2) ? ex[2] : ex[3]) / s;
        const int pos = atomicAdd(&cnt[ee], 1);
        toke[(size_t)t * 4 + e] = ee; tokg[(size_t)t * 4 + e] = gg; tokp[(size_t)t * 4 + e] = pos;
      }
    }
  }
}

__device__ __forceinline__ int expert_tstart(const int* cnt, int e) {
  int s = 0;
  for (int i = 0; i < e; ++i) s += (cnt[i] + 255) >> 8;
  return s;
}

__device__ __forceinline__ int* moe_tile_starts(const Params& p, char* smem) {
  int* ts = (int*)(smem + SM_TAIL + 64);
  const int* cnt = (const int*)(p.ws + OFF_CNT);
  __syncthreads();
  if (threadIdx.x <= NE) ts[threadIdx.x] = expert_tstart(cnt, threadIdx.x);
  __syncthreads();
  return ts;
}

__device__ void phase_fill_rows(const Params& p, char* smem) {
  const int* toke = (const int*)(p.ws + OFF_TOKE); const int* tokp = (const int*)(p.ws + OFF_TOKP);
  int* rowtok = (int*)(p.ws + OFF_ROWTOK);
  const int* ts = moe_tile_starts(p, smem);
  int gtid = blockIdx.x * NTHREADS + threadIdx.x, gsz = gridDim.x * NTHREADS;
  for (int i = gtid; i < T * 4; i += gsz) rowtok[ts[toke[i]] * 256 + tokp[i]] = i >> 2;
}

__device__ void phase_gemm_gu(const Params& p, char* smem) {
  const int* ts = moe_tile_starts(p, smem);
  g8::SchedMoE<8, true> S{(const char*)(p.ws + OFF_XN), (const char*)(p.ws + OFF_WGUT), 1024, ts, (int)gridDim.x, (int)blockIdx.x};
  g8::EpiGU E{(u16*)(p.ws + OFF_Z), p.exp_b_gu};
  g8::gemm_phase<g8::SchedMoE<8, true>, g8::EpiGU, true>((LAS unsigned char*)smem, 1024, S, E, (const int*)(p.ws + OFF_ROWTOK));
}

__device__ void phase_gemm_dn(const Params& p, char* smem) {
  const int* ts = moe_tile_starts(p, smem);
  g8::SchedMoE<4, false> S{(const char*)(p.ws + OFF_Z), (const char*)(p.ws + OFF_WDNT), 1024, ts, (int)gridDim.x, (int)blockIdx.x};
  g8::EpiDN E{(u16*)(p.ws + OFF_SV), p.exp_b_down};
  g8::gemm_phase<g8::SchedMoE<4, false>, g8::EpiDN, false>((LAS unsigned char*)smem, 1024, S, E, nullptr);
}

__device__ void phase_combine(const Params& p, char* smem) {
  const int* toke = (const int*)(p.ws + OFF_TOKE); const float* tokg = (const float*)(p.ws + OFF_TOKG); const int* tokp = (const int*)(p.ws + OFF_TOKP);
  const float* h1 = (const float*)(p.ws + OFF_H1); const u16* yb = (const u16*)(p.ws + OFF_SV);
  const int* ts = moe_tile_starts(p, smem);
  const int tid = threadIdx.x;
  const int sub = tid & 127, tl = tid >> 7;
  for (int t0 = blockIdx.x * 4; t0 < T; t0 += gridDim.x * 4) {
    const int t = t0 + tl;
    float4 a = *(const float4*)(h1 + (size_t)t * D + sub * 8), b = *(const float4*)(h1 + (size_t)t * D + sub * 8 + 4);
    float o[8] = {a.x, a.y, a.z, a.w, b.x, b.y, b.z, b.w};
#pragma unroll
    for (int k = 0; k < 4; ++k) {
      const int e = toke[t * 4 + k]; const float gte = tokg[t * 4 + k];
      const size_t row = (size_t)ts[e] * 256 + tokp[t * 4 + k];
      uint4 w = *(const uint4*)(yb + row * 1024 + sub * 8);
      u32 ww[4] = {w.x, w.y, w.z, w.w};
#pragma unroll
      for (int i = 0; i < 4; ++i) { o[2 * i] += gte * __uint_as_float(ww[i] << 16); o[2 * i + 1] += gte * __uint_as_float(ww[i] & 0xFFFF0000u); }
    }
    *(float4*)(p.out + (size_t)t * D + sub * 8) = make_float4(o[0], o[1], o[2], o[3]);
    *(float4*)(p.out + (size_t)t * D + sub * 8 + 4) = make_float4(o[4], o[5], o[6], o[7]);
  }
}

enum { PH_INIT = 0, PH_PREP, PH_GEMM_IN, PH_POST, PH_SCAN_A, PH_TOPK, PH_SCAN_B, PH_SCAN_C, PH_ATTN, PH_RWKV_OUT, PH_GEMM_OUT, PH_ROUTER, PH_FILL, PH_GEMM_GU, PH_GEMM_DN, PH_COMBINE, PH_COUNT };

template <int PH>
__device__ __forceinline__ void run_phase(const Params& p, char* smem) {
  if (PH == PH_INIT) { phase_init(p); phase_norm1(p); }
  if (PH == PH_PREP) {
    transpose_convert(p.w_in, (u16*)(p.ws + OFF_WINT), 1024, DIN, DINP, 1, smem, blockIdx.x, gridDim.x);
    transpose_convert(p.w_out, (u16*)(p.ws + OFF_WOUTT), 1024, 1024, 1024, 1, smem, blockIdx.x, gridDim.x);
  }
  if (PH == PH_GEMM_IN) phase_gemm_in(p, smem);
  if (PH == PH_POST) { phase_post_attn(p); phase_post_rwkv(p, smem); }
  if (PH == PH_SCAN_A) phase_scan_a(p, smem);
  if (PH == PH_TOPK) phase_topk(p, smem);
  if (PH == PH_SCAN_B) { }
  if (PH == PH_SCAN_C) phase_scan_c(p, smem);
  if (PH == PH_ATTN) phase_attn(p, smem);
  if (PH == PH_RWKV_OUT) phase_rwkv_out(p);
  if (PH == PH_GEMM_OUT) phase_gemm_out(p, smem);
  if (PH == PH_ROUTER) phase_router(p, smem);
  if (PH == PH_FILL) phase_fill_rows(p, smem);
  if (PH == PH_GEMM_GU) phase_gemm_gu(p, smem);
  if (PH == PH_GEMM_DN) phase_gemm_dn(p, smem);
  if (PH == PH_COMBINE) phase_combine(p, smem);
}

#ifndef FUSED
#define FUSED 1
#endif

template <int PH>
__global__ void __launch_bounds__(NTHREADS) phase_kernel(Params p) {
  extern __shared__ __attribute__((aligned(16))) char smem[];
  run_phase<PH>(p, smem);
}

__host__ __device__ constexpr bool barrier_after(int ph) { return !(ph == PH_INIT || ph == PH_SCAN_B || ph == PH_SCAN_C); }

template <int PH>
__device__ __forceinline__ void run_from(const Params& p, char* smem, cg::grid_group& grid, const XcdBarrier& xb) {
#ifdef REPEAT_PH
  if constexpr (PH == REPEAT_PH) { run_phase<PH>(p, smem); xcd_barrier(xb); }
#endif
  run_phase<PH>(p, smem);
  if constexpr (PH + 1 < PH_COUNT) {
    if constexpr (barrier_after(PH)) xcd_barrier(xb);
    else __syncthreads();
    run_from<PH + 1>(p, smem, grid, xb);
  }
}

__global__ void __launch_bounds__(NTHREADS) fwd_megakernel(Params p) {
  extern __shared__ __attribute__((aligned(16))) char smem[];
  uint4& xb_words = *(uint4*)(smem + SM_TAIL);
  cg::grid_group grid = cg::this_grid();
  if (threadIdx.x == 0) { xb_words = make_uint4(0u, 0u, 0u, 0u); g_prof = 0ull; }
  __syncthreads();
  XcdBarrier xb = xcd_barrier_post((unsigned*)(p.ws + OFF_BAR), (volatile LAS unsigned*)&xb_words);
  if (p.ws == nullptr) grid.sync();
  run_from<0>(p, smem, grid, xb);
  if (PROBE_ID != 0 && blockIdx.x == PROF_BLOCK && threadIdx.x == 0) {
    const unsigned long long t0 = __builtin_amdgcn_s_memrealtime(), w = g_prof * PROF_AMP;
    while (__builtin_amdgcn_s_memrealtime() - t0 < w) __builtin_amdgcn_s_sleep(8);
  }
}

template <int PH>
static void launch_phase(const Params& p, int grid, hipStream_t stream) {
  static bool attr_set = false;
  if (!attr_set) { (void)hipFuncSetAttribute((const void*)phase_kernel<PH>, hipFuncAttributeMaxDynamicSharedMemorySize, LDS_BYTES); attr_set = true; }
  hipLaunchKernelGGL(phase_kernel<PH>, dim3(grid), dim3(NTHREADS), LDS_BYTES, stream, p);
}

template <int PH>
static void launch_all(const Params& p, int grid, hipStream_t stream) {
  launch_phase<PH>(p, grid, stream);
  if constexpr (PH + 1 < PH_COUNT) launch_all<PH + 1>(p, grid, stream);
}

extern "C" void kernel_launch(void* const* d_in, const int* in_sizes, int n_in, void* d_out, int out_size, void* d_ws, size_t ws_size,
                              hipStream_t stream) {
  if (ws_size < WS_NEEDED) { fprintf(stderr, "workspace too small: %zu < %zu\n", ws_size, (size_t)WS_NEEDED); return; }
  Params p{};
  p.x = (const float*)d_in[0]; p.positions = (const int*)d_in[1]; p.norm1_w = (const float*)d_in[2]; p.w_in = (const float*)d_in[3];
  p.q_norm_w = (const float*)d_in[4]; p.k_norm_w = (const float*)d_in[5]; p.rwkv_mu = (const float*)d_in[6]; p.rwkv_w0 = (const float*)d_in[7];
  p.rwkv_w2 = (const float*)d_in[8]; p.rwkv_a0 = (const float*)d_in[9]; p.rwkv_a2 = (const float*)d_in[10]; p.rwkv_g2 = (const float*)d_in[11];
  p.rwkv_k_k = (const float*)d_in[12]; p.rwkv_k_a = (const float*)d_in[13]; p.rwkv_r_k = (const float*)d_in[14]; p.rwkv_ln_w = (const float*)d_in[15];
  p.rwkv_ln_b = (const float*)d_in[16]; p.w_out = (const float*)d_in[17]; p.norm2_w = (const float*)d_in[18]; p.router_w = (const float*)d_in[19];
  p.router_b = (const float*)d_in[20]; p.exp_w_gu = (const float*)d_in[21]; p.exp_b_gu = (const float*)d_in[22]; p.exp_w_down = (const float*)d_in[23];
  p.exp_b_down = (const float*)d_in[24];
  p.out = (float*)d_out; p.ws = (char*)d_ws;
#if FUSED
  static int grid_blocks = 0;
  if (!grid_blocks) {
    (void)hipFuncSetAttribute((const void*)fwd_megakernel, hipFuncAttributeMaxDynamicSharedMemorySize, LDS_BYTES);
    int dev = 0, cus = 0, per_cu = 0;
    (void)hipGetDevice(&dev);
    (void)hipDeviceGetAttribute(&cus, hipDeviceAttributeMultiprocessorCount, dev);
    (void)hipOccupancyMaxActiveBlocksPerMultiprocessor(&per_cu, fwd_megakernel, NTHREADS, LDS_BYTES);
    if (per_cu < 1) { fprintf(stderr, "occupancy query returned %d\n", per_cu); per_cu = 1; }
    grid_blocks = cus;
  }
  (void)hipMemsetAsync((char*)d_ws + OFF_BAR, 0, 16384, stream);
  void* args[] = {(void*)&p};
  hipError_t e = hipLaunchCooperativeKernel((void*)fwd_megakernel, dim3(grid_blocks), dim3(NTHREADS), args, LDS_BYTES, stream);
  if (e != hipSuccess) fprintf(stderr, "cooperative launch failed: %s (grid %d)\n", hipGetErrorString(e), grid_blocks);
#else
  launch_all<0>(p, 256, stream);
#endif
}
```
